# Optimizing an MI355X kernel written in HIP

```python
import math
import jax
import jax.numpy as jnp
from jax import lax
import numpy as np

D_MODEL = 1024
BATCH = 2
SEQ = 8192
DEPTH = 2

GRID_W = 64
CTX_LEN = 256
N_MIXERS = 2
N_HG_HEADS = 8
HG_HEAD_DIM = D_MODEL // N_HG_HEADS
HG_CHUNK = 64
SGU_WIDTH = D_MODEL
SGU_CHUNK = 128
SGU_GROUPS = 8
SGU_GROUP_DIM = SGU_WIDTH // SGU_GROUPS
N_EXPERTS = 16
EC_CAPACITY_FACTOR = 2
EXPERT_FF = 2 * D_MODEL
N_ADA = 6
EPS = 1e-6
N_HGRN_LAYERS = (DEPTH + 1) // 2
N_SGU_LAYERS = DEPTH // 2

kernel_name = 'hybrid_hgrn2_sgu_ecmoe_dit'


def _rmsnorm(x, w):
    xf = x.astype(jnp.float32)
    y = xf * lax.rsqrt(jnp.mean(xf * xf, axis=-1, keepdims=True) + EPS)
    return (y * w.astype(jnp.float32)).astype(x.dtype)


def _layernorm(x, w, b):
    xf = x.astype(jnp.float32)
    mu = jnp.mean(xf, axis=-1, keepdims=True)
    xc = xf - mu
    y = xc * lax.rsqrt(jnp.mean(xc * xc, axis=-1, keepdims=True) + EPS)
    return (y * w.astype(jnp.float32) + b.astype(jnp.float32)).astype(x.dtype)


def _modulate(h, shift, scale):
    return h * (1 + scale) + shift


def _sincos_2d(rows, dim):
    quarter = dim // 4
    half = dim // 2
    freqs = jnp.exp(-math.log(10000.0) * jnp.arange(quarter, dtype=jnp.float32) / quarter)

    def emb1d(n):
        ang = jnp.arange(n, dtype=jnp.float32)[:, None] * freqs[None, :]
        return jnp.concatenate([jnp.sin(ang), jnp.cos(ang)], axis=-1)

    er = emb1d(rows)
    ec = emb1d(GRID_W)
    pos = jnp.concatenate([jnp.broadcast_to(er[:, None, :], (rows, GRID_W, half)),
                           jnp.broadcast_to(ec[None, :, :], (rows, GRID_W, half))], axis=-1)
    return pos.reshape(rows * GRID_W, dim)


def _to_chunks(t):
    b, n, h, d = t.shape
    return t.reshape(b, n // HG_CHUNK, HG_CHUNK, h, d).transpose(1, 0, 3, 2, 4)


def _from_chunks(t):
    n, b, h, c, d = t.shape
    return t.transpose(1, 0, 3, 2, 4).reshape(b, n * c, h, d)


def _gla_scan(k, v, log_f, s0, q=None):
    tri = jnp.tril(jnp.ones((HG_CHUNK, HG_CHUNK), dtype=bool))[:, :, None]
    xs = (_to_chunks(k), _to_chunks(v), _to_chunks(log_f))
    if q is not None:
        xs = xs + (_to_chunks(q),)

    def body(state, inp):
        kc, vc, gc = inp[0], inp[1], inp[2]
        b = jnp.cumsum(gc, axis=2)
        b_last = b[:, :, -1:, :]
        new_state = (jnp.exp(b_last[:, :, 0, :])[..., None] * state
                     + jnp.einsum('bhsk,bhsv->bhkv', kc * jnp.exp(b_last - b), vc))
        if q is None:
            return new_state, None
        qc = inp[3]
        o_inter = jnp.einsum('bhtk,bhkv->bhtv', qc * jnp.exp(b), state)
        diff = b[:, :, :, None, :] - b[:, :, None, :, :]
        decay = jnp.exp(jnp.where(tri, diff, -jnp.inf))
        scores = jnp.einsum('bhtk,bhsk,bhtsk->bhts', qc, kc, decay)
        return new_state, o_inter + jnp.einsum('bhts,bhsv->bhtv', scores, vc)

    final_state, o = lax.scan(body, s0, xs)
    return (None if q is None else _from_chunks(o)), final_state


def _forget(f_raw, lb):
    f = lb + (1 - lb) * jax.nn.sigmoid(f_raw)
    return 1 - f, jnp.log(f)


def _hgrn2_bidir(pr, lb, s0_f, s0_b, with_output):
    bsz, t = pr.shape[0], pr.shape[1]
    d = D_MODEL

    def heads(a):
        return a.reshape(bsz, t, N_HG_HEADS, HG_HEAD_DIM).astype(jnp.float32)

    def flip(a):
        return jnp.flip(a, axis=1)

    v = heads(pr[..., 0:d])
    k_f, lf_f = _forget(heads(pr[..., d:2 * d]), lb[0])
    k_b, lf_b = _forget(heads(pr[..., 2 * d:3 * d]), lb[1])
    q = jax.nn.silu(heads(pr[..., 3 * d:4 * d])) if with_output else None
    o_f, s_f = _gla_scan(k_f, v, lf_f, s0_f, q)
    o_b, s_b = _gla_scan(flip(k_b), flip(v), flip(lf_b), s0_b, None if q is None else flip(q))
    o = (o_f + flip(o_b)) if with_output else None
    return o, s_f, s_b


def _hgrn2_readout(o, g, gnorm_w, w_out, dtype):
    bsz, t = o.shape[0], o.shape[1]
    gw = gnorm_w.astype(jnp.float32).reshape(N_HG_HEADS, HG_HEAD_DIM)
    o = o * lax.rsqrt(jnp.mean(o * o, axis=-1, keepdims=True) + EPS) * gw
    o = o.reshape(bsz, t, D_MODEL).astype(dtype) * jax.nn.silu(g)
    return o @ w_out


def _sgu_mixer(h, w_in, ln_w, ln_b, w_s, b_s, w_out):
    bsz, t, _ = h.shape
    z = jax.nn.gelu(h @ w_in)
    u, v = jnp.split(z, 2, axis=-1)
    v = _layernorm(v, ln_w, ln_b)
    vb = v.reshape(bsz, t // SGU_CHUNK, SGU_CHUNK, SGU_GROUPS, SGU_GROUP_DIM)
    mixed = jnp.einsum('gpq,bnqgc->bnpgc', w_s, vb) + b_s.T[:, :, None]
    return (u * mixed.reshape(bsz, t, SGU_WIDTH)) @ w_out


def _ec_moe(h, router, w_gate, w_up, w_down):
    bsz, t, d = h.shape
    cap = EC_CAPACITY_FACTOR * t // N_EXPERTS
    aff = jax.nn.softmax((h @ router).astype(jnp.float32), axis=-1)
    gate, idx = lax.top_k(jnp.swapaxes(aff, 1, 2), cap)
    xs = jax.vmap(lambda hb, ib: hb[ib])(h, idx)
    hid = jax.nn.silu(jnp.einsum('becd,edf->becf', xs, w_gate)) * jnp.einsum('becd,edf->becf', xs, w_up)
    y = jnp.einsum('becf,efd->becd', hid, w_down) * gate[..., None].astype(h.dtype)
    return jax.vmap(lambda yb, ib: jnp.zeros((t, d), y.dtype).at[ib.reshape(-1)].add(yb.reshape(-1, d)))(y, idx)


def setup_inputs(seed: int = 0) -> dict:
    key = jax.random.key(seed)
    ks = jax.random.split(key, 21)
    d = D_MODEL

    def nrm(k, shape, s):
        return jax.random.normal(k, shape, jnp.float32) * s

    return {
        'x': nrm(ks[0], (BATCH, SEQ, d), 1.0),
        'c': nrm(ks[1], (BATCH, d), 1.0),
        'ctx': nrm(ks[2], (BATCH, CTX_LEN, d), 1.0),
        'c_ctx': nrm(ks[3], (d,), 1.0),
        'w_ada': nrm(ks[4], (DEPTH, d, N_ADA * d), 0.5 * d ** -0.5),
        'b_ada': nrm(ks[5], (DEPTH, N_ADA * d), 0.01),
        'norm_w': 1.0 + nrm(ks[6], (DEPTH, 4, d), 0.02),
        'hg_w_in': nrm(ks[7], (N_HGRN_LAYERS, d, 5 * d), d ** -0.5),
        'hg_lb': nrm(ks[8], (DEPTH + 1, 2, d), 0.5),
        'hg_gnorm': 1.0 + nrm(ks[9], (N_HGRN_LAYERS, d), 0.02),
        'hg_w_out': nrm(ks[10], (N_HGRN_LAYERS, d, d), d ** -0.5),
        'sg_w_in': nrm(ks[11], (N_SGU_LAYERS, d, 2 * SGU_WIDTH), d ** -0.5),
        'sg_ln_w': 1.0 + nrm(ks[12], (N_SGU_LAYERS, SGU_WIDTH), 0.02),
        'sg_ln_b': nrm(ks[13], (N_SGU_LAYERS, SGU_WIDTH), 0.02),
        'sg_w_s': nrm(ks[14], (N_SGU_LAYERS, SGU_GROUPS, SGU_CHUNK, SGU_CHUNK), SGU_CHUNK ** -0.5),
        'sg_b_s': 1.0 + nrm(ks[15], (N_SGU_LAYERS, SGU_GROUPS, SGU_CHUNK), 0.1),
        'sg_w_out': nrm(ks[16], (N_SGU_LAYERS, SGU_WIDTH, d), SGU_WIDTH ** -0.5),
        'moe_router': nrm(ks[17], (DEPTH, d, N_EXPERTS), d ** -0.5),
        'moe_w_gate': nrm(ks[18], (DEPTH, N_EXPERTS, d, EXPERT_FF), d ** -0.5),
        'moe_w_up': nrm(ks[19], (DEPTH, N_EXPERTS, d, EXPERT_FF), d ** -0.5),
        'moe_w_down': nrm(ks[20], (DEPTH, N_EXPERTS, EXPERT_FF, d), EXPERT_FF ** -0.5),
    }


def reference(x, c, ctx, c_ctx, w_ada, b_ada, norm_w, hg_w_in, hg_lb, hg_gnorm, hg_w_out,
              sg_w_in, sg_ln_w, sg_ln_b, sg_w_s, sg_b_s, sg_w_out,
              moe_router, moe_w_gate, moe_w_up, moe_w_down):
    bsz, seq_len, d = x.shape
    ROWS = seq_len // GRID_W
    x = x + _sincos_2d(ROWS, d).astype(x.dtype)[None]
    lb_all = jnp.cumsum(jax.nn.softmax(hg_lb.astype(jnp.float32), axis=0), axis=0)
    is_hgrn = [i % N_MIXERS == 0 for i in range(DEPTH)]
    ctx_needed = [any(is_hgrn[j:]) for j in range(DEPTH + 1)]
    silu_c = jax.nn.silu(c)
    silu_cc = jax.nn.silu(c_ctx)
    for i in range(DEPTH):
        j = i // N_MIXERS
        upd_ctx = ctx_needed[i + 1]
        mod = jnp.split(silu_c @ w_ada[i] + b_ada[i], N_ADA, axis=-1)
        sh1, sc1, g1, sh2, sc2, g2 = [m[:, None, :] for m in mod]
        sh1c, sc1c, g1c, sh2c, sc2c, g2c = jnp.split(silu_cc @ w_ada[i] + b_ada[i], N_ADA, axis=-1)

        h = _modulate(_rmsnorm(x, norm_w[i, 0]), sh1, sc1)
        if is_hgrn[i]:
            lb = lb_all[i].reshape(2, N_HG_HEADS, HG_HEAD_DIM)
            hc = _modulate(_rmsnorm(ctx, norm_w[i, 0]), sh1c, sc1c)
            w_c = hg_w_in[j] if upd_ctx else hg_w_in[j][:, :3 * d]
            pc = hc @ w_c
            s0 = jnp.zeros((bsz, N_HG_HEADS, HG_HEAD_DIM, HG_HEAD_DIM), jnp.float32)
            o_c, s_f, s_b = _hgrn2_bidir(pc, lb, s0, s0, upd_ctx)
            pr = h @ hg_w_in[j]
            o, _, _ = _hgrn2_bidir(pr, lb, s_f, s_b, True)
            y = _hgrn2_readout(o, pr[..., 4 * d:], hg_gnorm[j], hg_w_out[j], x.dtype)
            if upd_ctx:
                yc = _hgrn2_readout(o_c, pc[..., 4 * d:], hg_gnorm[j], hg_w_out[j], ctx.dtype)
        else:
            y = _sgu_mixer(h, sg_w_in[j], sg_ln_w[j], sg_ln_b[j], sg_w_s[j], sg_b_s[j], sg_w_out[j])
            if upd_ctx:
                hc = _modulate(_rmsnorm(ctx, norm_w[i, 0]), sh1c, sc1c)
                yc = _sgu_mixer(hc, sg_w_in[j], sg_ln_w[j], sg_ln_b[j], sg_w_s[j], sg_b_s[j], sg_w_out[j])
        x = x + g1 * _rmsnorm(y, norm_w[i, 1])
        if upd_ctx:
            ctx = ctx + g1c * _rmsnorm(yc, norm_w[i, 1])

        h = _modulate(_rmsnorm(x, norm_w[i, 2]), sh2, sc2)
        y = _ec_moe(h, moe_router[i], moe_w_gate[i], moe_w_up[i], moe_w_down[i])
        x = x + g2 * _rmsnorm(y, norm_w[i, 3])
        if upd_ctx:
            hc = _modulate(_rmsnorm(ctx, norm_w[i, 2]), sh2c, sc2c)
            yc = _ec_moe(hc, moe_router[i], moe_w_gate[i], moe_w_up[i], moe_w_down[i])
            ctx = ctx + g2c * _rmsnorm(yc, norm_w[i, 3])
    return x
```

```cpp
#include <hip/hip_runtime.h>
#include <cstdio>
#include <cstdint>

#ifndef MK_N_LAUNCHES
#define MK_N_LAUNCHES 1
#endif

#define LAS __attribute__((address_space(3)))
typedef unsigned short bf16;
typedef short bf16x8 __attribute__((ext_vector_type(8)));
typedef short s16x4 __attribute__((ext_vector_type(4)));
typedef float f32x4 __attribute__((ext_vector_type(4)));
typedef float f32x2 __attribute__((ext_vector_type(2)));
typedef unsigned u32x4 __attribute__((ext_vector_type(4)));
typedef unsigned u32x2 __attribute__((ext_vector_type(2)));
typedef __bf16 bf16x2_t __attribute__((ext_vector_type(2)));

constexpr int NB = 2, T = 8192, D = 1024, M = NB * T, CTX = 256, MC = NB * CTX, MT = M + MC;
constexpr int NH = 8, HD = 128, NE = 16, CAP = 1024, FF = 2048, NPAIR = NB * NE * CAP;
constexpr int SCT = 512, NSC = T / SCT;
constexpr float EPS = 1e-6f;
constexpr int NPHASE = 20;

constexpr size_t MiB = 1u << 20;
constexpr size_t WS_CTL = 0, CTL_ZERO_BYTES = 64 * 1024;
constexpr size_t WS_LB = 1 * MiB;
constexpr size_t WS_MOD = 1 * MiB + 64 * 1024;
constexpr size_t WS_MODP = 2 * MiB;
constexpr size_t WS_WS = 4 * MiB;
constexpr size_t WS_WHIN = 5 * MiB;
constexpr size_t WS_WHOUT = 15 * MiB;
constexpr size_t WS_WSIN = 17 * MiB;
constexpr size_t WS_WSOUT = 21 * MiB;
constexpr size_t WS_WGU = 24 * MiB;
constexpr size_t WS_WD = 280 * MiB;
constexpr size_t WS_XR = 408 * MiB;
constexpr size_t WS_H = 472 * MiB;
constexpr size_t WS_R1 = 505 * MiB;
constexpr size_t WS_V = WS_R1, WS_KF = WS_V + 33 * MiB, WS_LFF = WS_KF + 33 * MiB, WS_KB = WS_LFF + 33 * MiB, WS_LFB = WS_KB + 33 * MiB;
constexpr size_t WS_Q = WS_LFB + 33 * MiB, WS_SG = WS_Q + 32 * MiB;
constexpr size_t WS_HID = WS_R1, WS_YP = WS_R1 + 128 * MiB;
constexpr size_t WS_Z = WS_R1, WS_A2 = WS_R1 + 64 * MiB, WS_STATS = WS_R1 + 96 * MiB;
constexpr size_t WS_OG = 734 * MiB;
constexpr size_t WS_OF = 766 * MiB;
constexpr size_t WS_LST = 830 * MiB;
constexpr size_t WS_SENT = 862 * MiB;
constexpr size_t WS_LSTC = 894 * MiB;
constexpr size_t WS_DSUM = 896 * MiB;
constexpr size_t WS_Y = 897 * MiB;
constexpr size_t WS_AFF = 929 * MiB;
constexpr size_t WS_ROWMAP = 930 * MiB;
constexpr size_t WS_GATE = 930 * MiB + 512 * 1024;
constexpr size_t WS_INV = 931 * MiB;
constexpr size_t WS_END = 932 * MiB;

constexpr int LDS_BYTES = 163840;
constexpr int GEMM_TAB_OFF = 131072;
constexpr int GEMM_AUX_OFF = 131072 + 8192;
constexpr int MISC_OFF = LDS_BYTES - 256;
constexpr int HALF_LDS = 81792;

__device__ __forceinline__ float bflo(unsigned u) { return __uint_as_float(u << 16); }
__device__ __forceinline__ float bfhi(unsigned u) { return __uint_as_float(u & 0xffff0000u); }
__device__ __forceinline__ unsigned pk2(float lo, float hi) { f32x2 v = {lo, hi}; bf16x2_t b = __builtin_convertvector(v, bf16x2_t); return __builtin_bit_cast(unsigned, b); }
__device__ __forceinline__ float wave_sum(float v) {
#pragma unroll
    for (int o = 1; o < 64; o <<= 1) v += __shfl_xor(v, o);
    return v;
}
__device__ __forceinline__ float sigmoidf_(float x) { return 1.0f / (1.0f + __expf(-x)); }
__device__ __forceinline__ float siluf_(float x) { return x / (1.0f + __expf(-x)); }
__device__ __forceinline__ float gelu_tanh(float x) { const float u = 0.7978845608028654f * (x + 0.044715f * x * x * x); return x / (1.0f + __expf(-2.0f * u)); }
__device__ __forceinline__ int opaque_tid() { int t = threadIdx.x; asm volatile("" : "+v"(t)); return t; }
#define LDS_WAIT() asm volatile("s_waitcnt lgkmcnt(0)" ::: "memory")
#define VM_WAIT() asm volatile("s_waitcnt vmcnt(0)" ::: "memory")

#define XB_TMO      128
#define XB_XCNT(j)  (256  + 64 * (j))
#define XB_XSUB(j)  (1280 + 64 * (j))
#define XB_XGEN(j)  (2304 + 64 * (j))
#define XB_TOP      3328
#define XB_TOPGEN   3392
#define XCD_BAR_WORDS 3456
#define XB_SPIN_CAP (1u << 22)
__device__ __forceinline__ unsigned xb_ld(unsigned* p)              { return __hip_atomic_load(p, __ATOMIC_RELAXED, __HIP_MEMORY_SCOPE_AGENT); }
__device__ __forceinline__ unsigned xb_add(unsigned* p, unsigned v) { return __hip_atomic_fetch_add(p, v, __ATOMIC_RELAXED, __HIP_MEMORY_SCOPE_AGENT); }
__device__ __forceinline__ unsigned xb_xcc_id() { return (unsigned)__builtin_amdgcn_s_getreg((3 << 11) | 20) & 0xFu; }
#define XB_SPIN(cond, bar) do { unsigned _sp = 0; while (cond) { __builtin_amdgcn_s_sleep(1); \
    if ((++_sp & 255u) == 0u) { if (xb_ld(&(bar)[XB_TMO])) break; if (_sp > XB_SPIN_CAP) { atomicAdd(&(bar)[XB_TMO], 1u); break; } } } } while (0)
struct XcdBarrier { unsigned* bar; unsigned x; volatile LAS unsigned* st; };
__device__ __forceinline__ XcdBarrier xcd_barrier_post(unsigned* bar, volatile LAS unsigned* st) {
    XcdBarrier b; b.bar = bar; b.x = xb_xcc_id(); b.st = st;
    if (threadIdx.x == 0) (void)xb_add(&bar[XB_XCNT(b.x)], 1u);
    return b;
}
__device__ __forceinline__ void xcd_barrier_complete(unsigned* bar, unsigned x, unsigned& nloc, unsigned& nx) {
    const unsigned G = gridDim.x * gridDim.y * gridDim.z;
    unsigned sum, cnt, mine, sp = 0u;
    for (;;) {
        sum = 0u; cnt = 0u; mine = 0u;
#pragma unroll
        for (unsigned j = 0; j < 16; ++j) { const unsigned c = xb_ld(&bar[XB_XCNT(j)]); sum += c; cnt += (c > 0u) ? 1u : 0u; mine = (j == x) ? c : mine; }
        if (sum == G) break;
        __builtin_amdgcn_s_sleep(1);
        if ((++sp & 255u) == 0u) { if (xb_ld(&bar[XB_TMO])) break; if (sp > XB_SPIN_CAP) { atomicAdd(&bar[XB_TMO], 1u); break; } }
    }
    nloc = mine > 0u ? mine : 1u; nx = cnt > 0u ? cnt : 1u;
}
__device__ __forceinline__ void xcd_barrier(const XcdBarrier& b) {
    asm volatile("s_waitcnt vmcnt(0)" ::: "memory");
    __syncthreads();
    if (threadIdx.x == 0) {
        unsigned* bar = b.bar;
        __builtin_amdgcn_s_waitcnt(0);
        unsigned nloc = b.st[0], nx = b.st[1];
        if (nloc == 0u) { xcd_barrier_complete(bar, b.x, nloc, nx); b.st[0] = nloc; b.st[1] = nx; }
        const unsigned old = xb_add(&bar[XB_XSUB(b.x)], 1u);
        const unsigned gen = old / nloc;
        if (old + 1u == (gen + 1u) * nloc) {
            __builtin_amdgcn_fence(__ATOMIC_RELEASE, "agent");
            asm volatile("s_waitcnt vmcnt(0)" ::: "memory");
            const unsigned og = xb_add(&bar[XB_TOP], 1u);
            const unsigned tg = og / nx;
            if (og + 1u == (tg + 1u) * nx) xb_add(&bar[XB_TOPGEN], 1u);
            else XB_SPIN(xb_ld(&bar[XB_TOPGEN]) == tg, bar);
            __builtin_amdgcn_fence(__ATOMIC_ACQUIRE, "agent");
            xb_add(&bar[XB_XGEN(b.x)], 1u);
            asm volatile("s_waitcnt vmcnt(0)" ::: "memory");
        } else {
            XB_SPIN(xb_ld(&bar[XB_XGEN(b.x)]) == gen, bar);
            __builtin_amdgcn_fence(__ATOMIC_ACQUIRE, "agent");
            asm volatile("s_waitcnt vmcnt(0)" ::: "memory");
        }
    }
    __syncthreads();
}

namespace pg8 {
constexpr int BM = 256, BK = 64, HALF = 128, HTB = HALF * BK * 2, STAGE_BYTES = 8 * HTB, NXCD = 8, WGM = 8;
__host__ __device__ __forceinline__ int lds_byte(int r, int c) { const int st = (r >> 4) * 2 + (c >> 5), rr = r & 15, cc = c & 31, ob = rr * 64 + cc * 2; return st * 1024 + (ob ^ (((ob >> 9) & 1) << 5)); }
__host__ __device__ __forceinline__ void stage_rc(int b, int& R, int& C) { const int st = b / 1024, sb = b % 1024, swz = sb ^ (((sb >> 9) & 1) << 5); R = (st >> 1) * 16 + swz / 64; C = (st & 1) * 32 + (swz % 64) / 2; }
__host__ __device__ __forceinline__ int perm32(int rho) { const int n = rho >> 4, i = rho & 15; return 8 * (i >> 2) + 4 * n + (i & 3); }

struct Unit { int pm, pn, bt; };
struct Gemm { const bf16* A; const bf16* Bt; int K; const int* rowmap; };

struct GridOrder {
    int nM, nN, nwg, G, c, bmul;
    __device__ void init(int nM_, int nN_, int G_, int c_, int bmul_) { nM = nM_; nN = nN_; nwg = nM * nN; G = G_; c = c_; bmul = bmul_; }
    __device__ __forceinline__ bool next(int i, Unit& u) const {
        const long L = (long)i * G + c; if (L >= nwg) return false;
        int wgid = (int)L; { const int q = nwg / NXCD, r = nwg % NXCD, xcd = wgid % NXCD, off = wgid / NXCD; wgid = (xcd < r ? xcd * (q + 1) : r * (q + 1) + (xcd - r) * q) + off; }
        const int nig = WGM * nN, gid = wgid / nig, fm = gid * WGM, gsz = (nM - fm) < WGM ? (nM - fm) : WGM;
        u.pm = fm + ((wgid % nig) % gsz); u.pn = (wgid % nig) / gsz; u.bt = bmul ? (u.pm >> 3) * bmul + u.pn : u.pn; return true;
    }
};
struct HinOrder {
    GridOrder g;
    __device__ void init(int G_, int c_) { g.init(64, 20, G_, c_, 0); }
    __device__ __forceinline__ bool next(int i, Unit& u) const {
        const long L = (long)i * g.G + g.c;
        if (L < 1280) return g.next(i, u);
        const int r = (int)L - 1280; if (r >= 24) return false;
        u.pm = 64 + r / 12; u.pn = r % 12; u.bt = u.pn; return true;
    }
};

__device__ __forceinline__ unsigned cvt_pk_bf16(float lo, float hi) { return pk2(lo, hi); }


template <class Epi, class Sched, bool GATHER>
__device__ __forceinline__ void gemm_phase(LAS unsigned char* lds, const Gemm g, const Sched& S, const Epi& E) {
    const int tid = opaque_tid(), wid = __builtin_amdgcn_readfirstlane(tid >> 6), lane = tid & 63, wr = wid >> 2, wc = wid & 3, fr = lane & 15, fq = lane >> 4;
    const int K = g.K, nt = K / BK;
    int RA[2], CA[2]; unsigned voffB[2], voffA[2];
#pragma unroll
    for (int i = 0; i < 2; ++i) { int R, C; stage_rc(tid * 16 + i * 8192, R, C); RA[i] = R; CA[i] = C; const int Rb = (R & ~31) + perm32(R & 31); voffB[i] = (unsigned)(Rb * K + C) * 2u; voffA[i] = (unsigned)(R * K + C) * 2u; }
    const size_t kstep = (size_t)(BK * 2);
    const size_t hstep = (size_t)HALF * K * 2;
    const size_t tstep = 2 * hstep;
    const unsigned ldsw = (unsigned)wid * 1024u;
    const int aoff = lds_byte(wr * 64 + fr, fq * 8), boff = lds_byte(wc * 32 + fr, fq * 8);
    LAS int* tab = (LAS int*)(lds + GEMM_TAB_OFF);
#define PG8_SA(b, h) (((b) * 2 + (h)) * HTB)
#define PG8_SB(b, h) ((4 + (b) * 2 + (h)) * HTB)
#define PG8_STAGE_B(bufoff, gbase) do { _Pragma("unroll") for (int _i = 0; _i < 2; ++_i) \
        __builtin_amdgcn_global_load_lds((const unsigned*)((const char*)(gbase) + voffB[_i]), (LAS unsigned*)(lds + (bufoff) + ldsw + _i * 8192), 16, 0, 0); } while (0)
#define PG8_STAGE_A(bufoff, koff, nx, h) do { _Pragma("unroll") for (int _i = 0; _i < 2; ++_i) { \
        const char* _p = GATHER ? (const char*)g.A + (koff) + ((nx) ? o2[h][_i] : oAc[h][_i]) : ((nx) ? a2b : cAb) + (koff) + (h) * hstep + voffA[_i]; \
        __builtin_amdgcn_global_load_lds((const unsigned*)_p, (LAS unsigned*)(lds + (bufoff) + ldsw + _i * 8192), 16, 0, 0); } } while (0)
#define PG8_LDA(dst, b, h) do { _Pragma("unroll") for (int m = 0; m < 4; ++m) _Pragma("unroll") for (int k = 0; k < 2; ++k) dst[m][k] = *(const LAS bf16x8*)(lds + PG8_SA(b, h) + aoff + m * 2048 + k * 1024); } while (0)
#define PG8_LDB(dst, b, h) do { _Pragma("unroll") for (int n = 0; n < 2; ++n) _Pragma("unroll") for (int k = 0; k < 2; ++k) dst[n][k] = *(const LAS bf16x8*)(lds + PG8_SB(b, h) + boff + n * 2048 + k * 1024); } while (0)
#define PG8_MMA(ai, bj, At, Bt) do { __builtin_amdgcn_s_setprio(1); _Pragma("unroll") for (int m = 0; m < 4; ++m) _Pragma("unroll") for (int n = 0; n < 2; ++n) _Pragma("unroll") for (int k = 0; k < 2; ++k) \
        acc[ai][bj][m][n] = __builtin_amdgcn_mfma_f32_16x16x32_bf16(Bt[n][k], At[m][k], acc[ai][bj][m][n], 0, 0, 0); __builtin_amdgcn_s_setprio(0); } while (0)
#define PG8_WAIT_V(n) asm volatile("s_waitcnt vmcnt(" #n ")" ::: "memory")
#define PG8_WAIT_L(n) asm volatile("s_waitcnt lgkmcnt(" #n ")" ::: "memory")
#define PG8_BAR __builtin_amdgcn_s_barrier()
#define PG8_SCHED __builtin_amdgcn_sched_barrier(0)
#define PG8_AOFFS(o, ui) do { _Pragma("unroll") for (int _h = 0; _h < 2; ++_h) _Pragma("unroll") for (int _i = 0; _i < 2; ++_i) { \
        const int _row = tab[(ui) * 256 + _h * HALF + RA[_i]]; (o)[_h][_i] = (unsigned)(_row * K + CA[_i]) * 2u; } } while (0)
    Unit cur, nxt; int ui = 0;
    if (!S.next(0, cur)) return;
    f32x4 acc[2][2][4][2];
#pragma unroll
    for (int a = 0; a < 2; ++a)
#pragma unroll
        for (int b = 0; b < 2; ++b)
#pragma unroll
            for (int m = 0; m < 4; ++m)
#pragma unroll
                for (int n = 0; n < 2; ++n) acc[a][b][m][n] = (f32x4){0.f, 0.f, 0.f, 0.f};
    bf16x8 At[4][2], B0[2][2], B1[2][2];
    unsigned oAc[2][2], oAn[2][2], o2[2][2];
#pragma unroll
    for (int h = 0; h < 2; ++h)
#pragma unroll
        for (int i = 0; i < 2; ++i) { oAc[h][i] = 0u; oAn[h][i] = 0u; o2[h][i] = 0u; }
    if (GATHER) { PG8_AOFFS(oAc, 0); }
    const char* cAb = (const char*)g.A + (size_t)cur.pm * tstep; const char* a2b = cAb;
    const char* cB = (const char*)g.Bt + (size_t)cur.bt * tstep;
    PG8_STAGE_B(PG8_SB(0, 0), cB); PG8_STAGE_B(PG8_SB(0, 1), cB + hstep); PG8_STAGE_A(PG8_SA(0, 0), 0, 0, 0); PG8_STAGE_A(PG8_SA(0, 1), 0, 0, 1);
    if (wr == 1) PG8_BAR;
    PG8_WAIT_V(2); PG8_BAR;
    PG8_STAGE_B(PG8_SB(1, 0), cB + kstep); PG8_STAGE_A(PG8_SA(1, 0), kstep, 0, 0); PG8_STAGE_B(PG8_SB(1, 1), cB + hstep + kstep);
    PG8_WAIT_V(6); PG8_BAR;
    for (;;) {
        const bool has_next = S.next(ui + 1, nxt);
        if (GATHER) {
            if (has_next) { PG8_AOFFS(oAn, ui + 1); }
            else {
#pragma unroll
                for (int h = 0; h < 2; ++h)
#pragma unroll
                    for (int i = 0; i < 2; ++i) oAn[h][i] = oAc[h][i];
            }
        }
        const char* nAb = has_next ? (const char*)g.A + (size_t)nxt.pm * tstep : cAb;
        const char* nB = has_next ? (const char*)g.Bt + (size_t)nxt.bt * tstep : cB;
        for (int t = 0; t < nt; t += 2) {
            const bool last = (t == nt - 2);
            const size_t k1 = (size_t)(t + 1) * kstep;
            const size_t k2 = last ? 0 : (size_t)(t + 2) * kstep, k3 = k2 + kstep;
            if (GATHER) {
#pragma unroll
                for (int h = 0; h < 2; ++h)
#pragma unroll
                    for (int i = 0; i < 2; ++i) o2[h][i] = last ? oAn[h][i] : oAc[h][i];
            }
            a2b = last ? nAb : cAb;
            const char* b2 = last ? nB : cB + (size_t)(t + 2) * kstep; const char* b3 = b2 + kstep;
            PG8_LDB(B0, 0, 0); PG8_LDB(B1, 0, 1); PG8_SCHED; PG8_LDA(At, 0, 0); PG8_STAGE_A(PG8_SA(1, 1), k1, 0, 1);
            PG8_WAIT_V(8); PG8_WAIT_L(0); PG8_BAR; PG8_MMA(0, 0, At, B0); PG8_MMA(0, 1, At, B1); PG8_BAR; PG8_SCHED;
            PG8_LDA(At, 0, 1); PG8_STAGE_B(PG8_SB(0, 0), b2); PG8_STAGE_B(PG8_SB(0, 1), b2 + hstep); PG8_STAGE_A(PG8_SA(0, 0), k2, 1, 0);
            PG8_WAIT_V(8); PG8_WAIT_L(0); PG8_BAR; PG8_MMA(1, 0, At, B0); PG8_MMA(1, 1, At, B1); PG8_BAR; PG8_SCHED;
            PG8_LDB(B0, 1, 0); PG8_LDB(B1, 1, 1); PG8_SCHED; PG8_LDA(At, 1, 0); PG8_STAGE_A(PG8_SA(0, 1), k2, 1, 1);
            PG8_WAIT_V(8); PG8_WAIT_L(0); PG8_BAR; PG8_MMA(0, 0, At, B0); PG8_MMA(0, 1, At, B1); PG8_BAR; PG8_SCHED;
            PG8_LDA(At, 1, 1); PG8_STAGE_B(PG8_SB(1, 0), b3); PG8_STAGE_B(PG8_SB(1, 1), b3 + hstep); PG8_STAGE_A(PG8_SA(1, 0), k3, 1, 0);
            PG8_WAIT_V(8); PG8_WAIT_L(0); PG8_BAR; PG8_MMA(1, 0, At, B0); PG8_MMA(1, 1, At, B1); PG8_BAR; PG8_SCHED;
        }
        if (wr == 0) PG8_BAR;
        E(acc, cur, ui, wr, wc, fr, fq, lds);
        if (!has_next) break;
#pragma unroll
        for (int a = 0; a < 2; ++a)
#pragma unroll
            for (int b = 0; b < 2; ++b)
#pragma unroll
                for (int m = 0; m < 4; ++m)
#pragma unroll
                    for (int n = 0; n < 2; ++n) acc[a][b][m][n] = (f32x4){0.f, 0.f, 0.f, 0.f};
        cur = nxt; cB = nB; cAb = nAb; ++ui;
        if (GATHER) {
#pragma unroll
            for (int h = 0; h < 2; ++h)
#pragma unroll
                for (int i = 0; i < 2; ++i) oAc[h][i] = oAn[h][i];
        }
        if (wr == 1) PG8_BAR;
    }
    PG8_WAIT_V(0);
    PG8_BAR;
#undef PG8_SA
#undef PG8_SB
#undef PG8_STAGE_A
#undef PG8_STAGE_B
#undef PG8_LDA
#undef PG8_LDB
#undef PG8_MMA
#undef PG8_WAIT_V
#undef PG8_WAIT_L
#undef PG8_BAR
#undef PG8_SCHED
#undef PG8_AOFFS
}

#define EPI_ROWS_BEGIN(u) \
    _Pragma("unroll") for (int ai = 0; ai < 2; ++ai) _Pragma("unroll") for (int m = 0; m < 4; ++m) { const int row = (u).pm * BM + ai * HALF + wr * 64 + m * 16 + fr; const int rloc = ai * HALF + wr * 64 + m * 16 + fr; (void)rloc; (void)row;
#define EPI_ROWS_END }

struct EpiHin {
    unsigned char* ws;
    __device__ __forceinline__ void operator()(const f32x4 (&acc)[2][2][4][2], const Unit& u, int ui, int wr, int wc, int fr, int fq, LAS unsigned char* lds) const {
        const int region = u.pn >> 2, cc0 = (u.pn & 3) * 256 + wc * 32 + 8 * fq;
        const LAS float* lbt = (const LAS float*)(lds + GEMM_AUX_OFF);
        if (region == 0 || region >= 3) {
            bf16* O = (bf16*)(ws + (region == 0 ? WS_V : (region == 3 ? WS_Q : WS_SG)));
            EPI_ROWS_BEGIN(u)
                bf16* rowp = O + (size_t)row * D + cc0;
#pragma unroll
                for (int bj = 0; bj < 2; ++bj) { f32x4 v0 = acc[ai][bj][m][0], v1 = acc[ai][bj][m][1];
                    if (region != 0) {
#pragma unroll
                        for (int j = 0; j < 4; ++j) { v0[j] = siluf_(v0[j]); v1[j] = siluf_(v1[j]); } }
                    u32x4 w; w.x = pk2(v0[0], v0[1]); w.y = pk2(v0[2], v0[3]); w.z = pk2(v1[0], v1[1]); w.w = pk2(v1[2], v1[3]);
                    *(u32x4*)(rowp + bj * HALF) = w; }
            EPI_ROWS_END
        } else {
            bf16* OK = (bf16*)(ws + (region == 1 ? WS_KF : WS_KB)); bf16* OL = (bf16*)(ws + (region == 1 ? WS_LFF : WS_LFB));
            EPI_ROWS_BEGIN(u)
                const size_t ro = (size_t)row * D + cc0;
#pragma unroll
                for (int bj = 0; bj < 2; ++bj) {
                    const f32x4 l0 = *(const LAS f32x4*)(lbt + (region - 1) * 1024 + cc0 + bj * HALF), l1 = *(const LAS f32x4*)(lbt + (region - 1) * 1024 + cc0 + bj * HALF + 4);
                    f32x4 k0, k1, f0, f1;
#pragma unroll
                    for (int j = 0; j < 4; ++j) {
                        { const float a = acc[ai][bj][m][0][j], l = l0[j], e = __expf(-a), sg = 1.0f / (1.0f + e); k0[j] = (1.0f - l) * (e * sg); f0[j] = __logf(l + (1.0f - l) * sg); }
                        { const float a = acc[ai][bj][m][1][j], l = l1[j], e = __expf(-a), sg = 1.0f / (1.0f + e); k1[j] = (1.0f - l) * (e * sg); f1[j] = __logf(l + (1.0f - l) * sg); }
                    }
                    u32x4 w; w.x = pk2(k0[0], k0[1]); w.y = pk2(k0[2], k0[3]); w.z = pk2(k1[0], k1[1]); w.w = pk2(k1[2], k1[3]);
                    *(u32x4*)(OK + ro + bj * HALF) = w;
                    w.x = pk2(f0[0], f0[1]); w.y = pk2(f0[2], f0[3]); w.z = pk2(f1[0], f1[1]); w.w = pk2(f1[2], f1[3]);
                    *(u32x4*)(OL + ro + bj * HALF) = w; }
            EPI_ROWS_END
        }
    }
};
template <int ACT> struct EpiBf16 {
    bf16* O; int ldc; float* stats;
    __device__ __forceinline__ void operator()(const f32x4 (&acc)[2][2][4][2], const Unit& u, int ui, int wr, int wc, int fr, int fq, LAS unsigned char* lds) const {
        const int col0 = u.pn * BM + wc * 32 + 8 * fq;
        EPI_ROWS_BEGIN(u)
            bf16* rowp = O + (size_t)row * ldc + col0; float s1 = 0.f, s2 = 0.f;
#pragma unroll
            for (int bj = 0; bj < 2; ++bj) { f32x4 v0 = acc[ai][bj][m][0], v1 = acc[ai][bj][m][1];
                if (ACT == 1) {
#pragma unroll
                    for (int j = 0; j < 4; ++j) { v0[j] = gelu_tanh(v0[j]); v1[j] = gelu_tanh(v1[j]); s1 += v0[j] + v1[j]; s2 += v0[j] * v0[j] + v1[j] * v1[j]; } }
                u32x4 w; w.x = pk2(v0[0], v0[1]); w.y = pk2(v0[2], v0[3]); w.z = pk2(v1[0], v1[1]); w.w = pk2(v1[2], v1[3]);
                *(u32x4*)(rowp + bj * HALF) = w; }
            if (ACT == 1) { s1 += __shfl_xor(s1, 16); s1 += __shfl_xor(s1, 32); s2 += __shfl_xor(s2, 16); s2 += __shfl_xor(s2, 32);
                if (u.pn >= 4 && fq == 0) *(f32x2*)(stats + ((size_t)row * 16 + (u.pn - 4) * 4 + wc) * 2) = (f32x2){s1, s2}; }
        EPI_ROWS_END
    }
};
struct EpiGU {
    bf16* Hd;
    __device__ __forceinline__ void operator()(const f32x4 (&acc)[2][2][4][2], const Unit& u, int ui, int wr, int wc, int fr, int fq, LAS unsigned char* lds) const {
        const int col0 = u.pn * HALF + wc * 32 + 8 * fq;
        EPI_ROWS_BEGIN(u)
            f32x4 g0 = acc[ai][0][m][0], g1 = acc[ai][0][m][1], u0 = acc[ai][1][m][0], u1 = acc[ai][1][m][1];
#pragma unroll
            for (int j = 0; j < 4; ++j) { g0[j] = siluf_(g0[j]) * u0[j]; g1[j] = siluf_(g1[j]) * u1[j]; }
            u32x4 w; w.x = pk2(g0[0], g0[1]); w.y = pk2(g0[2], g0[3]); w.z = pk2(g1[0], g1[1]); w.w = pk2(g1[2], g1[3]);
            *(u32x4*)(Hd + (size_t)row * FF + col0) = w;
        EPI_ROWS_END
    }
};
struct EpiDown {
    bf16* Yp;
    __device__ __forceinline__ void operator()(const f32x4 (&acc)[2][2][4][2], const Unit& u, int ui, int wr, int wc, int fr, int fq, LAS unsigned char* lds) const {
        const int col0 = u.pn * BM + wc * 32 + 8 * fq;
        const LAS float* gt = (const LAS float*)(lds + GEMM_TAB_OFF) + ui * 256;
        EPI_ROWS_BEGIN(u)
            const float gv = gt[rloc]; bf16* rowp = Yp + (size_t)row * D + col0;
#pragma unroll
            for (int bj = 0; bj < 2; ++bj) { const f32x4 v0 = acc[ai][bj][m][0] * gv, v1 = acc[ai][bj][m][1] * gv;
                u32x4 w; w.x = pk2(v0[0], v0[1]); w.y = pk2(v0[2], v0[3]); w.z = pk2(v1[0], v1[1]); w.w = pk2(v1[2], v1[3]);
                *(u32x4*)(rowp + bj * HALF) = w; }
        EPI_ROWS_END
    }
};
template <class Sched> __device__ __forceinline__ void fill_row_table(LAS unsigned char* lds, const Sched& S, const unsigned* src) {
    LAS unsigned* tab = (LAS unsigned*)(lds + GEMM_TAB_OFF); Unit u;
    for (int i = 0; i < 8 && S.next(i, u); ++i) if (threadIdx.x < 256) tab[i * 256 + threadIdx.x] = src[u.pm * 256 + threadIdx.x];
    VM_WAIT(); LDS_WAIT(); __syncthreads();
}
}

namespace gla {
constexpr int QX_OFF = 0, KE_OFF = 17408, KST_OFF = 34816, VT_OFF = 53248, TOT_OFF = 71680, DG_OFF = 73728, OD_OFF = 75776, DEC_OFF = 77312, SSQ_OFF = 77824;
constexpr int QSTR = 272, PSTR = 144, TSTR = 144;
static_assert(SSQ_OFF + 1024 <= HALF_LDS, "gla LDS map");

__device__ __forceinline__ bf16x8 scale8(bf16x8 a, f32x4 f0, f32x4 f1) {
    u32x4 w = __builtin_bit_cast(u32x4, a);
    w.x = pk2(bflo(w.x) * f0[0], bfhi(w.x) * f0[1]); w.y = pk2(bflo(w.y) * f0[2], bfhi(w.y) * f0[3]);
    w.z = pk2(bflo(w.z) * f1[0], bfhi(w.z) * f1[1]); w.w = pk2(bflo(w.w) * f1[2], bfhi(w.w) * f1[3]);
    return __builtin_bit_cast(bf16x8, w);
}

template <bool OUT>
__device__ __forceinline__ void step(LAS unsigned char* hl, int hw, int lane_in, const bf16* Kp, const bf16* LFp, const bf16* Vp, const bf16* Qp, const bf16* SGp,
                                     long row0, int rstep, int hc, f32x4 (&Sacc)[8][2], float& dsum0, float& dsum1, bool second, float* OF, bf16* OG, const float* gn) {
    int lane = lane_in; asm volatile("" : "+v"(lane));
    const int J = hw, c0 = 2 * lane, l15 = lane & 15, g = lane >> 4;
    unsigned kraw[16], lraw[16], vraw[16], qraw[16];
#pragma unroll
    for (int jj = 0; jj < 16; ++jj) { const unsigned off = (unsigned)((int)row0 + rstep * (16 * J + jj)) * (unsigned)D + (unsigned)(hc + c0);
        kraw[jj] = *(const unsigned*)(Kp + off); lraw[jj] = *(const unsigned*)(LFp + off); vraw[jj] = *(const unsigned*)(Vp + off);
        if (OUT) qraw[jj] = *(const unsigned*)(Qp + off); else qraw[jj] = 0u; }
    float a0 = 0.f, a1 = 0.f;
#pragma unroll
    for (int jj = 0; jj < 16; ++jj) { a0 += bflo(lraw[jj]); a1 += bfhi(lraw[jj]); }
    LAS float* TOT = (LAS float*)(hl + TOT_OFF);
    *(LAS f32x2*)(TOT + J * 128 + c0) = (f32x2){a0, a1};
    LDS_WAIT(); __builtin_amdgcn_s_barrier(); asm volatile("" ::: "memory");
    float t0[4], t1[4];
#pragma unroll
    for (int I = 0; I < 4; ++I) { const f32x2 t = *(const LAS f32x2*)(TOT + I * 128 + c0); t0[I] = t.x; t1[I] = t.y; }
    float RJ0 = 0.f, RJ1 = 0.f, RA0 = 0.f, RA1 = 0.f;
#pragma unroll
    for (int I = 0; I < 4; ++I) { if (I < J) { RJ0 += t0[I]; RJ1 += t1[I]; } if (I > J) { RA0 += t0[I]; RA1 += t1[I]; } }
    const float R40 = (t0[0] + t0[1]) + (t0[2] + t0[3]), R41 = (t1[0] + t1[1]) + (t1[2] + t1[3]);
    {
        LAS float* DG = (LAS float*)(hl + DG_OFF); LAS float* OD = (LAS float*)(hl + OD_OFF); LAS float* DEC = (LAS float*)(hl + DEC_OFF);
        *(LAS f32x2*)(DG + J * 128 + c0) = (f32x2){__expf(fminf(-a0, 80.f)), __expf(fminf(-a1, 80.f))};
        if (J == 0) { *(LAS f32x2*)(DEC + c0) = (f32x2){__expf(R40), __expf(R41)}; dsum0 += R40; dsum1 += R41; }
        else if (J == 1) *(LAS f32x2*)(OD + 0 * 128 + c0) = (f32x2){__expf(t0[1]), __expf(t1[1])};
        else if (J == 2) *(LAS f32x2*)(OD + 1 * 128 + c0) = (f32x2){__expf(t0[2]), __expf(t1[2])};
        else *(LAS f32x2*)(OD + 2 * 128 + c0) = (f32x2){__expf(t0[1] + t0[2]), __expf(t1[1] + t1[2])};
    }
    const float eR0 = __expf(RJ0), eR1 = __expf(RJ1), eA0 = __expf(RA0), eA1 = __expf(RA1);
    unsigned qs[16];
    {
        float r0 = 0.f, r1 = 0.f;
#pragma unroll
        for (int hh = 0; hh < 2; ++hh) {
            float ks0[8], ks1[8];
#pragma unroll
            for (int j8 = 0; j8 < 8; ++j8) {
                const int jj = 8 * hh + j8, i = 16 * J + jj;
                r0 += bflo(lraw[jj]); r1 += bfhi(lraw[jj]);
                const float ke0 = bflo(kraw[jj]) * __expf(a0 - r0), ke1 = bfhi(kraw[jj]) * __expf(a1 - r1);
                ks0[j8] = ke0 * eA0; ks1[j8] = ke1 * eA1;
                if (OUT) {
                    *(LAS unsigned*)(hl + KE_OFF + i * QSTR + c0 * 2) = pk2(ke0, ke1);
                    const float qt0 = bflo(qraw[jj]) * __expf(r0), qt1 = bfhi(qraw[jj]) * __expf(r1);
                    *(LAS unsigned*)(hl + QX_OFF + i * QSTR + c0 * 2) = pk2(qt0, qt1);
                    qs[jj] = pk2(qt0 * eR0, qt1 * eR1);
                } else qs[jj] = 0u;
            }
            u32x4 w;
            w.x = pk2(ks0[0], ks0[1]); w.y = pk2(ks0[2], ks0[3]); w.z = pk2(ks0[4], ks0[5]); w.w = pk2(ks0[6], ks0[7]);
            *(LAS u32x4*)(hl + KST_OFF + c0 * TSTR + 32 * J + 16 * hh) = w;
            w.x = pk2(ks1[0], ks1[1]); w.y = pk2(ks1[2], ks1[3]); w.z = pk2(ks1[4], ks1[5]); w.w = pk2(ks1[6], ks1[7]);
            *(LAS u32x4*)(hl + KST_OFF + (c0 + 1) * TSTR + 32 * J + 16 * hh) = w;
#define VLO(a, b) ((vraw[a] & 0xffffu) | (vraw[b] << 16))
#define VHI(a, b) ((vraw[a] >> 16) | (vraw[b] & 0xffff0000u))
            w.x = VLO(8 * hh + 0, 8 * hh + 1); w.y = VLO(8 * hh + 2, 8 * hh + 3); w.z = VLO(8 * hh + 4, 8 * hh + 5); w.w = VLO(8 * hh + 6, 8 * hh + 7);
            *(LAS u32x4*)(hl + VT_OFF + c0 * TSTR + 32 * J + 16 * hh) = w;
            w.x = VHI(8 * hh + 0, 8 * hh + 1); w.y = VHI(8 * hh + 2, 8 * hh + 3); w.z = VHI(8 * hh + 4, 8 * hh + 5); w.w = VHI(8 * hh + 6, 8 * hh + 7);
            *(LAS u32x4*)(hl + VT_OFF + (c0 + 1) * TSTR + 32 * J + 16 * hh) = w;
#undef VLO
#undef VHI
        }
    }
    LDS_WAIT(); __builtin_amdgcn_s_barrier(); asm volatile("" ::: "memory");
    f32x4 o[4][2];
    if (OUT) {
        const int I = hw;
        f32x4 sc[4];
#pragma unroll
        for (int Jp = 0; Jp < 4; ++Jp) {
            sc[Jp] = (f32x4){0.f, 0.f, 0.f, 0.f};
            if (Jp <= I) {
                const LAS float* ft = (Jp == I) ? (const LAS float*)(hl + DG_OFF) + I * 128
                                    : ((I - Jp == 2) ? (const LAS float*)(hl + OD_OFF) + (I - 2) * 128 : (const LAS float*)(hl + OD_OFF) + 2 * 128);
                const bool needf = (Jp != I - 1);
                f32x4 acc = (f32x4){0.f, 0.f, 0.f, 0.f};
#pragma unroll
                for (int ks = 0; ks < 4; ++ks) {
                    bf16x8 a = *(const LAS bf16x8*)(hl + QX_OFF + (16 * I + l15) * QSTR + (32 * ks + 8 * g) * 2);
                    if (needf) { const f32x4 f0 = *(const LAS f32x4*)(ft + 32 * ks + 8 * g), f1 = *(const LAS f32x4*)(ft + 32 * ks + 8 * g + 4); a = scale8(a, f0, f1); }
                    const bf16x8 b = *(const LAS bf16x8*)(hl + KE_OFF + (16 * Jp + l15) * QSTR + (32 * ks + 8 * g) * 2);
                    acc = __builtin_amdgcn_mfma_f32_16x16x32_bf16(a, b, acc, 0, 0, 0);
                }
                if (Jp == I) {
#pragma unroll
                    for (int r = 0; r < 4; ++r) if (l15 > 4 * g + r) acc[r] = 0.f;
                }
                sc[Jp] = acc;
            }
        }
        LDS_WAIT(); __builtin_amdgcn_s_barrier(); asm volatile("" ::: "memory");
#pragma unroll
        for (int Jp = 0; Jp < 4; ++Jp) {
            const bool wr_blk = (Jp <= I) || (I == 0 && Jp == 1) || (I == 2 && Jp == 3);
            if (wr_blk) {
#pragma unroll
                for (int r = 0; r < 4; ++r) *(LAS unsigned short*)(hl + KE_OFF + (16 * I + 4 * g + r) * PSTR + (16 * Jp + l15) * 2) = (unsigned short)(pk2(sc[Jp][r], 0.f) & 0xffffu);
            }
        }
#pragma unroll
        for (int jj = 0; jj < 16; ++jj) *(LAS unsigned*)(hl + QX_OFF + (16 * J + jj) * QSTR + c0 * 2) = qs[jj];
        LDS_WAIT(); __builtin_amdgcn_s_barrier(); asm volatile("" ::: "memory");
    }
    bf16x8 vb[2][2];
#pragma unroll
    for (int ct = 0; ct < 2; ++ct)
#pragma unroll
        for (int js = 0; js < 2; ++js) vb[ct][js] = *(const LAS bf16x8*)(hl + VT_OFF + (32 * hw + 16 * ct + l15) * TSTR + (32 * js + 8 * g) * 2);
    if (OUT) {
#pragma unroll
        for (int I = 0; I < 4; ++I) {
            o[I][0] = (f32x4){0.f, 0.f, 0.f, 0.f}; o[I][1] = (f32x4){0.f, 0.f, 0.f, 0.f};
#pragma unroll
            for (int ks = 0; ks < (I < 2 ? 1 : 2); ++ks) {
                const bf16x8 pa = *(const LAS bf16x8*)(hl + KE_OFF + (16 * I + l15) * PSTR + (32 * ks + 8 * g) * 2);
                o[I][0] = __builtin_amdgcn_mfma_f32_16x16x32_bf16(pa, vb[0][ks], o[I][0], 0, 0, 0);
                o[I][1] = __builtin_amdgcn_mfma_f32_16x16x32_bf16(pa, vb[1][ks], o[I][1], 0, 0, 0);
            }
        }
#pragma unroll
        for (int ks = 0; ks < 4; ++ks) {
            bf16x8 Sb[2];
#pragma unroll
            for (int ct = 0; ct < 2; ++ct) { const f32x4 s0 = Sacc[2 * ks][ct], s1 = Sacc[2 * ks + 1][ct]; u32x4 w; w.x = pk2(s0[0], s0[1]); w.y = pk2(s0[2], s0[3]); w.z = pk2(s1[0], s1[1]); w.w = pk2(s1[2], s1[3]); Sb[ct] = __builtin_bit_cast(bf16x8, w); }
#pragma unroll
            for (int I = 0; I < 4; ++I) {
                const u32x2 lo = *(const LAS u32x2*)(hl + QX_OFF + (16 * I + l15) * QSTR + (32 * ks + 4 * g) * 2), hi = *(const LAS u32x2*)(hl + QX_OFF + (16 * I + l15) * QSTR + (32 * ks + 16 + 4 * g) * 2);
                const bf16x8 qa = __builtin_bit_cast(bf16x8, (u32x4){lo.x, lo.y, hi.x, hi.y});
                o[I][0] = __builtin_amdgcn_mfma_f32_16x16x32_bf16(qa, Sb[0], o[I][0], 0, 0, 0);
                o[I][1] = __builtin_amdgcn_mfma_f32_16x16x32_bf16(qa, Sb[1], o[I][1], 0, 0, 0);
            }
        }
    }
#pragma unroll
    for (int kt = 0; kt < 8; ++kt) {
        const f32x4 d = *(const LAS f32x4*)(hl + DEC_OFF + (16 * kt + 4 * g) * 4);
        Sacc[kt][0] = Sacc[kt][0] * d; Sacc[kt][1] = Sacc[kt][1] * d;
#pragma unroll
        for (int js = 0; js < 2; ++js) {
            const bf16x8 ka = *(const LAS bf16x8*)(hl + KST_OFF + (16 * kt + l15) * TSTR + (32 * js + 8 * g) * 2);
            Sacc[kt][0] = __builtin_amdgcn_mfma_f32_16x16x32_bf16(ka, vb[0][js], Sacc[kt][0], 0, 0, 0);
            Sacc[kt][1] = __builtin_amdgcn_mfma_f32_16x16x32_bf16(ka, vb[1][js], Sacc[kt][1], 0, 0, 0);
        }
    }
    if (OUT) {
        const unsigned cbase = (unsigned)(hc + 32 * hw + l15);
        if (!second) {
#pragma unroll
            for (int I = 0; I < 4; ++I) {
#pragma unroll
                for (int r = 0; r < 4; ++r) { const unsigned ro = (unsigned)((int)row0 + rstep * (16 * I + 4 * g + r)) * (unsigned)D + cbase; OF[ro] = o[I][0][r]; OF[ro + 16] = o[I][1][r]; }
                asm volatile("" ::: "memory");
            }
        } else {
            LAS float* SSQ = (LAS float*)(hl + SSQ_OFF);
#pragma unroll
            for (int I = 0; I < 4; ++I) {
#pragma unroll
                for (int r = 0; r < 4; ++r) {
                    const unsigned ro = (unsigned)((int)row0 + rstep * (16 * I + 4 * g + r)) * (unsigned)D + cbase;
                    o[I][0][r] += OF[ro]; o[I][1][r] += OF[ro + 16];
                    float s = o[I][0][r] * o[I][0][r] + o[I][1][r] * o[I][1][r];
                    s += __shfl_xor(s, 1); s += __shfl_xor(s, 2); s += __shfl_xor(s, 4); s += __shfl_xor(s, 8);
                    if (l15 == 0) SSQ[hw * 64 + 16 * I + 4 * g + r] = s;
                }
                asm volatile("" ::: "memory");
            }
            LDS_WAIT(); __builtin_amdgcn_s_barrier(); asm volatile("" ::: "memory");
            const float gw0 = gn[hc + 32 * hw + l15], gw1 = gn[hc + 32 * hw + 16 + l15];
#pragma unroll
            for (int I = 0; I < 4; ++I) {
#pragma unroll
                for (int r = 0; r < 4; ++r) {
                    const int i = 16 * I + 4 * g + r;
                    const float tot = (SSQ[i] + SSQ[64 + i]) + (SSQ[128 + i] + SSQ[192 + i]);
                    const float rstd = rsqrtf(tot * (1.0f / HD) + EPS);
                    const unsigned ro = (unsigned)((int)row0 + rstep * i) * (unsigned)D + cbase;
                    const float s0 = bflo((unsigned)SGp[ro]), s1 = bflo((unsigned)SGp[ro + 16]);
                    OG[ro] = (bf16)(pk2(o[I][0][r] * rstd * gw0 * s0, 0.f) & 0xffffu);
                    OG[ro + 16] = (bf16)(pk2(o[I][1][r] * rstd * gw1 * s1, 0.f) & 0xffffu);
                }
                asm volatile("" ::: "memory");
            }
        }
    }
}

struct Ptrs { const bf16 *V, *KF, *LFF, *KB, *LFB, *Q, *SG; float* OF; bf16* OG; const float* gn; float *LST, *SENT, *LSTC, *DSUM; };

__device__ __forceinline__ void pass_a(LAS unsigned char* lds, const Ptrs& P, int G) {
    const int tid = opaque_tid(), wid = __builtin_amdgcn_readfirstlane(tid >> 6), lane = tid & 63, dir = wid >> 2, hw = wid & 3, l15 = lane & 15, g = lane >> 4;
    LAS unsigned char* hl = lds + dir * HALF_LDS;
    const bf16* Kp = dir ? P.KB : P.KF; const bf16* LFp = dir ? P.LFB : P.LFF;
    for (int it = blockIdx.x; it < 272; it += G) {
        const bool isctx = it >= 256;
        int b, h, sc, nsteps; long base;
        if (!isctx) { b = it >> 7; h = (it >> 4) & 7; sc = it & 15; nsteps = 8; base = (long)b * T + sc * SCT; }
        else { const int r = it - 256; b = r >> 3; h = r & 7; sc = 0; nsteps = 4; base = (long)M + b * CTX; }
        f32x4 Sacc[8][2];
#pragma unroll
        for (int kt = 0; kt < 8; ++kt) { Sacc[kt][0] = (f32x4){0.f, 0.f, 0.f, 0.f}; Sacc[kt][1] = (f32x4){0.f, 0.f, 0.f, 0.f}; }
        float ds0 = 0.f, ds1 = 0.f;
        for (int s = 0; s < nsteps; ++s) {
            const long row0 = dir ? base + 64 * (nsteps - 1 - s) + 63 : base + 64 * s;
            step<false>(hl, hw, lane, Kp, LFp, P.V, P.Q, P.SG, row0, dir ? -1 : 1, h * HD, Sacc, ds0, ds1, false, P.OF, P.OG, P.gn);
        }
        const int seq = (b * NH + h) * 2 + dir;
        float* dst = isctx ? P.LSTC + (size_t)seq * 16384 : P.LST + ((size_t)seq * NSC + sc) * 16384;
#pragma unroll
        for (int kt = 0; kt < 8; ++kt)
#pragma unroll
            for (int ct = 0; ct < 2; ++ct)
#pragma unroll
                for (int r = 0; r < 4; ++r) dst[(16 * kt + 4 * g + r) * 128 + 32 * hw + 16 * ct + l15] = Sacc[kt][ct][r];
        if (!isctx && hw == 0) *(f32x2*)(P.DSUM + ((size_t)seq * NSC + sc) * 128 + 2 * lane) = (f32x2){ds0, ds1};
    }
}
__device__ __forceinline__ void pass_b(const Ptrs& P, int G) {
    for (int idx = blockIdx.x * 512 + threadIdx.x; idx < 32 * 4096; idx += G * 512) {
        const int seq = idx >> 12, e4 = (idx & 4095) * 4, k = e4 >> 7, dir = seq & 1;
        f32x4 cur = *(const f32x4*)(P.LSTC + (size_t)seq * 16384 + e4);
        for (int j = 0; j < NSC; ++j) {
            const int sc = dir ? NSC - 1 - j : j;
            const size_t o = ((size_t)seq * NSC + sc);
            *(f32x4*)(P.SENT + o * 16384 + e4) = cur;
            const float dk = __expf(P.DSUM[o * 128 + k]);
            const f32x4 l = *(const f32x4*)(P.LST + o * 16384 + e4);
            cur = cur * dk + l;
        }
    }
}
__device__ __forceinline__ void pass_c(LAS unsigned char* lds, const Ptrs& P, int G) {
    const int tid = opaque_tid(), wid = __builtin_amdgcn_readfirstlane(tid >> 6), lane = tid & 63, dir = wid >> 2, hw = wid & 3, l15 = lane & 15, g = lane >> 4;
    LAS unsigned char* hl = lds + dir * HALF_LDS;
    const bf16* Kp = dir ? P.KB : P.KF; const bf16* LFp = dir ? P.LFB : P.LFF;
    for (int it = blockIdx.x; it < 256; it += G) {
        const int b = it >> 7, h = (it >> 4) & 7, sc = it & 15; const long base = (long)b * T + sc * SCT;
        const int seq = (b * NH + h) * 2 + dir;
        const float* src = P.SENT + ((size_t)seq * NSC + sc) * 16384;
        f32x4 Sacc[8][2];
#pragma unroll
        for (int kt = 0; kt < 8; ++kt)
#pragma unroll
            for (int ct = 0; ct < 2; ++ct)
#pragma unroll
                for (int r = 0; r < 4; ++r) Sacc[kt][ct][r] = src[(16 * kt + 4 * g + r) * 128 + 32 * hw + 16 * ct + l15];
        float ds0 = 0.f, ds1 = 0.f;
        for (int s = 0; s < 8; ++s) {
            const long row0 = dir ? base + 64 * (7 - s) + 63 : base + 64 * s;
            step<true>(hl, hw, lane, Kp, LFp, P.V, P.Q, P.SG, row0, dir ? -1 : 1, h * HD, Sacc, ds0, ds1, s >= 4, P.OF, P.OG, P.gn);
            VM_WAIT();
        }
        __syncthreads();
    }
}
}

struct Args {
    const float *x, *c, *ctx, *c_ctx, *w_ada, *b_ada, *norm_w, *hg_w_in, *hg_lb, *hg_gnorm, *hg_w_out, *sg_w_in, *sg_ln_w, *sg_ln_b, *sg_w_s, *sg_b_s, *sg_w_out,
                *moe_router, *moe_w_gate, *moe_w_up, *moe_w_down;
    float* out; unsigned char* ws; int ph_lo, ph_hi, li, pad;
};
#define CAS __attribute__((address_space(4)))
typedef const CAS Args& ArgsRef;
__device__ __forceinline__ const CAS Args* launder_args(const CAS Args* p) { asm volatile("" : "+s"(p)); return p; }

__device__ __forceinline__ void transpose_item(const float* W, int K, int N, bf16* WT, int rowmode, LAS float* scr, int item, int lane) {
    const int nblk = N / 32, kb = item / nblk, nb = item % nblk, k0 = 64 * kb, n0 = 32 * nb;
    const int rbase = rowmode == 0 ? n0 : ((n0 >> 7) * 256 + (n0 & 127) + (rowmode == 2 ? 128 : 0));
#pragma unroll 8
    for (int i = 0; i < 32; ++i) { const int kk = 2 * i + (lane >> 5); scr[kk * 33 + (lane & 31)] = W[(size_t)(k0 + kk) * N + n0 + (lane & 31)]; }
    LDS_WAIT(); asm volatile("" ::: "memory");
    const int c = lane & 7;
#pragma unroll
    for (int j = 0; j < 4; ++j) { const int n = (lane >> 3) + 8 * j; const LAS float* s = scr + (8 * c) * 33 + n;
        u32x4 o; o.x = pk2(s[0 * 33], s[1 * 33]); o.y = pk2(s[2 * 33], s[3 * 33]); o.z = pk2(s[4 * 33], s[5 * 33]); o.w = pk2(s[6 * 33], s[7 * 33]);
        *(u32x4*)(WT + (size_t)(rbase + n) * K + k0 + 8 * c) = o; }
    LDS_WAIT(); asm volatile("" ::: "memory");
}

__device__ __forceinline__ void phase_p0a(LAS unsigned char* lds, ArgsRef a, int G, int vcu) {
    unsigned char* ws = a.ws;
    const int tid = opaque_tid(), lane = tid & 63, wave = __builtin_amdgcn_readfirstlane(tid >> 6);
    {
        LAS float* sv = (LAS float*)(lds + 67584);
        float* MODP = (float*)(ws + WS_MODP);
        for (int it = blockIdx.x; it < 192; it += G) {
            const int l = it / 96, kc = (it / 12) % 8, cb = it % 12, n = cb * 512 + tid;
            __syncthreads();
            if (tid < 384) { const int v = tid >> 7, k = kc * 128 + (tid & 127); const float cv = v < 2 ? a.c[v * D + k] : a.c_ctx[k]; sv[tid] = siluf_(cv); }
            __syncthreads();
            const float* w = a.w_ada + (size_t)l * D * 6144 + (size_t)(kc * 128) * 6144 + n;
            float a0 = 0.f, a1 = 0.f, a2 = 0.f;
#pragma unroll 8
            for (int k = 0; k < 128; ++k) { const float wv = w[(size_t)k * 6144]; a0 += sv[k] * wv; a1 += sv[128 + k] * wv; a2 += sv[256 + k] * wv; }
            float* dst = MODP + ((size_t)(l * 8 + kc) * 3) * 6144 + n;
            dst[0] = a0; dst[6144] = a1; dst[2 * 6144] = a2;
        }
        __syncthreads();
    }
    {
        LAS float* scr = (LAS float*)(lds + wave * 8448);
        const int gw = vcu * 8 + wave, NGW = G * 8;
        bf16* WHIN = (bf16*)(ws + WS_WHIN); bf16* WHOUT = (bf16*)(ws + WS_WHOUT); bf16* WSIN = (bf16*)(ws + WS_WSIN); bf16* WSOUT = (bf16*)(ws + WS_WSOUT);
        bf16* WGU = (bf16*)(ws + WS_WGU); bf16* WD = (bf16*)(ws + WS_WD);
        constexpr int NIT = 2560 + 512 + 1024 + 512 + 3 * 32768;
        for (int it = gw; it < NIT; it += NGW) {
            int r = it;
            if (r < 2560) { transpose_item(a.hg_w_in, D, 5 * D, WHIN, 0, scr, r, lane); continue; } r -= 2560;
            if (r < 512) { transpose_item(a.hg_w_out, D, D, WHOUT, 0, scr, r, lane); continue; } r -= 512;
            if (r < 1024) { transpose_item(a.sg_w_in, D, 2 * D, WSIN, 0, scr, r, lane); continue; } r -= 1024;
            if (r < 512) { transpose_item(a.sg_w_out, D, D, WSOUT, 0, scr, r, lane); continue; } r -= 512;
            if (r < 32768) { const int le = r >> 10; transpose_item(a.moe_w_gate + (size_t)le * D * FF, D, FF, WGU + (size_t)le * 4096 * D, 1, scr, r & 1023, lane); continue; } r -= 32768;
            if (r < 32768) { const int le = r >> 10; transpose_item(a.moe_w_up + (size_t)le * D * FF, D, FF, WGU + (size_t)le * 4096 * D, 2, scr, r & 1023, lane); continue; } r -= 32768;
            { const int le = r >> 10; transpose_item(a.moe_w_down + (size_t)le * FF * D, FF, D, WD + (size_t)le * D * FF, 0, scr, r & 1023, lane); }
        }
    }
    {
        const int gt = blockIdx.x * 512 + tid, GT = G * 512;
        bf16* WSb = (bf16*)(ws + WS_WS);
        for (int i = gt; i < 8 * 128 * 128 / 2; i += GT) { const f32x2 v = *(const f32x2*)(a.sg_w_s + 2 * i); ((unsigned*)WSb)[i] = pk2(v.x, v.y); }
        float* LB = (float*)(ws + WS_LB);
        for (int i = gt; i < 2048; i += GT) { const float l0 = a.hg_lb[i], l1 = a.hg_lb[2048 + i], l2 = a.hg_lb[4096 + i]; const float mx = fmaxf(l0, fmaxf(l1, l2));
            const float e0 = expf(l0 - mx), e1 = expf(l1 - mx), e2 = expf(l2 - mx); LB[i] = e0 / (e0 + e1 + e2); }
        float* XR = (float*)(ws + WS_XR);
        for (int i = gt; i < M * D / 4; i += GT) {
            const int m = i >> 8, d0 = (i & 255) * 4, t = m & (T - 1), pr = t >> 6, pc = t & 63;
            f32x4 v = *(const f32x4*)(a.x + (size_t)i * 4);
#pragma unroll
            for (int j = 0; j < 4; ++j) { const int dd = d0 + j, q = dd & 511, jj = q & 255; const float p = (float)(dd < 512 ? pr : pc);
                const float fr = expf(-9.210340371976184f * (float)jj / 256.0f), ang = p * fr; v[j] += (q < 256) ? sinf(ang) : cosf(ang); }
            *(f32x4*)(XR + (size_t)i * 4) = v;
        }
    }
}

__device__ __forceinline__ void row_load_f32(const float* p, int lane, f32x4 (&x)[4]) {
#pragma unroll
    for (int j = 0; j < 4; ++j) x[j] = *(const f32x4*)(p + 4 * lane + 256 * j);
}
__device__ __forceinline__ void row_store_f32(float* p, int lane, const f32x4 (&x)[4]) {
#pragma unroll
    for (int j = 0; j < 4; ++j) *(f32x4*)(p + 4 * lane + 256 * j) = x[j];
}
__device__ __forceinline__ void row_load_bf16(const bf16* p, int lane, f32x4 (&x)[4]) {
#pragma unroll
    for (int j = 0; j < 4; ++j) { const u32x2 w = *(const u32x2*)(p + 4 * lane + 256 * j); x[j] = (f32x4){bflo(w.x), bfhi(w.x), bflo(w.y), bfhi(w.y)}; }
}
__device__ __forceinline__ void row_store_bf16(bf16* p, int lane, const f32x4 (&x)[4]) {
#pragma unroll
    for (int j = 0; j < 4; ++j) { u32x2 w; w.x = pk2(x[j][0], x[j][1]); w.y = pk2(x[j][2], x[j][3]); *(u32x2*)(p + 4 * lane + 256 * j) = w; }
}
__device__ __forceinline__ float row_rstd(const f32x4 (&x)[4]) {
    float s = 0.f;
#pragma unroll
    for (int j = 0; j < 4; ++j) s += (x[j][0] * x[j][0] + x[j][1] * x[j][1]) + (x[j][2] * x[j][2] + x[j][3] * x[j][3]);
    return rsqrtf(wave_sum(s) * (1.0f / D) + EPS);
}

__device__ __forceinline__ void phase_p0b(LAS unsigned char* lds, ArgsRef a, int G, int vcu) {
    unsigned char* ws = a.ws;
    const int tid = opaque_tid(), lane = tid & 63, wave = __builtin_amdgcn_readfirstlane(tid >> 6);
    const float* MODP = (const float*)(ws + WS_MODP); float* MOD = (float*)(ws + WS_MOD);
    LAS float* modl = (LAS float*)lds;
    for (int i = tid; i < 6144; i += 512) { const int v = i >> 11, n = i & 2047; float s = a.b_ada[n];
#pragma unroll
        for (int kc = 0; kc < 8; ++kc) s += MODP[((size_t)(0 * 8 + kc) * 3 + v) * 6144 + n];
        modl[i] = s; }
    for (int i = blockIdx.x * 512 + tid; i < 2 * 3 * 6144; i += G * 512) { const int l = i / 18432, v = (i / 6144) % 3, n = i % 6144; float s = a.b_ada[l * 6144 + n];
#pragma unroll
        for (int kc = 0; kc < 8; ++kc) s += MODP[((size_t)(l * 8 + kc) * 3 + v) * 6144 + n];
        MOD[i] = s; }
    __syncthreads();
    const float* XR = (const float*)(ws + WS_XR); bf16* H = (bf16*)(ws + WS_H);
    f32x4 nw[4]; row_load_f32(a.norm_w, lane, nw);
    for (int m = vcu * 8 + wave; m < MT; m += G * 8) {
        const float* src = m < M ? XR + (size_t)m * D : a.ctx + (size_t)(m - M) * D; const int v = m < M ? (m >> 13) : 2;
        f32x4 x[4]; row_load_f32(src, lane, x); const float rs = row_rstd(x);
#pragma unroll
        for (int j = 0; j < 4; ++j) { const f32x4 sh = *(const LAS f32x4*)(modl + v * 2048 + 4 * lane + 256 * j), sc = *(const LAS f32x4*)(modl + v * 2048 + 1024 + 4 * lane + 256 * j);
            x[j] = x[j] * rs * nw[j] * (sc + 1.0f) + sh; }
        row_store_bf16(H + (size_t)m * D, lane, x);
    }
}

__device__ __forceinline__ void phase_rowpass_a(LAS unsigned char* lds, ArgsRef a, int G, int vcu, int l) {
    unsigned char* ws = a.ws;
    const int tid = opaque_tid(), lane = tid & 63, wave = __builtin_amdgcn_readfirstlane(tid >> 6);
    LAS float* RT = (LAS float*)lds;
    const float* router = a.moe_router + (size_t)l * D * NE;
    for (int i = tid; i < D * NE; i += 512) RT[(i & 15) * 1024 + (i >> 4)] = router[i];
    __syncthreads();
    const float* MOD = (const float*)(ws + WS_MOD); float* XR = (float*)(ws + WS_XR); bf16* H = (bf16*)(ws + WS_H); const bf16* Y = (const bf16*)(ws + WS_Y); float* AFF = (float*)(ws + WS_AFF);
    f32x4 nw1[4], nw2[4]; row_load_f32(a.norm_w + (size_t)(l * 4 + 1) * D, lane, nw1); row_load_f32(a.norm_w + (size_t)(l * 4 + 2) * D, lane, nw2);
    for (int m = vcu * 8 + wave; m < M; m += G * 8) {
        const int b = m >> 13; const float* mod = MOD + (size_t)(l * 3 + b) * 6144;
        f32x4 y[4], x[4], g1[4], sh[4], sc[4];
        row_load_bf16(Y + (size_t)m * D, lane, y); row_load_f32(XR + (size_t)m * D, lane, x);
        row_load_f32(mod + 2 * D, lane, g1); row_load_f32(mod + 3 * D, lane, sh); row_load_f32(mod + 4 * D, lane, sc);
        const float r1 = row_rstd(y);
#pragma unroll
        for (int j = 0; j < 4; ++j) x[j] = x[j] + g1[j] * (y[j] * r1 * nw1[j]);
        row_store_f32(XR + (size_t)m * D, lane, x);
        const float r2 = row_rstd(x);
#pragma unroll
        for (int j = 0; j < 4; ++j) y[j] = x[j] * r2 * nw2[j] * (sc[j] + 1.0f) + sh[j];
        row_store_bf16(H + (size_t)m * D, lane, y);
        float mylg = -1e30f;
#pragma unroll 1
        for (int e = 0; e < 16; ++e) { float p = 0.f;
#pragma unroll
            for (int j = 0; j < 4; ++j) { const f32x4 r = *(const LAS f32x4*)(RT + e * 1024 + 4 * lane + 256 * j); p += (y[j][0] * r[0] + y[j][1] * r[1]) + (y[j][2] * r[2] + y[j][3] * r[3]); }
            p = wave_sum(p); if ((lane & 15) == e) mylg = p; }
        float mx = mylg;
#pragma unroll
        for (int o = 1; o < 16; o <<= 1) mx = fmaxf(mx, __shfl_xor(mx, o));
        const float mine = expf(mylg - mx); float se = mine;
#pragma unroll
        for (int o = 1; o < 16; o <<= 1) se += __shfl_xor(se, o);
        if (lane < 16) AFF[(size_t)m * 16 + lane] = mine / se;
    }
}

__device__ __forceinline__ int block_exscan(int v, LAS int* sbuf, int tid, int* tot) {
    const int lane = tid & 63, wave = tid >> 6; int inc = v;
#pragma unroll
    for (int o = 1; o < 64; o <<= 1) { const int n = __shfl_up(inc, o); if (lane >= o) inc += n; }
    __syncthreads();
    if (lane == 63) sbuf[wave] = inc;
    __syncthreads();
    int base = 0, t = 0;
#pragma unroll
    for (int w = 0; w < 8; ++w) { const int s = sbuf[w]; if (w < wave) base += s; t += s; }
    *tot = t;
    return base + inc - v;
}

__device__ __forceinline__ void phase_topk(LAS unsigned char* lds, ArgsRef a, int G) {
    unsigned char* ws = a.ws; const int tid = opaque_tid();
    const float* AFF = (const float*)(ws + WS_AFF); int* ROWMAP = (int*)(ws + WS_ROWMAP); float* GATE = (float*)(ws + WS_GATE); int* INV = (int*)(ws + WS_INV);
    LAS int* hist = (LAS int*)lds; LAS int* ctl = hist + 256; LAS int* sbuf = hist + 272;
    for (int pe = blockIdx.x; pe < NB * NE; pe += G) {
        const int e = pe >> 1, b = pe & 1;
        unsigned key[16];
#pragma unroll
        for (int i = 0; i < 16; ++i) key[i] = __float_as_uint(AFF[((size_t)b * T + tid * 16 + i) * 16 + e]);
        unsigned prefix = 0u, mask = 0u; int need = CAP;
        for (int pass = 0; pass < 4; ++pass) {
            const int shift = 24 - 8 * pass;
            __syncthreads();
            if (tid < 256) hist[tid] = 0;
            __syncthreads();
#pragma unroll
            for (int i = 0; i < 16; ++i) if ((key[i] & mask) == prefix) __hip_atomic_fetch_add(&hist[(key[i] >> shift) & 255u], 1, __ATOMIC_RELAXED, __HIP_MEMORY_SCOPE_WORKGROUP);
            __syncthreads();
            if (tid == 0) { int cum = 0, bin = 255; for (; bin > 0; --bin) { const int hcount = hist[bin]; if (cum + hcount >= need) break; cum += hcount; } ctl[0] = bin; ctl[1] = need - cum; }
            __syncthreads();
            prefix |= (unsigned)ctl[0] << shift; mask |= 255u << shift; need = ctl[1];
        }
        int neq = 0;
#pragma unroll
        for (int i = 0; i < 16; ++i) neq += (key[i] == prefix) ? 1 : 0;
        int tot; int eqb = block_exscan(neq, sbuf, tid, &tot);
        int nsel = 0; unsigned selm = 0u;
#pragma unroll
        for (int i = 0; i < 16; ++i) { bool s = key[i] > prefix; if (key[i] == prefix) { s = eqb < need; ++eqb; } if (s) { selm |= 1u << i; ++nsel; } }
        int slot = block_exscan(nsel, sbuf, tid, &tot);
#pragma unroll
        for (int i = 0; i < 16; ++i) { const int t = tid * 16 + i; const bool s = (selm >> i) & 1u;
            INV[((size_t)b * T + t) * 16 + e] = s ? slot : -1;
            if (s) { ROWMAP[(e * 2 + b) * CAP + slot] = b * T + t; GATE[(e * 2 + b) * CAP + slot] = __uint_as_float(key[i]); ++slot; } }
    }
}

__device__ __forceinline__ void phase_rowpass_b(ArgsRef a, int G, int vcu, int l) {
    unsigned char* ws = a.ws;
    const int tid = opaque_tid(), lane = tid & 63, wave = __builtin_amdgcn_readfirstlane(tid >> 6);
    const float* MOD = (const float*)(ws + WS_MOD); float* XR = (float*)(ws + WS_XR); bf16* H = (bf16*)(ws + WS_H); const bf16* YP = (const bf16*)(ws + WS_YP); const int* INV = (const int*)(ws + WS_INV);
    f32x4 nw3[4], nwn[4]; row_load_f32(a.norm_w + (size_t)(l * 4 + 3) * D, lane, nw3); row_load_f32(a.norm_w + (size_t)(4 + 0) * D, lane, nwn);
    for (int m = vcu * 8 + wave; m < M; m += G * 8) {
        const int b = m >> 13; const float* mod = MOD + (size_t)(l * 3 + b) * 6144;
        const int iv = INV[(size_t)m * 16 + (lane & 15)];
        f32x4 y[4];
#pragma unroll
        for (int j = 0; j < 4; ++j) y[j] = (f32x4){0.f, 0.f, 0.f, 0.f};
        for (int e = 0; e < 16; ++e) { const int slot = __shfl(iv, e);
            if (slot >= 0) { f32x4 t[4]; row_load_bf16(YP + (size_t)((e * 2 + b) * CAP + slot) * D, lane, t);
#pragma unroll
                for (int j = 0; j < 4; ++j) y[j] = y[j] + t[j]; } }
        f32x4 x[4], g2[4]; row_load_f32(XR + (size_t)m * D, lane, x); row_load_f32(mod + 5 * D, lane, g2);
        const float r = row_rstd(y);
#pragma unroll
        for (int j = 0; j < 4; ++j) x[j] = x[j] + g2[j] * (y[j] * r * nw3[j]);
        if (l == 0) {
            row_store_f32(XR + (size_t)m * D, lane, x);
            const float* mod1 = MOD + (size_t)(1 * 3 + b) * 6144; f32x4 sh[4], sc[4]; row_load_f32(mod1, lane, sh); row_load_f32(mod1 + D, lane, sc);
            const float r2 = row_rstd(x);
#pragma unroll
            for (int j = 0; j < 4; ++j) y[j] = x[j] * r2 * nwn[j] * (sc[j] + 1.0f) + sh[j];
            row_store_bf16(H + (size_t)m * D, lane, y);
        } else row_store_f32(a.out + (size_t)m * D, lane, x);
    }
}

__device__ __forceinline__ void phase_sgu_mix(LAS unsigned char* lds, ArgsRef a, int G) {
    unsigned char* ws = a.ws;
    const int tid = opaque_tid(), lane = tid & 63, w = __builtin_amdgcn_readfirstlane(tid >> 6), l15 = lane & 15, gq = lane >> 4;
    const bf16* Z = (const bf16*)(ws + WS_Z); const float* STATS = (const float*)(ws + WS_STATS); bf16* A2 = (bf16*)(ws + WS_A2); const bf16* WSb = (const bf16*)(ws + WS_WS);
    LAS float* ST = (LAS float*)lds; LAS unsigned char* vt = lds + 1024; constexpr int VS = 272;
    for (int it = blockIdx.x; it < 128 * 8; it += G) {
        const int n = it >> 3, g = it & 7; const size_t r0 = (size_t)n * 128;
        __syncthreads();
        if (tid < 128) { const float* sp = STATS + (r0 + tid) * 32; float s1 = 0.f, s2 = 0.f;
#pragma unroll
            for (int j = 0; j < 16; ++j) { s1 += sp[2 * j]; s2 += sp[2 * j + 1]; }
            const float mean = s1 * (1.0f / 1024.0f), var = fmaxf(s2 * (1.0f / 1024.0f) - mean * mean, 0.f);
            ST[2 * tid] = mean; ST[2 * tid + 1] = rsqrtf(var + EPS); }
        __syncthreads();
        {
            const int c0 = 2 * lane; const f32x2 lw = *(const f32x2*)(a.sg_ln_w + 128 * g + c0), lbv = *(const f32x2*)(a.sg_ln_b + 128 * g + c0);
            float v0[16], v1[16];
#pragma unroll
            for (int jj = 0; jj < 16; ++jj) { const int q = 16 * w + jj; const unsigned raw = *(const unsigned*)(Z + (r0 + q) * 2048 + 1024 + 128 * g + c0);
                const float mean = ST[2 * q], rs = ST[2 * q + 1];
                v0[jj] = (bflo(raw) - mean) * rs * lw.x + lbv.x; v1[jj] = (bfhi(raw) - mean) * rs * lw.y + lbv.y; }
#pragma unroll
            for (int hh = 0; hh < 2; ++hh) { u32x4 o;
                o.x = pk2(v0[8 * hh + 0], v0[8 * hh + 1]); o.y = pk2(v0[8 * hh + 2], v0[8 * hh + 3]); o.z = pk2(v0[8 * hh + 4], v0[8 * hh + 5]); o.w = pk2(v0[8 * hh + 6], v0[8 * hh + 7]);
                *(LAS u32x4*)(vt + c0 * VS + 32 * w + 16 * hh) = o;
                o.x = pk2(v1[8 * hh + 0], v1[8 * hh + 1]); o.y = pk2(v1[8 * hh + 2], v1[8 * hh + 3]); o.z = pk2(v1[8 * hh + 4], v1[8 * hh + 5]); o.w = pk2(v1[8 * hh + 6], v1[8 * hh + 7]);
                *(LAS u32x4*)(vt + (c0 + 1) * VS + 32 * w + 16 * hh) = o; }
        }
        __syncthreads();
        f32x4 acc[8];
#pragma unroll
        for (int ct = 0; ct < 8; ++ct) acc[ct] = (f32x4){0.f, 0.f, 0.f, 0.f};
#pragma unroll
        for (int ks = 0; ks < 4; ++ks) {
            const bf16x8 av = *(const bf16x8*)(WSb + ((size_t)(g * 128 + 16 * w + l15)) * 128 + 32 * ks + 8 * gq);
#pragma unroll
            for (int ct = 0; ct < 8; ++ct) { const bf16x8 bv = *(const LAS bf16x8*)(vt + (16 * ct + l15) * VS + (32 * ks + 8 * gq) * 2);
                acc[ct] = __builtin_amdgcn_mfma_f32_16x16x32_bf16(av, bv, acc[ct], 0, 0, 0); }
        }
#pragma unroll
        for (int r = 0; r < 4; ++r) { const int p = 16 * w + 4 * gq + r; const float bias = a.sg_b_s[g * 128 + p];
#pragma unroll
            for (int ct = 0; ct < 8; ++ct) { const int c = 128 * g + 16 * ct + l15; const float u = bflo((unsigned)Z[(r0 + p) * 2048 + c]);
                A2[(r0 + p) * D + c] = (bf16)(pk2(u * (acc[ct][r] + bias), 0.f) & 0xffffu); } }
    }
}

constexpr int N_LAUNCHES = MK_N_LAUNCHES;
__global__ void __launch_bounds__(512, 2) fwd_kernel(Args a_unused) {
    extern __shared__ __attribute__((aligned(16))) unsigned char lds_raw[];
    LAS unsigned char* lds = (LAS unsigned char*)lds_raw;
    const CAS Args* kp = (const CAS Args*)__builtin_amdgcn_kernarg_segment_ptr();
    {
        volatile LAS unsigned* MISC = (volatile LAS unsigned*)(lds + MISC_OFF);
        if (threadIdx.x < 64) MISC[threadIdx.x] = 0u;
        __syncthreads();
        if (N_LAUNCHES == 1) (void)xcd_barrier_post((unsigned*)(kp->ws + WS_CTL) + 1024, MISC + 8);
    }
#if defined(PHASE_MASK)
#define IN(k) ((((PHASE_MASK) >> (k)) & 1) && A.ph_lo <= (k) && (k) < A.ph_hi)
#elif defined(ONLY_PHASE)
#define IN(k) ((k) == ONLY_PHASE && A.ph_lo <= (k) && (k) < A.ph_hi)
#else
#define IN(k) (A.ph_lo <= (k) && (k) < A.ph_hi)
#endif
#define PHASE_BEGIN(k) { ArgsRef A = *launder_args(kp); if (IN(k)) { unsigned char* ws = A.ws; const int G = gridDim.x, bx = blockIdx.x; const int vcu = (G % 8 == 0) ? (bx % 8) * (G / 8) + bx / 8 : bx; (void)vcu; (void)ws;
#define PHASE_END(k) if (N_LAUNCHES == 1 && (k) + 1 < A.ph_hi) { XcdBarrier bar; bar.bar = (unsigned*)(ws + WS_CTL) + 1024; bar.x = xb_xcc_id(); bar.st = (volatile LAS unsigned*)(lds + MISC_OFF) + 8; xcd_barrier(bar); } } }
#define GLA_PTRS gla::Ptrs GP{(const bf16*)(ws + WS_V), (const bf16*)(ws + WS_KF), (const bf16*)(ws + WS_LFF), (const bf16*)(ws + WS_KB), (const bf16*)(ws + WS_LFB), (const bf16*)(ws + WS_Q), (const bf16*)(ws + WS_SG), \
                 (float*)(ws + WS_OF), (bf16*)(ws + WS_OG), A.hg_gnorm, (float*)(ws + WS_LST), (float*)(ws + WS_SENT), (float*)(ws + WS_LSTC), (float*)(ws + WS_DSUM)}

    PHASE_BEGIN(0) phase_p0a(lds, A, G, vcu); PHASE_END(0)
    PHASE_BEGIN(1) phase_p0b(lds, A, G, vcu); PHASE_END(1)
    PHASE_BEGIN(2)
        const float* LB = (const float*)(ws + WS_LB); LAS float* aux = (LAS float*)(lds + GEMM_AUX_OFF);
        for (int i = threadIdx.x; i < 2048; i += 512) aux[i] = LB[i];
        __syncthreads();
        pg8::Gemm g{(const bf16*)(ws + WS_H), (const bf16*)(ws + WS_WHIN), D, nullptr}; pg8::HinOrder S; S.init(G, bx);
        pg8::EpiHin E{ws};
        pg8::gemm_phase<pg8::EpiHin, pg8::HinOrder, false>(lds, g, S, E);
    PHASE_END(2)
    PHASE_BEGIN(3) GLA_PTRS; gla::pass_a(lds, GP, G); PHASE_END(3)
    PHASE_BEGIN(4) GLA_PTRS; gla::pass_b(GP, G); PHASE_END(4)
    PHASE_BEGIN(5) GLA_PTRS; gla::pass_c(lds, GP, G); PHASE_END(5)
    PHASE_BEGIN(6)
        pg8::Gemm g{(const bf16*)(ws + WS_OG), (const bf16*)(ws + WS_WHOUT), D, nullptr}; pg8::GridOrder S; S.init(64, 4, G, bx, 0);
        pg8::EpiBf16<0> E{(bf16*)(ws + WS_Y), D, nullptr};
        pg8::gemm_phase<pg8::EpiBf16<0>, pg8::GridOrder, false>(lds, g, S, E);
    PHASE_END(6)
#define MOE_PHASES(l, p0) \
    PHASE_BEGIN(p0) phase_rowpass_a(lds, A, G, vcu, l); PHASE_END(p0) \
    PHASE_BEGIN(p0 + 1) phase_topk(lds, A, G); PHASE_END(p0 + 1) \
    PHASE_BEGIN(p0 + 2)   \
        pg8::Gemm g{(const bf16*)(ws + WS_H), (const bf16*)(ws + WS_WGU) + (size_t)(l) * NE * 4096 * D, D, (const int*)(ws + WS_ROWMAP)}; pg8::GridOrder S; S.init(128, 16, G, bx, 16); \
        pg8::fill_row_table(lds, S, (const unsigned*)(ws + WS_ROWMAP)); \
        pg8::EpiGU E{(bf16*)(ws + WS_HID)}; \
        pg8::gemm_phase<pg8::EpiGU, pg8::GridOrder, true>(lds, g, S, E); \
    PHASE_END(p0 + 2) \
    PHASE_BEGIN(p0 + 3)   \
        pg8::Gemm g{(const bf16*)(ws + WS_HID), (const bf16*)(ws + WS_WD) + (size_t)(l) * NE * D * FF, FF, nullptr}; pg8::GridOrder S; S.init(128, 4, G, bx, 4); \
        pg8::fill_row_table(lds, S, (const unsigned*)(ws + WS_GATE)); \
        pg8::EpiDown E{(bf16*)(ws + WS_YP)}; \
        pg8::gemm_phase<pg8::EpiDown, pg8::GridOrder, false>(lds, g, S, E); \
    PHASE_END(p0 + 3) \
    PHASE_BEGIN(p0 + 4) phase_rowpass_b(A, G, vcu, l); PHASE_END(p0 + 4)

    MOE_PHASES(0, 7)
    PHASE_BEGIN(12)
        pg8::Gemm g{(const bf16*)(ws + WS_H), (const bf16*)(ws + WS_WSIN), D, nullptr}; pg8::GridOrder S; S.init(64, 8, G, bx, 0);
        pg8::EpiBf16<1> E{(bf16*)(ws + WS_Z), 2 * D, (float*)(ws + WS_STATS)};
        pg8::gemm_phase<pg8::EpiBf16<1>, pg8::GridOrder, false>(lds, g, S, E);
    PHASE_END(12)
    PHASE_BEGIN(13) phase_sgu_mix(lds, A, G); PHASE_END(13)
    PHASE_BEGIN(14)
        pg8::Gemm g{(const bf16*)(ws + WS_A2), (const bf16*)(ws + WS_WSOUT), D, nullptr}; pg8::GridOrder S; S.init(64, 4, G, bx, 0);
        pg8::EpiBf16<0> E{(bf16*)(ws + WS_Y), D, nullptr};
        pg8::gemm_phase<pg8::EpiBf16<0>, pg8::GridOrder, false>(lds, g, S, E);
    PHASE_END(14)
    MOE_PHASES(1, 15)
#undef IN
}

extern "C" void kernel_launch(void* const* d_in, const int* in_sizes, int n_in, void* d_out, int out_size, void* d_ws, size_t ws_size, hipStream_t stream) {
    static int grid = 0;
    if (grid == 0) {
        if (n_in != 21 || in_sizes[0] != M * D || out_size != M * D || ws_size < WS_END) {
            fprintf(stderr, "kernel_launch: unexpected problem (n_in %d, in0 %d, out %d, ws %zu; need ws >= %zu); nothing launched\n", n_in, n_in > 0 ? in_sizes[0] : -1, out_size, ws_size, (size_t)WS_END); grid = -1; return; }
        int dev = 0, cus = 0, per_cu = 0;
        if (hipGetDevice(&dev) != hipSuccess || hipDeviceGetAttribute(&cus, hipDeviceAttributeMultiprocessorCount, dev) != hipSuccess) { grid = -1; return; }
        if (hipFuncSetAttribute((const void*)fwd_kernel, hipFuncAttributeMaxDynamicSharedMemorySize, LDS_BYTES) != hipSuccess) { fprintf(stderr, "kernel_launch: hipFuncSetAttribute failed\n"); grid = -1; return; }
        if (hipOccupancyMaxActiveBlocksPerMultiprocessor(&per_cu, (const void*)fwd_kernel, 512, LDS_BYTES) != hipSuccess || per_cu < 1) { fprintf(stderr, "kernel_launch: occupancy query reports %d blocks per CU\n", per_cu); (void)hipGetLastError(); }
        grid = cus;
    }
    if (grid < 0) return;
    (void)hipMemsetAsync((char*)d_ws + WS_CTL, 0, CTL_ZERO_BYTES, stream);
    Args a{};
    const float** fp = (const float**)&a;
    for (int i = 0; i < 21; ++i) fp[i] = (const float*)d_in[i];
    a.out = (float*)d_out; a.ws = (unsigned char*)d_ws;
    if (N_LAUNCHES == 1) { a.ph_lo = 0; a.ph_hi = NPHASE; a.li = 0; hipLaunchKernelGGL(fwd_kernel, dim3(grid), dim3(512), LDS_BYTES, stream, a); }
    else for (int li = 0; li < NPHASE; ++li) { a.ph_lo = li; a.ph_hi = li + 1; a.li = li; hipLaunchKernelGGL(fwd_kernel, dim3(grid), dim3(512), LDS_BYTES, stream, a); }
}
```

```cpp
#include <hip/hip_runtime.h>
#include <cstdio>
#include <cstdint>

#ifndef MK_N_LAUNCHES
#define MK_N_LAUNCHES 1
#endif

#define LAS __attribute__((address_space(3)))
typedef unsigned short bf16;
typedef short bf16x8 __attribute__((ext_vector_type(8)));
typedef short s16x4 __attribute__((ext_vector_type(4)));
typedef float f32x4 __attribute__((ext_vector_type(4)));
typedef float f32x2 __attribute__((ext_vector_type(2)));
typedef unsigned u32x4 __attribute__((ext_vector_type(4)));
typedef unsigned u32x2 __attribute__((ext_vector_type(2)));
typedef __bf16 bf16x2_t __attribute__((ext_vector_type(2)));
typedef int v8i __attribute__((ext_vector_type(8)));
typedef int v4i __attribute__((ext_vector_type(4)));

constexpr int NB = 2, T = 8192, D = 1024, M = NB * T, CTX = 256, MC = NB * CTX, MT = M + MC;
constexpr int NH = 8, HD = 128, NE = 16, CAP = 1024, FF = 2048, NPAIR = NB * NE * CAP;
constexpr int SCT = 512, NSC = T / SCT;
constexpr float EPS = 1e-6f;
constexpr int NPHASE = 20;

constexpr size_t MiB = 1u << 20;
constexpr size_t WS_CTL = 0, CTL_ZERO_BYTES = 64 * 1024;
constexpr size_t WS_LB = 1 * MiB;
constexpr size_t WS_MOD = 1 * MiB + 64 * 1024;
constexpr size_t WS_MODP = 2 * MiB;
constexpr size_t WS_WS = 4 * MiB;
constexpr size_t WS_WHIN = 5 * MiB;
constexpr size_t WS_WHOUT = 15 * MiB;
constexpr size_t WS_WSIN = 17 * MiB;
constexpr size_t WS_WSOUT = 21 * MiB;
constexpr size_t WS_WGU = 24 * MiB;
constexpr size_t WS_WD = 280 * MiB;
constexpr size_t WS_XR = 408 * MiB;
constexpr size_t WS_H = 472 * MiB;
constexpr size_t WS_R1 = 505 * MiB;
constexpr size_t WS_V = WS_R1, WS_KF = WS_V + 33 * MiB, WS_LFF = WS_KF + 33 * MiB, WS_KB = WS_LFF + 33 * MiB, WS_LFB = WS_KB + 33 * MiB;
constexpr size_t WS_Q = WS_LFB + 33 * MiB, WS_SG = WS_Q + 32 * MiB;
constexpr size_t WS_HID = WS_R1, WS_YP = WS_R1 + 128 * MiB;
constexpr size_t WS_Z = WS_R1, WS_A2 = WS_R1 + 64 * MiB, WS_STATS = WS_R1 + 96 * MiB;
constexpr size_t WS_OG = 734 * MiB;
constexpr size_t WS_OF = 766 * MiB;
constexpr size_t WS_LST = 830 * MiB;
constexpr size_t WS_SENT = 862 * MiB;
constexpr size_t WS_LSTC = 932 * MiB;
constexpr size_t WS_DSUM = 896 * MiB;
constexpr size_t WS_Y = 897 * MiB;
constexpr size_t WS_AFF = 929 * MiB;
constexpr size_t WS_ROWMAP = 930 * MiB;
constexpr size_t WS_GATE = 930 * MiB + 512 * 1024;
constexpr size_t WS_INV = 931 * MiB;
constexpr size_t WS_DSUMC = 896 * MiB + 512 * 1024;
constexpr size_t WS_END = 940 * MiB;

constexpr int LDS_BYTES = 163840;
constexpr int GEMM_TAB_OFF = 131072;
constexpr int GEMM_AUX_OFF = 131072 + 8192;
constexpr int MISC_OFF = LDS_BYTES - 256;
constexpr int HALF_LDS = 81792;

__device__ __forceinline__ float bflo(unsigned u) { return __uint_as_float(u << 16); }
__device__ __forceinline__ float bfhi(unsigned u) { return __uint_as_float(u & 0xffff0000u); }
__device__ __forceinline__ unsigned pk2(float lo, float hi) { f32x2 v = {lo, hi}; bf16x2_t b = __builtin_convertvector(v, bf16x2_t); return __builtin_bit_cast(unsigned, b); }
__device__ __forceinline__ unsigned pk4_fp8(float a, float b, float c, float d) {
    a = __builtin_amdgcn_fmed3f(a, -448.f, 448.f); b = __builtin_amdgcn_fmed3f(b, -448.f, 448.f); c = __builtin_amdgcn_fmed3f(c, -448.f, 448.f); d = __builtin_amdgcn_fmed3f(d, -448.f, 448.f);
    unsigned w = 0u; w = __builtin_amdgcn_cvt_pk_fp8_f32(a, b, w, false); w = __builtin_amdgcn_cvt_pk_fp8_f32(c, d, w, true); return w;
}
#define DPP_ADD(v, ctrl) ((v) + __builtin_bit_cast(float, __builtin_amdgcn_update_dpp(0, __builtin_bit_cast(int, (v)), (ctrl), 0xF, 0xF, true)))
__device__ __forceinline__ float row16_sum(float v) {
    v = DPP_ADD(v, 0xB1); v = DPP_ADD(v, 0x4E); v = DPP_ADD(v, 0x141); v = DPP_ADD(v, 0x140);
    return v;
}
__device__ __forceinline__ float wave_sum(float v) {
    v = row16_sum(v);
    const float s0 = __builtin_bit_cast(float, __builtin_amdgcn_readlane(__builtin_bit_cast(int, v), 0)), s1 = __builtin_bit_cast(float, __builtin_amdgcn_readlane(__builtin_bit_cast(int, v), 16));
    const float s2 = __builtin_bit_cast(float, __builtin_amdgcn_readlane(__builtin_bit_cast(int, v), 32)), s3 = __builtin_bit_cast(float, __builtin_amdgcn_readlane(__builtin_bit_cast(int, v), 48));
    return (s0 + s1) + (s2 + s3);
}
__device__ __forceinline__ float sigmoidf_(float x) { return __builtin_amdgcn_rcpf(1.0f + __expf(-x)); }
__device__ __forceinline__ float siluf_(float x) { return x * __builtin_amdgcn_rcpf(1.0f + __expf(-x)); }
__device__ __forceinline__ float gelu_tanh(float x) { const float u = 0.7978845608028654f * (x + 0.044715f * x * x * x); return x * __builtin_amdgcn_rcpf(1.0f + __expf(-2.0f * u)); }
__device__ __forceinline__ int opaque_tid() { int t = threadIdx.x; asm volatile("" : "+v"(t)); return t; }
#define LDS_WAIT() asm volatile("s_waitcnt lgkmcnt(0)" ::: "memory")
#define VM_WAIT() asm volatile("s_waitcnt vmcnt(0)" ::: "memory")

#define XB_TMO      128
#define XB_XCNT(j)  (256  + 64 * (j))
#define XB_XSUB(j)  (1280 + 64 * (j))
#define XB_XGEN(j)  (2304 + 64 * (j))
#define XB_TOP      3328
#define XB_TOPGEN   3392
#define XCD_BAR_WORDS 3456
#define XB_SPIN_CAP (1u << 22)
__device__ __forceinline__ unsigned xb_ld(unsigned* p)              { return __hip_atomic_load(p, __ATOMIC_RELAXED, __HIP_MEMORY_SCOPE_AGENT); }
__device__ __forceinline__ unsigned xb_add(unsigned* p, unsigned v) { return __hip_atomic_fetch_add(p, v, __ATOMIC_RELAXED, __HIP_MEMORY_SCOPE_AGENT); }
__device__ __forceinline__ unsigned xb_xcc_id() { return (unsigned)__builtin_amdgcn_s_getreg((3 << 11) | 20) & 0xFu; }
#define XB_SPIN(cond, bar) do { unsigned _sp = 0; while (cond) { __builtin_amdgcn_s_sleep(1); \
    if ((++_sp & 255u) == 0u) { if (xb_ld(&(bar)[XB_TMO])) break; if (_sp > XB_SPIN_CAP) { atomicAdd(&(bar)[XB_TMO], 1u); break; } } } } while (0)
struct XcdBarrier { unsigned* bar; unsigned x; volatile LAS unsigned* st; };
__device__ __forceinline__ XcdBarrier xcd_barrier_post(unsigned* bar, volatile LAS unsigned* st) {
    XcdBarrier b; b.bar = bar; b.x = xb_xcc_id(); b.st = st;
    if (threadIdx.x == 0) (void)xb_add(&bar[XB_XCNT(b.x)], 1u);
    return b;
}
__device__ __forceinline__ void xcd_barrier_complete(unsigned* bar, unsigned x, unsigned& nloc, unsigned& nx) {
    const unsigned G = gridDim.x * gridDim.y * gridDim.z;
    unsigned sum, cnt, mine, sp = 0u;
    for (;;) {
        sum = 0u; cnt = 0u; mine = 0u;
#pragma unroll
        for (unsigned j = 0; j < 16; ++j) { const unsigned c = xb_ld(&bar[XB_XCNT(j)]); sum += c; cnt += (c > 0u) ? 1u : 0u; mine = (j == x) ? c : mine; }
        if (sum == G) break;
        __builtin_amdgcn_s_sleep(1);
        if ((++sp & 255u) == 0u) { if (xb_ld(&bar[XB_TMO])) break; if (sp > XB_SPIN_CAP) { atomicAdd(&bar[XB_TMO], 1u); break; } }
    }
    nloc = mine > 0u ? mine : 1u; nx = cnt > 0u ? cnt : 1u;
}
__device__ __forceinline__ void xcd_barrier(const XcdBarrier& b) {
    asm volatile("s_waitcnt vmcnt(0)" ::: "memory");
    __syncthreads();
    if (threadIdx.x == 0) {
        unsigned* bar = b.bar;
        __builtin_amdgcn_s_waitcnt(0);
        unsigned nloc = b.st[0], nx = b.st[1];
        if (nloc == 0u) { xcd_barrier_complete(bar, b.x, nloc, nx); b.st[0] = nloc; b.st[1] = nx; }
        const unsigned old = xb_add(&bar[XB_XSUB(b.x)], 1u);
        const unsigned gen = old / nloc;
        asm volatile("buffer_inv sc1" ::: "memory");
        if (old + 1u == (gen + 1u) * nloc) {
            __builtin_amdgcn_fence(__ATOMIC_RELEASE, "agent");
            asm volatile("s_waitcnt vmcnt(0)" ::: "memory");
            const unsigned og = xb_add(&bar[XB_TOP], 1u);
            const unsigned tg = og / nx;
            if (og + 1u == (tg + 1u) * nx) xb_add(&bar[XB_TOPGEN], 1u);
            else XB_SPIN(xb_ld(&bar[XB_TOPGEN]) == tg, bar);
            asm volatile("" ::: "memory");
            xb_add(&bar[XB_XGEN(b.x)], 1u);
            asm volatile("s_waitcnt vmcnt(0)" ::: "memory");
        } else {
            XB_SPIN(xb_ld(&bar[XB_XGEN(b.x)]) == gen, bar);
            asm volatile("s_waitcnt vmcnt(0)" ::: "memory");
        }
    }
    __syncthreads();
}

namespace pg8 {
constexpr int BM = 256, BK = 64, HALF = 128, HTB = HALF * BK * 2, STAGE_BYTES = 8 * HTB, NXCD = 8, WGM = 8;
__host__ __device__ __forceinline__ int lds_byte(int r, int c) { const int st = (r >> 4) * 2 + (c >> 5), rr = r & 15, cc = c & 31, ob = rr * 64 + cc * 2; return st * 1024 + (ob ^ (((ob >> 9) & 1) << 5)); }
__host__ __device__ __forceinline__ void stage_rc(int b, int& R, int& C) { const int st = b / 1024, sb = b % 1024, swz = sb ^ (((sb >> 9) & 1) << 5); R = (st >> 1) * 16 + swz / 64; C = (st & 1) * 32 + (swz % 64) / 2; }
__host__ __device__ __forceinline__ int perm32(int rho) { const int n = rho >> 4, i = rho & 15; return 8 * (i >> 2) + 4 * n + (i & 3); }

struct Unit { int pm, pn, bt; };
struct Gemm { const bf16* A; const bf16* Bt; int K; const int* rowmap; };

struct GridOrder {
    int nM, nN, nwg, G, c, bmul;
    __device__ void init(int nM_, int nN_, int G_, int c_, int bmul_) { nM = nM_; nN = nN_; nwg = nM * nN; G = G_; c = c_; bmul = bmul_; }
    __device__ __forceinline__ bool next(int i, Unit& u) const {
        const long L = (long)i * G + c; if (L >= nwg) return false;
        int wgid = (int)L; { const int q = nwg / NXCD, r = nwg % NXCD, xcd = wgid % NXCD, off = wgid / NXCD; wgid = (xcd < r ? xcd * (q + 1) : r * (q + 1) + (xcd - r) * q) + off; }
        const int nig = WGM * nN, gid = wgid / nig, fm = gid * WGM, gsz = (nM - fm) < WGM ? (nM - fm) : WGM;
        u.pm = fm + ((wgid % nig) % gsz); u.pn = (wgid % nig) / gsz; u.bt = bmul ? (u.pm >> 3) * bmul + u.pn : u.pn; return true;
    }
};
struct HinOrder {
    GridOrder g;
    __device__ void init(int G_, int c_) { g.init(64, 20, G_, c_, 0); }
    __device__ __forceinline__ bool next(int i, Unit& u) const {
        const long L = (long)i * g.G + g.c;
        if (L < 1280) return g.next(i, u);
        const int r = (int)L - 1280; if (r >= 24) return false;
        u.pm = 64 + r / 12; u.pn = r % 12; u.bt = u.pn; return true;
    }
};

__device__ __forceinline__ unsigned cvt_pk_bf16(float lo, float hi) { return pk2(lo, hi); }


template <class Epi, class Sched, bool GATHER, bool F8 = false, int KC = 0>
__device__ __forceinline__ void gemm_phase(LAS unsigned char* lds, const Gemm g, const Sched& S, const Epi& E) {
    const int tid = opaque_tid(), wid = __builtin_amdgcn_readfirstlane(tid >> 6), lane = tid & 63, wr = wid >> 2, wc = wid & 3, fr = lane & 15, fq = lane >> 4;
    const int K = KC ? KC : g.K, KB = F8 ? K : 2 * K  , ntr = KB / (BK * 2);
#ifdef DUPK
    const int nt = (GATHER && F8) ? 2 * ntr : ntr;
#define KWRAP(t_) ((t_) % ntr)
#else
    const int nt = ntr;
#define KWRAP(t_) (t_)
#endif
    int RA[2], CA[2]; unsigned voffB[2], voffA[2];
#pragma unroll
    for (int i = 0; i < 2; ++i) { int R, C; stage_rc(tid * 16 + i * 8192, R, C); RA[i] = R; CA[i] = C; const int Rb = (R & ~31) + perm32(R & 31); voffB[i] = (unsigned)(Rb * KB + C * 2); voffA[i] = (unsigned)(R * KB + C * 2); }
    const size_t kstep = (size_t)(BK * 2);
    const size_t hstep = (size_t)HALF * KB;
    const size_t tstep = 2 * hstep;
    const unsigned ldsw = (unsigned)wid * 1024u;
    const int aoff = lds_byte(wr * 64 + fr, fq * 8), boff = lds_byte(wc * 32 + fr, fq * 8);
    LAS int* tab = (LAS int*)(lds + GEMM_TAB_OFF);
#define PG8_SA(b, h) (((b) * 2 + (h)) * HTB)
#define PG8_SB(b, h) ((4 + (b) * 2 + (h)) * HTB)
#define PG8_STAGE_B(bufoff, gbase) do { _Pragma("unroll") for (int _i = 0; _i < 2; ++_i) \
        __builtin_amdgcn_global_load_lds((const unsigned*)((const char*)(gbase) + voffB[_i]), (LAS unsigned*)(lds + (bufoff) + ldsw + _i * 8192), 16, 0, 0); } while (0)
#define PG8_STAGE_A(bufoff, koff, nx, h) do { _Pragma("unroll") for (int _i = 0; _i < 2; ++_i) { \
        const char* _p = GATHER ? (const char*)g.A + (koff) + ((nx) ? o2[h][_i] : oAc[h][_i]) : ((nx) ? a2b : cAb) + (koff) + (h) * hstep + voffA[_i]; \
        __builtin_amdgcn_global_load_lds((const unsigned*)_p, (LAS unsigned*)(lds + (bufoff) + ldsw + _i * 8192), 16, 0, 0); } } while (0)
#define PG8_LDA(dst, b, h) do { _Pragma("unroll") for (int m = 0; m < 4; ++m) { const v4i lo_ = *(const LAS v4i*)(lds + PG8_SA(b, h) + aoff + m * 2048), hi_ = *(const LAS v4i*)(lds + PG8_SA(b, h) + aoff + m * 2048 + 1024); dst[m] = __builtin_shufflevector(lo_, hi_, 0, 1, 2, 3, 4, 5, 6, 7); } } while (0)
#define PG8_LDB(dst, b, h) do { _Pragma("unroll") for (int n = 0; n < 2; ++n) { const v4i lo_ = *(const LAS v4i*)(lds + PG8_SB(b, h) + boff + n * 2048), hi_ = *(const LAS v4i*)(lds + PG8_SB(b, h) + boff + n * 2048 + 1024); dst[n] = __builtin_shufflevector(lo_, hi_, 0, 1, 2, 3, 4, 5, 6, 7); } } while (0)
#define PG8_MMA(ai, bj, At, Bt) do { __builtin_amdgcn_s_setprio(1); _Pragma("unroll") for (int m = 0; m < 4; ++m) _Pragma("unroll") for (int n = 0; n < 2; ++n) { \
        if constexpr (F8) {   \
            asm volatile("v_mfma_scale_f32_16x16x128_f8f6f4 %0, %1, %2, %0, %3, %3 op_sel_hi:[0,0,0]" : "+v"(acc[ai][bj][m][n]) : "v"(Bt[n]), "v"(At[m]), "v"(one_scale));   \
        } else { \
            acc[ai][bj][m][n] = __builtin_amdgcn_mfma_f32_16x16x32_bf16(__builtin_bit_cast(bf16x8, __builtin_shufflevector(Bt[n], Bt[n], 0, 1, 2, 3)), __builtin_bit_cast(bf16x8, __builtin_shufflevector(At[m], At[m], 0, 1, 2, 3)), acc[ai][bj][m][n], 0, 0, 0); \
            acc[ai][bj][m][n] = __builtin_amdgcn_mfma_f32_16x16x32_bf16(__builtin_bit_cast(bf16x8, __builtin_shufflevector(Bt[n], Bt[n], 4, 5, 6, 7)), __builtin_bit_cast(bf16x8, __builtin_shufflevector(At[m], At[m], 4, 5, 6, 7)), acc[ai][bj][m][n], 0, 0, 0); } } \
        __builtin_amdgcn_s_setprio(0); } while (0)
#define PG8_WAIT_V(n) asm volatile("s_waitcnt vmcnt(" #n ")" ::: "memory")
#define PG8_WAIT_L(n) asm volatile("s_waitcnt lgkmcnt(" #n ")" ::: "memory")
#define PG8_BAR __builtin_amdgcn_s_barrier()
#define PG8_SCHED __builtin_amdgcn_sched_barrier(0)
#define PG8_AOFFS(o, ui) do { _Pragma("unroll") for (int _h = 0; _h < 2; ++_h) _Pragma("unroll") for (int _i = 0; _i < 2; ++_i) { \
        const int _row = tab[(ui) * 256 + _h * HALF + RA[_i]]; (o)[_h][_i] = (unsigned)(_row * KB + CA[_i] * 2); } } while (0)
    Unit cur, nxt; int ui = 0;
    if (!S.next(0, cur)) return;
    int one_scale = 0x7f7f7f7f; asm volatile("" : "+v"(one_scale));
    f32x4 acc[2][2][4][2];
#pragma unroll
    for (int a = 0; a < 2; ++a)
#pragma unroll
        for (int b = 0; b < 2; ++b)
#pragma unroll
            for (int m = 0; m < 4; ++m)
#pragma unroll
                for (int n = 0; n < 2; ++n) acc[a][b][m][n] = (f32x4){0.f, 0.f, 0.f, 0.f};
    v8i At[4], B0[2], B1[2];
    unsigned oAc[2][2], oAn[2][2], o2[2][2];
#pragma unroll
    for (int h = 0; h < 2; ++h)
#pragma unroll
        for (int i = 0; i < 2; ++i) { oAc[h][i] = 0u; oAn[h][i] = 0u; o2[h][i] = 0u; }
    if (GATHER) { PG8_AOFFS(oAc, 0); }
    const char* cAb = (const char*)g.A + (size_t)cur.pm * tstep; const char* a2b = cAb;
    const char* cB = (const char*)g.Bt + (size_t)cur.bt * tstep;
    PG8_STAGE_B(PG8_SB(0, 0), cB); PG8_STAGE_B(PG8_SB(0, 1), cB + hstep); PG8_STAGE_A(PG8_SA(0, 0), 0, 0, 0); PG8_STAGE_A(PG8_SA(0, 1), 0, 0, 1);
    if (wr == 1) PG8_BAR;
    PG8_WAIT_V(2); PG8_BAR;
    PG8_STAGE_B(PG8_SB(1, 0), cB + kstep); PG8_STAGE_A(PG8_SA(1, 0), kstep, 0, 0); PG8_STAGE_B(PG8_SB(1, 1), cB + hstep + kstep);
    PG8_WAIT_V(6); PG8_BAR;
    for (;;) {
        const bool has_next = S.next(ui + 1, nxt);
        if (GATHER) {
            if (has_next) { PG8_AOFFS(oAn, ui + 1); }
            else {
#pragma unroll
                for (int h = 0; h < 2; ++h)
#pragma unroll
                    for (int i = 0; i < 2; ++i) oAn[h][i] = oAc[h][i];
            }
        }
        const char* nAb = has_next ? (const char*)g.A + (size_t)nxt.pm * tstep : cAb;
        const char* nB = has_next ? (const char*)g.Bt + (size_t)nxt.bt * tstep : cB;
#pragma unroll 1
        for (int t = 0; t < nt; t += 2) {
            const bool last = (t == nt - 2);
            const size_t k1 = (size_t)KWRAP(t + 1) * kstep;
            const size_t k2 = last ? 0 : (size_t)KWRAP(t + 2) * kstep, k3 = k2 + kstep;
            if (GATHER) {
#pragma unroll
                for (int h = 0; h < 2; ++h)
#pragma unroll
                    for (int i = 0; i < 2; ++i) o2[h][i] = last ? oAn[h][i] : oAc[h][i];
            }
            a2b = last ? nAb : cAb;
            const char* b2 = last ? nB : cB + (size_t)KWRAP(t + 2) * kstep; const char* b3 = b2 + kstep;
            PG8_LDB(B0, 0, 0); PG8_LDB(B1, 0, 1); PG8_SCHED; PG8_LDA(At, 0, 0); PG8_STAGE_A(PG8_SA(1, 1), k1, 0, 1);
            PG8_WAIT_V(8); PG8_WAIT_L(0); PG8_BAR; PG8_MMA(0, 0, At, B0); PG8_MMA(0, 1, At, B1); PG8_BAR; PG8_SCHED;
            PG8_LDA(At, 0, 1); PG8_STAGE_B(PG8_SB(0, 0), b2); PG8_STAGE_B(PG8_SB(0, 1), b2 + hstep); PG8_STAGE_A(PG8_SA(0, 0), k2, 1, 0);
            PG8_WAIT_V(8); PG8_WAIT_L(0); PG8_BAR; PG8_MMA(1, 0, At, B0); PG8_MMA(1, 1, At, B1); PG8_BAR; PG8_SCHED;
            PG8_LDB(B0, 1, 0); PG8_LDB(B1, 1, 1); PG8_SCHED; PG8_LDA(At, 1, 0); PG8_STAGE_A(PG8_SA(0, 1), k2, 1, 1);
            PG8_WAIT_V(8); PG8_WAIT_L(0); PG8_BAR; PG8_MMA(0, 0, At, B0); PG8_MMA(0, 1, At, B1); PG8_BAR; PG8_SCHED;
            PG8_LDA(At, 1, 1); PG8_STAGE_B(PG8_SB(1, 0), b3); PG8_STAGE_B(PG8_SB(1, 1), b3 + hstep); PG8_STAGE_A(PG8_SA(1, 0), k3, 1, 0);
            PG8_WAIT_V(8); PG8_WAIT_L(0); PG8_BAR; PG8_MMA(1, 0, At, B0); PG8_MMA(1, 1, At, B1); PG8_BAR; PG8_SCHED;
        }
        if (wr == 0) PG8_BAR;
        if constexpr (F8) asm volatile("s_nop 15\n\ts_nop 15" ::: "memory");
        E(acc, cur, ui, wr, wc, fr, fq, lds);
        if (!has_next) break;
#pragma unroll
        for (int a = 0; a < 2; ++a)
#pragma unroll
            for (int b = 0; b < 2; ++b)
#pragma unroll
                for (int m = 0; m < 4; ++m)
#pragma unroll
                    for (int n = 0; n < 2; ++n) acc[a][b][m][n] = (f32x4){0.f, 0.f, 0.f, 0.f};
        cur = nxt; cB = nB; cAb = nAb; ++ui;
        if (GATHER) {
#pragma unroll
            for (int h = 0; h < 2; ++h)
#pragma unroll
                for (int i = 0; i < 2; ++i) oAc[h][i] = oAn[h][i];
        }
        if (wr == 1) PG8_BAR;
    }
    PG8_WAIT_V(0);
    PG8_BAR;
#undef PG8_SA
#undef PG8_SB
#undef PG8_STAGE_A
#undef PG8_STAGE_B
#undef PG8_LDA
#undef PG8_LDB
#undef PG8_MMA
#undef PG8_WAIT_V
#undef PG8_WAIT_L
#undef PG8_BAR
#undef PG8_SCHED
#undef PG8_AOFFS
}

#define EPI_ROWS_BEGIN(u) \
    _Pragma("unroll") for (int ai = 0; ai < 2; ++ai) _Pragma("unroll") for (int m = 0; m < 4; ++m) { const int row = (u).pm * BM + ai * HALF + wr * 64 + m * 16 + fr; const int rloc = ai * HALF + wr * 64 + m * 16 + fr; (void)rloc; (void)row;
#define EPI_ROWS_END }

struct EpiHin {
    unsigned char* ws;
    __device__ __forceinline__ void operator()(const f32x4 (&acc)[2][2][4][2], const Unit& u, int ui, int wr, int wc, int fr, int fq, LAS unsigned char* lds) const {
        const int region = u.pn >> 2, cc0 = (u.pn & 3) * 256 + wc * 32 + 8 * fq;
        const LAS float* lbt = (const LAS float*)(lds + GEMM_AUX_OFF);
        if (region == 0 || region >= 3) {
            bf16* O = (bf16*)(ws + (region == 0 ? WS_V : (region == 3 ? WS_Q : WS_SG)));
            EPI_ROWS_BEGIN(u)
                bf16* rowp = O + (size_t)row * D + cc0;
#pragma unroll
                for (int bj = 0; bj < 2; ++bj) { f32x4 v0 = acc[ai][bj][m][0], v1 = acc[ai][bj][m][1];
                    if (region != 0) {
#pragma unroll
                        for (int j = 0; j < 4; ++j) { v0[j] = siluf_(v0[j]); v1[j] = siluf_(v1[j]); } }
                    u32x4 w; w.x = pk2(v0[0], v0[1]); w.y = pk2(v0[2], v0[3]); w.z = pk2(v1[0], v1[1]); w.w = pk2(v1[2], v1[3]);
                    *(u32x4*)(rowp + bj * HALF) = w; }
            EPI_ROWS_END
        } else {
            bf16* OL = (bf16*)(ws + (region == 1 ? WS_LFF : WS_LFB));
            EPI_ROWS_BEGIN(u)
                const size_t ro = (size_t)row * D + cc0;
#pragma unroll
                for (int bj = 0; bj < 2; ++bj) {
                    const f32x4 l0 = *(const LAS f32x4*)(lbt + (region - 1) * 1024 + cc0 + bj * HALF), l1 = *(const LAS f32x4*)(lbt + (region - 1) * 1024 + cc0 + bj * HALF + 4);
                    f32x4 f0, f1;
#pragma unroll
                    for (int j = 0; j < 4; ++j) {
                        { const float a = acc[ai][bj][m][0][j], l = l0[j], sg = __builtin_amdgcn_rcpf(1.0f + __expf(-a)); f0[j] = __builtin_amdgcn_logf(l + (1.0f - l) * sg); }
                        { const float a = acc[ai][bj][m][1][j], l = l1[j], sg = __builtin_amdgcn_rcpf(1.0f + __expf(-a)); f1[j] = __builtin_amdgcn_logf(l + (1.0f - l) * sg); }
                    }
                    u32x4 w; w.x = pk2(f0[0], f0[1]); w.y = pk2(f0[2], f0[3]); w.z = pk2(f1[0], f1[1]); w.w = pk2(f1[2], f1[3]);
                    *(u32x4*)(OL + ro + bj * HALF) = w; }
            EPI_ROWS_END
        }
    }
};
template <int ACT> struct EpiBf16 {
    bf16* O; int ldc; float* stats; float scale;
    __device__ __forceinline__ void operator()(const f32x4 (&acc)[2][2][4][2], const Unit& u, int ui, int wr, int wc, int fr, int fq, LAS unsigned char* lds) const {
        const int col0 = u.pn * BM + wc * 32 + 8 * fq;
        EPI_ROWS_BEGIN(u)
            bf16* rowp = O + (size_t)row * ldc + col0; float s1 = 0.f, s2 = 0.f;
#pragma unroll
            for (int bj = 0; bj < 2; ++bj) { f32x4 v0 = acc[ai][bj][m][0] * scale, v1 = acc[ai][bj][m][1] * scale;
                if (ACT == 1) {
#pragma unroll
                    for (int j = 0; j < 4; ++j) { v0[j] = gelu_tanh(v0[j]); v1[j] = gelu_tanh(v1[j]); s1 += v0[j] + v1[j]; s2 += v0[j] * v0[j] + v1[j] * v1[j]; } }
                u32x4 w; w.x = pk2(v0[0], v0[1]); w.y = pk2(v0[2], v0[3]); w.z = pk2(v1[0], v1[1]); w.w = pk2(v1[2], v1[3]);
                *(u32x4*)(rowp + bj * HALF) = w; }
            if (ACT == 1) { s1 += __shfl_xor(s1, 16); s1 += __shfl_xor(s1, 32); s2 += __shfl_xor(s2, 16); s2 += __shfl_xor(s2, 32);
                if (u.pn >= 4 && fq == 0) *(f32x2*)(stats + ((size_t)row * 16 + (u.pn - 4) * 4 + wc) * 2) = (f32x2){s1, s2}; }
        EPI_ROWS_END
    }
};
struct EpiGU {
    bf16* Hd;
    __device__ __forceinline__ void operator()(const f32x4 (&acc)[2][2][4][2], const Unit& u, int ui, int wr, int wc, int fr, int fq, LAS unsigned char* lds) const {
        const int col0 = u.pn * HALF + wc * 32 + 8 * fq;
        EPI_ROWS_BEGIN(u)
            f32x4 g0 = acc[ai][0][m][0], g1 = acc[ai][0][m][1], u0 = acc[ai][1][m][0], u1 = acc[ai][1][m][1];
#pragma unroll
            for (int j = 0; j < 4; ++j) { g0[j] = siluf_(g0[j]) * u0[j]; g1[j] = siluf_(g1[j]) * u1[j]; }
            u32x4 w; w.x = pk2(g0[0], g0[1]); w.y = pk2(g0[2], g0[3]); w.z = pk2(g1[0], g1[1]); w.w = pk2(g1[2], g1[3]);
            *(u32x4*)(Hd + (size_t)row * FF + col0) = w;
        EPI_ROWS_END
    }
};
struct EpiGU8 {
    unsigned char* Hd;
    __device__ __forceinline__ void operator()(const f32x4 (&acc)[2][2][4][2], const Unit& u, int ui, int wr, int wc, int fr, int fq, LAS unsigned char* lds) const {
        const int col0 = u.pn * HALF + wc * 32 + 8 * fq;
        EPI_ROWS_BEGIN(u)
#ifdef DUPK
            constexpr float GS = 0.015625f;
#else
            constexpr float GS = 0.03125f;
#endif
            f32x4 g0 = acc[ai][0][m][0] * GS, g1 = acc[ai][0][m][1] * GS, u0 = acc[ai][1][m][0] * GS, u1 = acc[ai][1][m][1] * GS;
#pragma unroll
            for (int j = 0; j < 4; ++j) { g0[j] = siluf_(g0[j]) * u0[j]; g1[j] = siluf_(g1[j]) * u1[j]; }
            u32x2 w; w.x = pk4_fp8(g0[0], g0[1], g0[2], g0[3]); w.y = pk4_fp8(g1[0], g1[1], g1[2], g1[3]);
            *(u32x2*)(Hd + (size_t)row * FF + col0) = w;
        EPI_ROWS_END
    }
};
struct EpiDown {
    bf16* Yp; float scale;
    __device__ __forceinline__ void operator()(const f32x4 (&acc)[2][2][4][2], const Unit& u, int ui, int wr, int wc, int fr, int fq, LAS unsigned char* lds) const {
        const int col0 = u.pn * BM + wc * 32 + 8 * fq;
        const LAS float* gt = (const LAS float*)(lds + GEMM_TAB_OFF) + ui * 256;
        EPI_ROWS_BEGIN(u)
            const float gv = gt[rloc] * scale * 16.0f; unsigned char* rowp = (unsigned char*)Yp + (size_t)row * D + col0;
#pragma unroll
            for (int bj = 0; bj < 2; ++bj) { const f32x4 v0 = acc[ai][bj][m][0] * gv, v1 = acc[ai][bj][m][1] * gv;
                u32x2 w; w.x = pk4_fp8(v0[0], v0[1], v0[2], v0[3]); w.y = pk4_fp8(v1[0], v1[1], v1[2], v1[3]);
                *(u32x2*)(rowp + bj * HALF) = w; }
        EPI_ROWS_END
    }
};
template <class Sched> __device__ __forceinline__ void fill_row_table(LAS unsigned char* lds, const Sched& S, const unsigned* src) {
    LAS unsigned* tab = (LAS unsigned*)(lds + GEMM_TAB_OFF); Unit u;
    for (int i = 0; i < 8 && S.next(i, u); ++i) if (threadIdx.x < 256) tab[i * 256 + threadIdx.x] = src[u.pm * 256 + threadIdx.x];
    VM_WAIT(); LDS_WAIT(); __syncthreads();
}
}

namespace gla {
__device__ __forceinline__ float ex2(float x) { return __builtin_amdgcn_exp2f(x); }
constexpr int QX_OFF = 0, KE_OFF = 17408, KST_OFF = 34816, VT_OFF = 53248, TOT_OFF = 71680, DG_OFF = 73728, OD_OFF = 75776, DEC_OFF = 77312, SSQ_OFF = 77824;
constexpr int QSTR = 272, PSTR = 144, TSTR = 144;
static_assert(SSQ_OFF + 1024 <= HALF_LDS, "gla LDS map");

__device__ __forceinline__ bf16x8 scale8(bf16x8 a, f32x4 f0, f32x4 f1) {
    u32x4 w = __builtin_bit_cast(u32x4, a);
    w.x = pk2(bflo(w.x) * f0[0], bfhi(w.x) * f0[1]); w.y = pk2(bflo(w.y) * f0[2], bfhi(w.y) * f0[3]);
    w.z = pk2(bflo(w.z) * f1[0], bfhi(w.z) * f1[1]); w.w = pk2(bflo(w.w) * f1[2], bfhi(w.w) * f1[3]);
    return __builtin_bit_cast(bf16x8, w);
}

__device__ __forceinline__ void half_barrier(volatile LAS unsigned* cnt, unsigned& gen, int lane) {
    asm volatile("s_waitcnt lgkmcnt(0)" ::: "memory");
    gen += 4u;
    if (lane == 0) {
        __hip_atomic_fetch_add((LAS unsigned*)cnt, 1u, __ATOMIC_RELAXED, __HIP_MEMORY_SCOPE_WORKGROUP);
        while (__hip_atomic_load((LAS unsigned*)cnt, __ATOMIC_RELAXED, __HIP_MEMORY_SCOPE_WORKGROUP) < gen) __builtin_amdgcn_s_sleep(1);
    }
    asm volatile("" ::: "memory");
}
template <bool OUT>
__device__ __forceinline__ void step(LAS unsigned char* hl, int hw, int lane_in, const bf16* Kp, const bf16* LFp, const bf16* Vp, const bf16* Qp, const bf16* SGp,
                                     long row0, int rstep, int hc, f32x4 (&Sacc)[8][2], float& dsum0, float& dsum1, volatile LAS unsigned* hbc, unsigned& hgen, bf16* OFd) {
    int lane = lane_in; asm volatile("" : "+v"(lane));
    const int J = hw, c0 = 2 * lane, l15 = lane & 15, g = lane >> 4;
    unsigned lraw[16], vraw[16], qraw[16];
#pragma unroll
    for (int jj = 0; jj < 16; ++jj) { const unsigned off = ((unsigned)((int)row0 + rstep * (16 * J + jj)) * (unsigned)D + (unsigned)(hc + c0)) * 2u;
        lraw[jj] = *(const unsigned*)((const char*)LFp + off); vraw[jj] = *(const unsigned*)((const char*)Vp + off);
        if (OUT) qraw[jj] = *(const unsigned*)((const char*)Qp + off); else qraw[jj] = 0u; }
    float a0 = 0.f, a1 = 0.f;
#pragma unroll
    for (int jj = 0; jj < 16; ++jj) { a0 += bflo(lraw[jj]); a1 += bfhi(lraw[jj]); }
    LAS float* TOT = (LAS float*)(hl + TOT_OFF);
    *(LAS f32x2*)(TOT + J * 128 + c0) = (f32x2){a0, a1};
    half_barrier(hbc, hgen, lane);
    float t0[4], t1[4];
#pragma unroll
    for (int I = 0; I < 4; ++I) { const f32x2 t = *(const LAS f32x2*)(TOT + I * 128 + c0); t0[I] = t.x; t1[I] = t.y; }
    float RJ0 = 0.f, RJ1 = 0.f, RA0 = 0.f, RA1 = 0.f;
#pragma unroll
    for (int I = 0; I < 4; ++I) { if (I < J) { RJ0 += t0[I]; RJ1 += t1[I]; } if (I > J) { RA0 += t0[I]; RA1 += t1[I]; } }
    const float R40 = (t0[0] + t0[1]) + (t0[2] + t0[3]), R41 = (t1[0] + t1[1]) + (t1[2] + t1[3]);
    {
        LAS float* DG = (LAS float*)(hl + DG_OFF); LAS float* OD = (LAS float*)(hl + OD_OFF); LAS float* DEC = (LAS float*)(hl + DEC_OFF);
        *(LAS f32x2*)(DG + J * 128 + c0) = (f32x2){ex2(fminf(-a0, 115.f)), ex2(fminf(-a1, 115.f))};
        if (J == 0) { *(LAS f32x2*)(DEC + c0) = (f32x2){ex2(R40), ex2(R41)}; dsum0 += R40; dsum1 += R41; }
        else if (J == 1) *(LAS f32x2*)(OD + 0 * 128 + c0) = (f32x2){ex2(t0[1]), ex2(t1[1])};
        else if (J == 2) *(LAS f32x2*)(OD + 1 * 128 + c0) = (f32x2){ex2(t0[2]), ex2(t1[2])};
        else *(LAS f32x2*)(OD + 2 * 128 + c0) = (f32x2){ex2(t0[1] + t0[2]), ex2(t1[1] + t1[2])};
    }
    const float eR0 = ex2(RJ0), eR1 = ex2(RJ1), eA0 = ex2(RA0), eA1 = ex2(RA1);
    unsigned qs[16];
    {
        float fk0[16], fk1[16];
        float su0 = 1.0f, su1 = 1.0f;
#pragma unroll
        for (int hh = 1; hh >= 0; --hh) {
            float ks0[8], ks1[8];
#pragma unroll
            for (int j8 = 7; j8 >= 0; --j8) {
                const int jj = 8 * hh + j8, i = 16 * J + jj;
                const float f0 = ex2(bflo(lraw[jj])), f1 = ex2(bfhi(lraw[jj]));
                const float ke0 = (1.0f - f0) * su0, ke1 = (1.0f - f1) * su1;
                ks0[j8] = ke0 * eA0; ks1[j8] = ke1 * eA1;
                if (OUT) { *(LAS unsigned*)(hl + KE_OFF + i * QSTR + c0 * 2) = pk2(ke0, ke1); fk0[jj] = f0; fk1[jj] = f1; }
                su0 *= f0; su1 *= f1;
            }
            u32x4 w;
            w.x = pk2(ks0[0], ks0[1]); w.y = pk2(ks0[2], ks0[3]); w.z = pk2(ks0[4], ks0[5]); w.w = pk2(ks0[6], ks0[7]);
            *(LAS u32x4*)(hl + KST_OFF + c0 * TSTR + 32 * J + 16 * hh) = w;
            w.x = pk2(ks1[0], ks1[1]); w.y = pk2(ks1[2], ks1[3]); w.z = pk2(ks1[4], ks1[5]); w.w = pk2(ks1[6], ks1[7]);
            *(LAS u32x4*)(hl + KST_OFF + (c0 + 1) * TSTR + 32 * J + 16 * hh) = w;
#define VLO(a, b) ((vraw[a] & 0xffffu) | (vraw[b] << 16))
#define VHI(a, b) ((vraw[a] >> 16) | (vraw[b] & 0xffff0000u))
            w.x = VLO(8 * hh + 0, 8 * hh + 1); w.y = VLO(8 * hh + 2, 8 * hh + 3); w.z = VLO(8 * hh + 4, 8 * hh + 5); w.w = VLO(8 * hh + 6, 8 * hh + 7);
            *(LAS u32x4*)(hl + VT_OFF + c0 * TSTR + 32 * J + 16 * hh) = w;
            w.x = VHI(8 * hh + 0, 8 * hh + 1); w.y = VHI(8 * hh + 2, 8 * hh + 3); w.z = VHI(8 * hh + 4, 8 * hh + 5); w.w = VHI(8 * hh + 6, 8 * hh + 7);
            *(LAS u32x4*)(hl + VT_OFF + (c0 + 1) * TSTR + 32 * J + 16 * hh) = w;
#undef VLO
#undef VHI
        }
        if (OUT) {
            float pr0 = 1.0f, pr1 = 1.0f;
#pragma unroll
            for (int jj = 0; jj < 16; ++jj) {
                pr0 *= fk0[jj]; pr1 *= fk1[jj];
                const float qt0 = bflo(qraw[jj]) * pr0, qt1 = bfhi(qraw[jj]) * pr1;
                *(LAS unsigned*)(hl + QX_OFF + (16 * J + jj) * QSTR + c0 * 2) = pk2(qt0, qt1);
                qs[jj] = pk2(qt0 * eR0, qt1 * eR1);
            }
        } else {
#pragma unroll
            for (int jj = 0; jj < 16; ++jj) qs[jj] = 0u;
        }
    }
    half_barrier(hbc, hgen, lane);
    f32x4 o[4][2];
    if (OUT) {
        const int I = hw;
        f32x4 sc[4];
#pragma unroll
        for (int Jp = 0; Jp < 4; ++Jp) {
            sc[Jp] = (f32x4){0.f, 0.f, 0.f, 0.f};
            if (Jp <= I) {
                const LAS float* ft = (Jp == I) ? (const LAS float*)(hl + DG_OFF) + I * 128
                                    : ((I - Jp == 2) ? (const LAS float*)(hl + OD_OFF) + (I - 2) * 128 : (const LAS float*)(hl + OD_OFF) + 2 * 128);
                const bool needf = (Jp != I - 1);
                f32x4 acc = (f32x4){0.f, 0.f, 0.f, 0.f};
#pragma unroll
                for (int ks = 0; ks < 4; ++ks) {
                    bf16x8 a = *(const LAS bf16x8*)(hl + QX_OFF + (16 * I + l15) * QSTR + (32 * ks + 8 * g) * 2);
                    if (needf) { const f32x4 f0 = *(const LAS f32x4*)(ft + 32 * ks + 8 * g), f1 = *(const LAS f32x4*)(ft + 32 * ks + 8 * g + 4); a = scale8(a, f0, f1); }
                    const bf16x8 b = *(const LAS bf16x8*)(hl + KE_OFF + (16 * Jp + l15) * QSTR + (32 * ks + 8 * g) * 2);
                    acc = __builtin_amdgcn_mfma_f32_16x16x32_bf16(a, b, acc, 0, 0, 0);
                }
                if (Jp == I) {
#pragma unroll
                    for (int r = 0; r < 4; ++r) if (l15 > 4 * g + r) acc[r] = 0.f;
                }
                sc[Jp] = acc;
            }
        }
        half_barrier(hbc, hgen, lane);
#pragma unroll
        for (int Jp = 0; Jp < 4; ++Jp) {
            const bool wr_blk = (Jp <= I) || (I == 0 && Jp == 1) || (I == 2 && Jp == 3);
            if (wr_blk) {
#pragma unroll
                for (int r = 0; r < 4; ++r) *(LAS unsigned short*)(hl + KE_OFF + (16 * I + 4 * g + r) * PSTR + (16 * Jp + l15) * 2) = (unsigned short)(pk2(sc[Jp][r], 0.f) & 0xffffu);
            }
        }
#pragma unroll
        for (int jj = 0; jj < 16; ++jj) *(LAS unsigned*)(hl + QX_OFF + (16 * J + jj) * QSTR + c0 * 2) = qs[jj];
        half_barrier(hbc, hgen, lane);
    }
    bf16x8 vb[2][2];
#pragma unroll
    for (int ct = 0; ct < 2; ++ct)
#pragma unroll
        for (int js = 0; js < 2; ++js) vb[ct][js] = *(const LAS bf16x8*)(hl + VT_OFF + (32 * hw + 16 * ct + l15) * TSTR + (32 * js + 8 * g) * 2);
    if (OUT) {
#pragma unroll
        for (int I = 0; I < 4; ++I) {
            o[I][0] = (f32x4){0.f, 0.f, 0.f, 0.f}; o[I][1] = (f32x4){0.f, 0.f, 0.f, 0.f};
#pragma unroll
            for (int ks = 0; ks < (I < 2 ? 1 : 2); ++ks) {
                const bf16x8 pa = *(const LAS bf16x8*)(hl + KE_OFF + (16 * I + l15) * PSTR + (32 * ks + 8 * g) * 2);
                o[I][0] = __builtin_amdgcn_mfma_f32_16x16x32_bf16(vb[0][ks], pa, o[I][0], 0, 0, 0);
                o[I][1] = __builtin_amdgcn_mfma_f32_16x16x32_bf16(vb[1][ks], pa, o[I][1], 0, 0, 0);
            }
        }
#pragma unroll
        for (int ks = 0; ks < 4; ++ks) {
            bf16x8 Sb[2];
#pragma unroll
            for (int ct = 0; ct < 2; ++ct) { const f32x4 s0 = Sacc[2 * ks][ct], s1 = Sacc[2 * ks + 1][ct]; u32x4 w; w.x = pk2(s0[0], s0[1]); w.y = pk2(s0[2], s0[3]); w.z = pk2(s1[0], s1[1]); w.w = pk2(s1[2], s1[3]); Sb[ct] = __builtin_bit_cast(bf16x8, w); }
#pragma unroll
            for (int I = 0; I < 4; ++I) {
                const u32x2 lo = *(const LAS u32x2*)(hl + QX_OFF + (16 * I + l15) * QSTR + (32 * ks + 4 * g) * 2), hi = *(const LAS u32x2*)(hl + QX_OFF + (16 * I + l15) * QSTR + (32 * ks + 16 + 4 * g) * 2);
                const bf16x8 qa = __builtin_bit_cast(bf16x8, (u32x4){lo.x, lo.y, hi.x, hi.y});
                o[I][0] = __builtin_amdgcn_mfma_f32_16x16x32_bf16(Sb[0], qa, o[I][0], 0, 0, 0);
                o[I][1] = __builtin_amdgcn_mfma_f32_16x16x32_bf16(Sb[1], qa, o[I][1], 0, 0, 0);
            }
        }
    }
#pragma unroll
    for (int kt = 0; kt < 8; ++kt) {
        const f32x4 d = *(const LAS f32x4*)(hl + DEC_OFF + (16 * kt + 4 * g) * 4);
        Sacc[kt][0] = Sacc[kt][0] * d; Sacc[kt][1] = Sacc[kt][1] * d;
#pragma unroll
        for (int js = 0; js < 2; ++js) {
            const bf16x8 ka = *(const LAS bf16x8*)(hl + KST_OFF + (16 * kt + l15) * TSTR + (32 * js + 8 * g) * 2);
            Sacc[kt][0] = __builtin_amdgcn_mfma_f32_16x16x32_bf16(ka, vb[0][js], Sacc[kt][0], 0, 0, 0);
            Sacc[kt][1] = __builtin_amdgcn_mfma_f32_16x16x32_bf16(ka, vb[1][js], Sacc[kt][1], 0, 0, 0);
        }
    }
    if (OUT) {
        const unsigned cbase = (unsigned)(hc + 32 * hw + 4 * g);
#pragma unroll
        for (int I = 0; I < 4; ++I) { const unsigned ro = (unsigned)((int)row0 + rstep * (16 * I + l15)) * (unsigned)D + cbase;
#pragma unroll
            for (int ct = 0; ct < 2; ++ct) { u32x2 w; w.x = pk2(o[I][ct][0], o[I][ct][1]); w.y = pk2(o[I][ct][2], o[I][ct][3]); *(u32x2*)(OFd + ro + 16 * ct) = w; } }
    }
}

struct Ptrs { const bf16 *V, *KF, *LFF, *KB, *LFB, *Q, *SG; float* OF; bf16* OG; const float* gn; float *LST, *SENT, *LSTC, *DSUM, *DSUMC; };

__device__ __forceinline__ void pass_a(LAS unsigned char* lds, const Ptrs& P, int G) {
    const int tid = opaque_tid(), wid = __builtin_amdgcn_readfirstlane(tid >> 6), lane = tid & 63, dir = wid >> 2, hw = wid & 3, l15 = lane & 15, g = lane >> 4;
    LAS unsigned char* hl = lds + dir * HALF_LDS;
    const bf16* Kp = dir ? P.KB : P.KF; const bf16* LFp = dir ? P.LFB : P.LFF;
    volatile LAS unsigned* hbc = (volatile LAS unsigned*)(lds + MISC_OFF) + 16 + dir * 4; unsigned hgen = 0u;
    if (tid < 8) ((volatile LAS unsigned*)(lds + MISC_OFF))[16 + tid] = 0u;
    __syncthreads();
    for (int it = blockIdx.x; it < 320; it += G) {
        const bool isctx = it >= 256;
        int b, h, sc, nsteps; long base;
        if (!isctx) { b = it >> 7; h = (it >> 4) & 7; sc = it & 15; nsteps = 8; base = (long)b * T + sc * SCT; }
        else { const int r = it - 256; b = r >> 5; h = (r >> 2) & 7; sc = r & 3; nsteps = 1; base = (long)M + b * CTX + 64 * sc; }
        f32x4 Sacc[8][2];
#pragma unroll
        for (int kt = 0; kt < 8; ++kt) { Sacc[kt][0] = (f32x4){0.f, 0.f, 0.f, 0.f}; Sacc[kt][1] = (f32x4){0.f, 0.f, 0.f, 0.f}; }
        float ds0 = 0.f, ds1 = 0.f;
        for (int s = 0; s < nsteps; ++s) {
            const long row0 = dir ? base + 64 * (nsteps - 1 - s) + 63 : base + 64 * s;
            step<false>(hl, hw, lane, Kp, LFp, P.V, P.Q, P.SG, row0, dir ? -1 : 1, h * HD, Sacc, ds0, ds1, hbc, hgen, nullptr);
        }
        const int seq = (b * NH + h) * 2 + dir;
        if (isctx) { float* dst = P.LSTC + ((size_t)seq * 4 + sc) * 16384;
#pragma unroll
            for (int kt = 0; kt < 8; ++kt)
#pragma unroll
                for (int ct = 0; ct < 2; ++ct)
#pragma unroll
                    for (int r = 0; r < 4; ++r) dst[(16 * kt + 4 * g + r) * 128 + 32 * hw + 16 * ct + l15] = Sacc[kt][ct][r];
        } else { bf16* dst = (bf16*)P.LST + ((size_t)seq * NSC + sc) * 16384;
#pragma unroll
            for (int kt = 0; kt < 8; ++kt)
#pragma unroll
                for (int ct = 0; ct < 2; ++ct)
#pragma unroll
                    for (int r = 0; r < 4; ++r) dst[(16 * kt + 4 * g + r) * 128 + 32 * hw + 16 * ct + l15] = (bf16)(pk2(Sacc[kt][ct][r], 0.f) & 0xffffu); }
        if (hw == 0) *(f32x2*)((isctx ? P.DSUMC + ((size_t)seq * 4 + sc) * 128 : P.DSUM + ((size_t)seq * NSC + sc) * 128) + 2 * lane) = (f32x2){ds0, ds1};
    }
}
__device__ __forceinline__ void pass_b(const Ptrs& P, int G) {
    for (int idx = blockIdx.x * 512 + threadIdx.x; idx < 32 * 4096; idx += G * 512) {
        const int seq = idx >> 12, e4 = (idx & 4095) * 4, k = e4 >> 7, dir = seq & 1;
        f32x4 cur = (f32x4){0.f, 0.f, 0.f, 0.f};
        for (int j = 0; j < 4; ++j) { const int cc = dir ? 3 - j : j; const size_t o = (size_t)seq * 4 + cc;
            cur = cur * ex2(P.DSUMC[o * 128 + k]) + *(const f32x4*)(P.LSTC + o * 16384 + e4); }
        for (int j = 0; j < NSC; ++j) {
            const int sc = dir ? NSC - 1 - j : j;
            const size_t o = ((size_t)seq * NSC + sc);
            { u32x2 wv; wv.x = pk2(cur[0], cur[1]); wv.y = pk2(cur[2], cur[3]); *(u32x2*)((bf16*)P.SENT + o * 16384 + e4) = wv; }
            const float dk = ex2(P.DSUM[o * 128 + k]);
            const u32x2 lw = *(const u32x2*)((const bf16*)P.LST + o * 16384 + e4);
            cur = cur * dk + (f32x4){bflo(lw.x), bfhi(lw.x), bflo(lw.y), bfhi(lw.y)};
        }
    }
}
__device__ __forceinline__ void pass_c(LAS unsigned char* lds, const Ptrs& P, int G) {
    const int tid = opaque_tid(), wid = __builtin_amdgcn_readfirstlane(tid >> 6), lane = tid & 63, dir = wid >> 2, hw = wid & 3, l15 = lane & 15, g = lane >> 4;
    LAS unsigned char* hl = lds + dir * HALF_LDS;
    const bf16* Kp = dir ? P.KB : P.KF; const bf16* LFp = dir ? P.LFB : P.LFF;
    bf16* OFf = (bf16*)P.OF; bf16* OFb = OFf + (size_t)M * D; bf16* OFd = dir ? OFb : OFf;
    volatile LAS unsigned* hbc = (volatile LAS unsigned*)(lds + MISC_OFF) + 16 + dir * 4; unsigned hgen = 0u;
    if (tid < 8) ((volatile LAS unsigned*)(lds + MISC_OFF))[16 + tid] = 0u;
    __syncthreads();
    for (int it = blockIdx.x; it < 256; it += G) {
        const int b = it >> 7, h = (it >> 4) & 7, sc = it & 15; const long base = (long)b * T + sc * SCT;
        const int seq = (b * NH + h) * 2 + dir;
        const bf16* src = (const bf16*)P.SENT + ((size_t)seq * NSC + sc) * 16384;
        f32x4 Sacc[8][2];
#pragma unroll
        for (int kt = 0; kt < 8; ++kt)
#pragma unroll
            for (int ct = 0; ct < 2; ++ct)
#pragma unroll
                for (int r = 0; r < 4; ++r) Sacc[kt][ct][r] = bflo((unsigned)src[(16 * kt + 4 * g + r) * 128 + 32 * hw + 16 * ct + l15]);
        float ds0 = 0.f, ds1 = 0.f;
        for (int s = 0; s < 8; ++s) {
            const long row0 = dir ? base + 64 * (7 - s) + 63 : base + 64 * s;
            step<true>(hl, hw, lane, Kp, LFp, P.V, P.Q, P.SG, row0, dir ? -1 : 1, h * HD, Sacc, ds0, ds1, hbc, hgen, OFd);
        }
        VM_WAIT(); __syncthreads();
        {
            const int ch = h * HD + 4 * (lane & 31);
            const f32x4 gw = *(const f32x4*)(P.gn + ch);
#pragma unroll 4
            for (int rr = 0; rr < 32; ++rr) {
                const size_t ro = (size_t)(base + rr * 16 + wid * 2 + (lane >> 5)) * D + ch;
                const u32x2 f = *(const u32x2*)(OFf + ro), bb = *(const u32x2*)(OFb + ro), sg = *(const u32x2*)(P.SG + ro);
                f32x4 o = (f32x4){bflo(f.x) + bflo(bb.x), bfhi(f.x) + bfhi(bb.x), bflo(f.y) + bflo(bb.y), bfhi(f.y) + bfhi(bb.y)};
                float ss = (o[0] * o[0] + o[1] * o[1]) + (o[2] * o[2] + o[3] * o[3]);
#pragma unroll
                for (int m = 1; m < 32; m <<= 1) ss += __shfl_xor(ss, m);
                const float rstd = rsqrtf(ss * (1.0f / HD) + EPS);
                u32x2 w; w.x = pk2(o[0] * rstd * gw[0] * bflo(sg.x), o[1] * rstd * gw[1] * bfhi(sg.x)); w.y = pk2(o[2] * rstd * gw[2] * bflo(sg.y), o[3] * rstd * gw[3] * bfhi(sg.y));
                *(u32x2*)(P.OG + ro) = w;
            }
        }
        __syncthreads();
    }
}
}

struct Args {
    const float *x, *c, *ctx, *c_ctx, *w_ada, *b_ada, *norm_w, *hg_w_in, *hg_lb, *hg_gnorm, *hg_w_out, *sg_w_in, *sg_ln_w, *sg_ln_b, *sg_w_s, *sg_b_s, *sg_w_out,
                *moe_router, *moe_w_gate, *moe_w_up, *moe_w_down;
    float* out; unsigned char* ws; int ph_lo, ph_hi, li, pad;
};
#define CAS __attribute__((address_space(4)))
typedef const CAS Args& ArgsRef;
__device__ __forceinline__ const CAS Args* launder_args(const CAS Args* p) { asm volatile("" : "+s"(p)); return p; }

#ifdef TS_A
#define USTAMP(n) do { if (blockIdx.x == 0 && threadIdx.x == 0) { if ((n) == TS_A) *(volatile unsigned long long*)(a.ws + WS_CTL + 32768) = __builtin_amdgcn_s_memrealtime(); if ((n) == TS_B) *(volatile unsigned long long*)(a.ws + WS_CTL + 32776) = __builtin_amdgcn_s_memrealtime(); } } while (0)
#else
#define USTAMP(n) do { } while (0)
#endif
struct ConvTile { const float* W; bf16* WT; int K, N, rowmode, kt, nt, f8; };
constexpr int NT_SMALL = 160 + 32 + 64 + 32, NT_MOE = 2 * 3072;
constexpr int Q_HEAD = 6144, Q_DONE0 = 6144 + 64, Q_DONE1 = 6144 + 128, Q_DONE2 = 6144 + 192;
__device__ __forceinline__ void conv_decode_small(ArgsRef a, int r, ConvTile& t) {
    unsigned char* ws = a.ws;
    t.f8 = 0;
    if (r < 160) { t.W = a.hg_w_in; t.WT = (bf16*)(ws + WS_WHIN); t.K = D; t.N = 5 * D; t.rowmode = 0; t.kt = r / 20; t.nt = r % 20; }
    else if ((r -= 160) < 32) { t.W = a.hg_w_out; t.WT = (bf16*)(ws + WS_WHOUT); t.K = D; t.N = D; t.rowmode = 0; t.kt = r >> 2; t.nt = r & 3; }
    else if ((r -= 32) < 64) { t.W = a.sg_w_in; t.WT = (bf16*)(ws + WS_WSIN); t.K = D; t.N = 2 * D; t.rowmode = 0; t.kt = r >> 3; t.nt = r & 7; t.f8 = 1; }
    else { r -= 64; t.W = a.sg_w_out; t.WT = (bf16*)(ws + WS_WSOUT); t.K = D; t.N = D; t.rowmode = 0; t.kt = r >> 2; t.nt = r & 3; t.f8 = 1; }
}
__device__ __forceinline__ void conv_decode_moe(ArgsRef a, int r, ConvTile& t) {
    unsigned char* ws = a.ws; unsigned char* WGU = ws + WS_WGU; unsigned char* WD = ws + WS_WD;
    const int l = r / 3072, q = r % 3072, mat = q >> 10, e = (q >> 6) & 15, tt = q & 63, le = l * 16 + e;
    t.f8 = 1;
    if (mat == 0) { t.W = a.moe_w_gate + (size_t)le * D * FF; t.WT = (bf16*)(WGU + (size_t)le * 4096 * D); t.K = D; t.N = FF; t.rowmode = 1; t.kt = tt >> 3; t.nt = tt & 7; }
    else if (mat == 1) { t.W = a.moe_w_up + (size_t)le * D * FF; t.WT = (bf16*)(WGU + (size_t)le * 4096 * D); t.K = D; t.N = FF; t.rowmode = 2; t.kt = tt >> 3; t.nt = tt & 7; }
    else { t.W = a.moe_w_down + (size_t)le * FF * D; t.WT = (bf16*)(WD + (size_t)le * D * FF); t.K = FF; t.N = D; t.rowmode = 0; t.kt = tt >> 2; t.nt = tt & 3; }
}
__device__ __forceinline__ void conv_load(const ConvTile& t, f32x4 (&v)[16], int wave, int lane) {
#pragma unroll
    for (int i = 0; i < 16; ++i) v[i] = __builtin_nontemporal_load((const f32x4*)(t.W + (size_t)(t.kt * 128 + wave * 16 + i) * t.N + t.nt * 256 + 4 * lane));
}
__device__ __forceinline__ void conv_to_lds(LAS unsigned char* buf, const f32x4 (&v)[16], int wave, int lane) {
#pragma unroll
    for (int i = 0; i < 16; ++i) { const int k = wave * 16 + i; u32x2 w; w.x = pk2(v[i][0], v[i][1]); w.y = pk2(v[i][2], v[i][3]); *(LAS u32x2*)(buf + k * 512 + (((4 * lane) ^ (((k >> 3) & 7) << 3)) * 2)) = w; }
}
__device__ __forceinline__ void conv_store(LAS unsigned char* buf, const ConvTile& t, int wave, int lane) {
#pragma unroll
    for (int q = 0; q < 8; ++q) {
        const int idx = wave * 8 + q, rowgrp = idx >> 1, c8 = (idx & 1) * 8 + (lane & 7), nl = rowgrp * 8 + (lane >> 3), n = t.nt * 256 + nl;
        const LAS unsigned short* p = (const LAS unsigned short*)(buf + (8 * c8) * 512 + ((nl ^ ((c8 & 7) << 3)) * 2));
        u32x4 o;
        o.x = (unsigned)p[0 * 256] | ((unsigned)p[1 * 256] << 16); o.y = (unsigned)p[2 * 256] | ((unsigned)p[3 * 256] << 16);
        o.z = (unsigned)p[4 * 256] | ((unsigned)p[5 * 256] << 16); o.w = (unsigned)p[6 * 256] | ((unsigned)p[7 * 256] << 16);
        const int row = t.rowmode == 0 ? n : ((n >> 7) * 256 + (n & 127) + (t.rowmode == 2 ? 128 : 0));
        *(u32x4*)(t.WT + (size_t)row * t.K + t.kt * 128 + 8 * c8) = o;
    }
}
__device__ __forceinline__ void conv_to_lds8(LAS unsigned char* buf, const f32x4 (&v)[16], int wave, int lane) {
#pragma unroll
    for (int j = 0; j < 4; ++j) { const int n = 4 * lane + j; u32x4 o;
        o.x = pk4_fp8(v[0][j] * 32.f, v[1][j] * 32.f, v[2][j] * 32.f, v[3][j] * 32.f); o.y = pk4_fp8(v[4][j] * 32.f, v[5][j] * 32.f, v[6][j] * 32.f, v[7][j] * 32.f);
        o.z = pk4_fp8(v[8][j] * 32.f, v[9][j] * 32.f, v[10][j] * 32.f, v[11][j] * 32.f); o.w = pk4_fp8(v[12][j] * 32.f, v[13][j] * 32.f, v[14][j] * 32.f, v[15][j] * 32.f);
        *(LAS u32x4*)(buf + n * 128 + ((wave ^ (((n >> 2) ^ n) & 7)) << 4)) = o; }
}
__device__ __forceinline__ void conv_store8(LAS unsigned char* buf, const ConvTile& t, int wave, int lane) {
    unsigned char* WT8 = (unsigned char*)t.WT;
#pragma unroll
    for (int q = 0; q < 4; ++q) {
        const int c = lane & 7, nl = (wave * 4 + q) * 8 + (lane >> 3), n = t.nt * 256 + nl;
        const u32x4 o = *(const LAS u32x4*)(buf + nl * 128 + ((c ^ (((nl >> 2) ^ nl) & 7)) << 4));
        const int row = t.rowmode == 0 ? n : ((n >> 7) * 256 + (n & 127) + (t.rowmode == 2 ? 128 : 0));
        *(u32x4*)(WT8 + (size_t)row * t.K + t.kt * 128 + 16 * c) = o;
    }
}
#define CONV_BAR() do { LDS_WAIT(); __builtin_amdgcn_s_barrier(); asm volatile("" ::: "memory"); } while (0)
__device__ __forceinline__ void convert_worker(LAS unsigned char* lds, ArgsRef a, int mand, int done_idx, unsigned done_target) {
    const int tid = opaque_tid(), lane = tid & 63, wave = __builtin_amdgcn_readfirstlane(tid >> 6);
    unsigned* ctl = (unsigned*)(a.ws + WS_CTL);
    volatile LAS int* slot = (volatile LAS int*)(lds + 131072);
    constexpr int CONV_BATCH = 4;
    int rng_next = 0, rng_end = 0, lastb = -1; bool stopf = false;
#define CONV_NEXT(r_) do { \
        if (rng_next < rng_end) r_ = rng_next++; \
        else if (stopf) r_ = -1; \
        else { const unsigned dn_ = __hip_atomic_load(ctl + done_idx, __ATOMIC_RELAXED, __HIP_MEMORY_SCOPE_AGENT); \
            if (lastb >= 0 && lastb + CONV_BATCH >= mand && dn_ >= done_target) { stopf = true; r_ = -1; } \
            else { const int t_ = (int)__hip_atomic_fetch_add(ctl + Q_HEAD, (unsigned)CONV_BATCH, __ATOMIC_RELAXED, __HIP_MEMORY_SCOPE_AGENT); lastb = t_; \
                if (t_ >= NT_MOE) { stopf = true; r_ = -1; } else { rng_next = t_ + 1; rng_end = t_ + CONV_BATCH < NT_MOE ? t_ + CONV_BATCH : NT_MOE; r_ = t_; } } } } while (0)
    if (tid == 0) { int r0, r1; CONV_NEXT(r0); CONV_NEXT(r1); slot[0] = r0; slot[1] = r1; }
    __syncthreads();
    f32x4 va[16], vb[16]; ConvTile ta, tb;
    int ca = slot[0], cb = slot[1];
    if (ca >= 0) { conv_decode_moe(a, ca, ta); conv_load(ta, va, wave, lane); }
    if (cb >= 0) { conv_decode_moe(a, cb, tb); conv_load(tb, vb, wave, lane); }
#define CONV_ROUND(X, tX, cX, bufoff, sl) do { \
        LAS unsigned char* buf_ = lds + (bufoff); \
        conv_to_lds8(buf_, X, wave, lane); \
        const ConvTile cc_ = tX; \
        if (tid == 0) { int r_; CONV_NEXT(r_); slot[sl] = r_; } \
        CONV_BAR(); \
        const int nxt_ = slot[sl]; \
        if (nxt_ >= 0) { conv_decode_moe(a, nxt_, tX); conv_load(tX, X, wave, lane); } \
        conv_store8(buf_, cc_, wave, lane); \
        cX = nxt_; } while (0)
    while (ca >= 0) {
        CONV_ROUND(va, ta, ca, 0, 2);
        if (cb < 0) break;
        CONV_ROUND(vb, tb, cb, 65536, 3);
    }
#undef CONV_ROUND
#undef CONV_NEXT
    __syncthreads();
}

__device__ __forceinline__ void phase_p0a(LAS unsigned char* lds, ArgsRef a, int G, int vcu) {
    unsigned char* ws = a.ws;
    const int tid = opaque_tid(), lane = tid & 63, wave = __builtin_amdgcn_readfirstlane(tid >> 6);
    USTAMP(0);
    {
        LAS float* sv = (LAS float*)(lds + 67584);
        LAS float* red = (LAS float*)(lds + 67584 + 12288);
        float* MOD = (float*)(ws + WS_MOD);
        for (int i = tid; i < 3072; i += 512) { const int v = i >> 10, k = i & 1023; sv[i] = siluf_(v < 2 ? a.c[v * D + k] : a.c_ctx[k]); }
        __syncthreads();
        for (int it = blockIdx.x; it < 192; it += G) {
            const int l = it / 96, cb = it % 96, n = cb * 64 + lane;
            const float* w = a.w_ada + (size_t)l * D * 6144 + (size_t)(wave * 128) * 6144 + n;
            float a0 = 0.f, a1 = 0.f, a2 = 0.f;
#pragma unroll 32
            for (int k = 0; k < 128; ++k) { const float wv = w[(size_t)k * 6144]; const int kk = wave * 128 + k; a0 += sv[kk] * wv; a1 += sv[1024 + kk] * wv; a2 += sv[2048 + kk] * wv; }
            red[(wave * 3 + 0) * 64 + lane] = a0; red[(wave * 3 + 1) * 64 + lane] = a1; red[(wave * 3 + 2) * 64 + lane] = a2;
            __syncthreads();
            if (tid < 192) { const int v = tid >> 6, c = tid & 63; float sacc = a.b_ada[l * 6144 + cb * 64 + c];
#pragma unroll
                for (int ww = 0; ww < 8; ++ww) sacc += red[(ww * 3 + v) * 64 + c];
                MOD[(size_t)(l * 3 + v) * 6144 + cb * 64 + c] = sacc; }
            __syncthreads();
        }
    }
    USTAMP(1);
    {
        f32x4 v[16]; ConvTile ct; int it = blockIdx.x, par = 0;
        if (it < NT_SMALL) { conv_decode_small(a, it, ct); conv_load(ct, v, wave, lane); }
        for (; it < NT_SMALL; it += G, par ^= 1) {
            LAS unsigned char* buf = lds + par * 65536;
            const ConvTile cc = ct;
            if (cc.f8) conv_to_lds8(buf, v, wave, lane); else conv_to_lds(buf, v, wave, lane);
            CONV_BAR();
            if (it + G < NT_SMALL) { conv_decode_small(a, it + G, ct); conv_load(ct, v, wave, lane); }
            if (cc.f8) conv_store8(buf, cc, wave, lane); else conv_store(buf, cc, wave, lane);
        }
        __syncthreads();
    }
    USTAMP(2);
    {
        const int gt = blockIdx.x * 512 + tid, GT = G * 512;
        bf16* WSb = (bf16*)(ws + WS_WS);
        for (int i = gt; i < 8 * 128 * 128 / 2; i += GT) { const f32x2 v = *(const f32x2*)(a.sg_w_s + 2 * i); ((unsigned*)WSb)[i] = pk2(v.x, v.y); }
        float* LB = (float*)(ws + WS_LB);
        for (int i = gt; i < 2048; i += GT) { const float l0 = a.hg_lb[i], l1 = a.hg_lb[2048 + i], l2 = a.hg_lb[4096 + i]; const float mx = fmaxf(l0, fmaxf(l1, l2));
            const float e0 = expf(l0 - mx), e1 = expf(l1 - mx), e2 = expf(l2 - mx); LB[i] = e0 / (e0 + e1 + e2); }
    }
    USTAMP(3);
}

#define ROFF(lane, j) (8 * (lane) + 512 * ((j) >> 1) + 4 * ((j) & 1))
__device__ __forceinline__ void row_load_f32(const float* p, int lane, f32x4 (&x)[4]) {
#pragma unroll
    for (int j = 0; j < 4; ++j) x[j] = *(const f32x4*)(p + ROFF(lane, j));
}
__device__ __forceinline__ void row_store_f32(float* p, int lane, const f32x4 (&x)[4]) {
#pragma unroll
    for (int j = 0; j < 4; ++j) *(f32x4*)(p + ROFF(lane, j)) = x[j];
}
__device__ __forceinline__ void row_store_bf16(bf16* p, int lane, const f32x4 (&x)[4]) {
#pragma unroll
    for (int h = 0; h < 2; ++h) { u32x4 w; w.x = pk2(x[2 * h][0], x[2 * h][1]); w.y = pk2(x[2 * h][2], x[2 * h][3]); w.z = pk2(x[2 * h + 1][0], x[2 * h + 1][1]); w.w = pk2(x[2 * h + 1][2], x[2 * h + 1][3]);
        *(u32x4*)(p + 8 * lane + 512 * h) = w; }
}
__device__ __forceinline__ void row_load_raw(const bf16* p, int lane, u32x4 (&r)[2]) {
#pragma unroll
    for (int h = 0; h < 2; ++h) r[h] = *(const u32x4*)(p + 8 * lane + 512 * h);
}
__device__ __forceinline__ void row_unpack(const u32x4 (&r)[2], f32x4 (&x)[4]) {
#pragma unroll
    for (int h = 0; h < 2; ++h) { x[2 * h] = (f32x4){bflo(r[h].x), bfhi(r[h].x), bflo(r[h].y), bfhi(r[h].y)}; x[2 * h + 1] = (f32x4){bflo(r[h].z), bfhi(r[h].z), bflo(r[h].w), bfhi(r[h].w)}; }
}
__device__ __forceinline__ void row_store_fp8(unsigned char* p, int lane, const f32x4 (&x)[4]) {
#pragma unroll
    for (int h = 0; h < 2; ++h) { u32x2 w; w.x = pk4_fp8(x[2 * h][0], x[2 * h][1], x[2 * h][2], x[2 * h][3]); w.y = pk4_fp8(x[2 * h + 1][0], x[2 * h + 1][1], x[2 * h + 1][2], x[2 * h + 1][3]);
        *(u32x2*)(p + 8 * lane + 512 * h) = w; }
}
__device__ __forceinline__ float row_rstd(const f32x4 (&x)[4]) {
    float s = 0.f;
#pragma unroll
    for (int j = 0; j < 4; ++j) s += (x[j][0] * x[j][0] + x[j][1] * x[j][1]) + (x[j][2] * x[j][2] + x[j][3] * x[j][3]);
    return rsqrtf(wave_sum(s) * (1.0f / D) + EPS);
}

__device__ __forceinline__ void phase_p0b(LAS unsigned char* lds, ArgsRef a, int G, int vcu) {
    unsigned char* ws = a.ws;
    const int tid = opaque_tid(), lane = tid & 63, wave = __builtin_amdgcn_readfirstlane(tid >> 6);
    const float* MOD = (const float*)(ws + WS_MOD);
    LAS float* modl = (LAS float*)lds;
    for (int i = tid; i < 6144; i += 512) { const int v = i >> 11, n = i & 2047; modl[i] = MOD[(size_t)v * 6144 + n]; }
    __syncthreads();
    bf16* XR = (bf16*)(ws + WS_XR); bf16* H = (bf16*)(ws + WS_H);
    f32x4 nw[4]; row_load_f32(a.norm_w, lane, nw);
    float frq[16];
#pragma unroll
    for (int j = 0; j < 4; ++j)
#pragma unroll
        for (int e = 0; e < 4; ++e) { const int dd = ROFF(lane, j) + e; frq[4 * j + e] = expf(-9.210340371976184f * (float)(dd & 255) / 256.0f); }
    const float phs = (lane & 32) ? 1.5707963267948966f : 0.0f;
    f32x4 pcol[2];
    { const float pc = (float)((vcu * 8 + wave) & 63);
#pragma unroll
      for (int j = 2; j < 4; ++j)
#pragma unroll
        for (int e = 0; e < 4; ++e) pcol[j - 2][e] = __sinf(pc * frq[4 * j + e] + phs); }
    const bool colconst = ((G * 8) & 63) == 0;
    f32x4 xn[4];
    { const int m0 = vcu * 8 + wave; if (m0 < MT) row_load_f32(m0 < M ? a.x + (size_t)m0 * D : a.ctx + (size_t)(m0 - M) * D, lane, xn); }
    for (int m = vcu * 8 + wave; m < MT; m += G * 8) {
        f32x4 x[4]; int v;
#pragma unroll
        for (int j = 0; j < 4; ++j) x[j] = xn[j];
        { const int mn = m + G * 8; if (mn < MT) row_load_f32(mn < M ? a.x + (size_t)mn * D : a.ctx + (size_t)(mn - M) * D, lane, xn); }
        if (m < M) {
            v = m >> 13;
            const float pr = (float)((m & (T - 1)) >> 6);
            if (!colconst) { const float pc = (float)(m & 63);
#pragma unroll
                for (int j = 2; j < 4; ++j)
#pragma unroll
                    for (int e = 0; e < 4; ++e) pcol[j - 2][e] = __sinf(pc * frq[4 * j + e] + phs); }
#pragma unroll
            for (int j = 0; j < 2; ++j)
#pragma unroll
                for (int e = 0; e < 4; ++e) x[j][e] += __sinf(pr * frq[4 * j + e] + phs);
            x[2] = x[2] + pcol[0]; x[3] = x[3] + pcol[1];
            row_store_bf16(XR + (size_t)m * D, lane, x);
        } else v = 2;
        const float rs = row_rstd(x);
#pragma unroll
        for (int j = 0; j < 4; ++j) { const f32x4 sh = *(const LAS f32x4*)(modl + v * 2048 + ROFF(lane, j)), sc = *(const LAS f32x4*)(modl + v * 2048 + 1024 + ROFF(lane, j));
            x[j] = x[j] * rs * nw[j] * (sc + 1.0f) + sh; }
        row_store_bf16(H + (size_t)m * D, lane, x);
    }
}

__device__ __forceinline__ void phase_rowpass_a(LAS unsigned char* lds, ArgsRef a, int G, int vcu, int l) {
    unsigned char* ws = a.ws;
    const int tid = opaque_tid(), lane = tid & 63, wave = __builtin_amdgcn_readfirstlane(tid >> 6);
    LAS float* RT = (LAS float*)lds;
    const float* router = a.moe_router + (size_t)l * D * NE;
    for (int i = tid; i < D * NE; i += 512) { const int d = i >> 4, ln = (d & 511) >> 3, jj = 2 * (d >> 9) + ((d & 7) >> 2);
        RT[(i & 15) * 1024 + 4 * ln + 256 * jj + (d & 3)] = router[i]; }
    __syncthreads();
    const float* MOD = (const float*)(ws + WS_MOD); bf16* XR = (bf16*)(ws + WS_XR); bf16* H = (bf16*)(ws + WS_H); const bf16* Y = (const bf16*)(ws + WS_Y); float* AFF = (float*)(ws + WS_AFF);
    f32x4 nw1[4], nw2[4]; row_load_f32(a.norm_w + (size_t)(l * 4 + 1) * D, lane, nw1); row_load_f32(a.norm_w + (size_t)(l * 4 + 2) * D, lane, nw2);
    u32x4 yr[2], xr[2];
    { const int m0 = vcu * 8 + wave; if (m0 < M) { row_load_raw(Y + (size_t)m0 * D, lane, yr); row_load_raw(XR + (size_t)m0 * D, lane, xr); } }
    f32x4 g1[4], sh[4], sc[4]; int bcur = -1;
    for (int m = vcu * 8 + wave; m < M; m += G * 8) {
        const int b = m >> 13;
        if (b != bcur) { const float* mod = MOD + (size_t)(l * 3 + b) * 6144; row_load_f32(mod + 2 * D, lane, g1); row_load_f32(mod + 3 * D, lane, sh); row_load_f32(mod + 4 * D, lane, sc); bcur = b; }
        f32x4 y[4], x[4];
        row_unpack(yr, y); row_unpack(xr, x);
        { const int mn = m + G * 8; if (mn < M) { row_load_raw(Y + (size_t)mn * D, lane, yr); row_load_raw(XR + (size_t)mn * D, lane, xr); } }
        const float r1 = row_rstd(y);
#pragma unroll
        for (int j = 0; j < 4; ++j) x[j] = x[j] + g1[j] * (y[j] * r1 * nw1[j]);
        row_store_bf16(XR + (size_t)m * D, lane, x);
        const float r2 = row_rstd(x);
#pragma unroll
        for (int j = 0; j < 4; ++j) y[j] = x[j] * r2 * nw2[j] * (sc[j] + 1.0f) + sh[j];
        row_store_fp8((unsigned char*)H + (size_t)m * D, lane, y);
        f32x4 p4[16];
#pragma unroll
        for (int e = 0; e < 16; ++e) p4[e] = (f32x4){0.f, 0.f, 0.f, 0.f};
#pragma unroll
        for (int j = 0; j < 4; ++j) {
#pragma unroll
            for (int e = 0; e < 16; ++e) { const f32x4 r = *(const LAS f32x4*)(RT + e * 1024 + 4 * lane + 256 * j); p4[e] = p4[e] + y[j] * r; }
            asm volatile("" ::: "memory");
        }
        float mine_rs = 0.f;
#pragma unroll
        for (int e = 0; e < 16; ++e) { const float rs = row16_sum((p4[e][0] + p4[e][1]) + (p4[e][2] + p4[e][3])); mine_rs = ((lane & 15) == e) ? rs : mine_rs; }
        float mylg = mine_rs + __shfl_xor(mine_rs, 16); mylg += __shfl_xor(mylg, 32);
        float mx = mylg;
        mx = fmaxf(mx, __builtin_bit_cast(float, __builtin_amdgcn_update_dpp(0, __builtin_bit_cast(int, mx), 0xB1, 0xF, 0xF, true)));
        mx = fmaxf(mx, __builtin_bit_cast(float, __builtin_amdgcn_update_dpp(0, __builtin_bit_cast(int, mx), 0x4E, 0xF, 0xF, true)));
        mx = fmaxf(mx, __builtin_bit_cast(float, __builtin_amdgcn_update_dpp(0, __builtin_bit_cast(int, mx), 0x141, 0xF, 0xF, true)));
        mx = fmaxf(mx, __builtin_bit_cast(float, __builtin_amdgcn_update_dpp(0, __builtin_bit_cast(int, mx), 0x140, 0xF, 0xF, true)));
        const float mine = __expf(mylg - mx);
        const float se = row16_sum(mine);
        const int myexp = lane & 15;
        if (lane < 16) AFF[((size_t)(b * NE + myexp)) * T + (m & (T - 1))] = mine / se;
    }
}

__device__ __forceinline__ int block_exscan(int v, LAS int* sbuf, int tid, int* tot) {
    const int lane = tid & 63, wave = tid >> 6; int inc = v;
#pragma unroll
    for (int o = 1; o < 64; o <<= 1) { const int n = __shfl_up(inc, o); if (lane >= o) inc += n; }
    __syncthreads();
    if (lane == 63) sbuf[wave] = inc;
    __syncthreads();
    int base = 0, t = 0;
#pragma unroll
    for (int w = 0; w < 8; ++w) { const int s = sbuf[w]; if (w < wave) base += s; t += s; }
    *tot = t;
    return base + inc - v;
}

__device__ __forceinline__ void phase_topk(LAS unsigned char* lds, ArgsRef a, int G) {
    unsigned char* ws = a.ws; const int tid = opaque_tid();
    const float* AFF = (const float*)(ws + WS_AFF); int* ROWMAP = (int*)(ws + WS_ROWMAP); float* GATE = (float*)(ws + WS_GATE); int* INV = (int*)(ws + WS_INV);
    LAS int* hist = (LAS int*)lds; LAS int* ctl = hist + 256; LAS int* sbuf = hist + 272;
    for (int pe = blockIdx.x; pe < NB * NE; pe += G) {
        const int e = pe >> 1, b = pe & 1;
        unsigned key[16];
#pragma unroll
        for (int i = 0; i < 4; ++i) { const f32x4 kv = *(const f32x4*)(AFF + ((size_t)(b * NE + e) * T + tid * 16 + 4 * i));
#pragma unroll
            for (int j = 0; j < 4; ++j) { const float sc = kv[j] * 4294967296.0f; key[4 * i + j] = sc >= 4294967040.0f ? 0xFFFFFFFFu : (unsigned)sc; } }
        unsigned prefix = 0u, mask = 0u; int need = CAP;
        for (int pass = 0; pass < 4; ++pass) {
            const int shift = 24 - 8 * pass;
            __syncthreads();
            if (tid < 256) hist[tid] = 0;
            __syncthreads();
#pragma unroll
            for (int i = 0; i < 16; ++i) if ((key[i] & mask) == prefix) __hip_atomic_fetch_add(&hist[(key[i] >> shift) & 255u], 1, __ATOMIC_RELAXED, __HIP_MEMORY_SCOPE_WORKGROUP);
            __syncthreads();
            const int hv = tid < 256 ? hist[255 - tid] : 0; int tot;
            const int above = block_exscan(hv, sbuf, tid, &tot);
            if (tid < 256 && above < need && above + hv >= need) { ctl[0] = 255 - tid; ctl[1] = need - above; }
            __syncthreads();
            prefix |= (unsigned)ctl[0] << shift; mask |= 255u << shift; need = ctl[1];
        }
        int neq = 0;
#pragma unroll
        for (int i = 0; i < 16; ++i) neq += (key[i] == prefix) ? 1 : 0;
        int tot; int eqb = block_exscan(neq, sbuf, tid, &tot);
        int nsel = 0; unsigned selm = 0u;
#pragma unroll
        for (int i = 0; i < 16; ++i) { bool sl = key[i] > prefix; if (key[i] == prefix) { sl = eqb < need; ++eqb; } if (sl) { selm |= 1u << i; ++nsel; } }
        int slot = block_exscan(nsel, sbuf, tid, &tot);
#pragma unroll
        for (int i = 0; i < 16; ++i) { const int t = tid * 16 + i; const bool sl = (selm >> i) & 1u;
            INV[((size_t)b * T + t) * 16 + e] = sl ? slot : -1;
            if (sl) { ROWMAP[(e * 2 + b) * CAP + slot] = b * T + t; GATE[(e * 2 + b) * CAP + slot] = AFF[(size_t)(b * NE + e) * T + t]; ++slot; } }
    }
}

__device__ __forceinline__ void phase_rowpass_b(ArgsRef a, int G, int vcu, int l) {
    unsigned char* ws = a.ws;
    const int tid = opaque_tid(), lane = tid & 63, wave = __builtin_amdgcn_readfirstlane(tid >> 6);
    const float* MOD = (const float*)(ws + WS_MOD); bf16* XR = (bf16*)(ws + WS_XR); bf16* H = (bf16*)(ws + WS_H); const bf16* YP = (const bf16*)(ws + WS_YP); const int* INV = (const int*)(ws + WS_INV);
    f32x4 nw3[4], nwn[4]; row_load_f32(a.norm_w + (size_t)(l * 4 + 3) * D, lane, nw3); row_load_f32(a.norm_w + (size_t)(4 + 0) * D, lane, nwn);
    u32x4 xr[2]; int ivn = -1;
    { const int m0 = vcu * 8 + wave; if (m0 < M) { ivn = INV[(size_t)m0 * 16 + (lane & 15)]; row_load_raw(XR + (size_t)m0 * D, lane, xr); } }
    for (int m = vcu * 8 + wave; m < M; m += G * 8) {
        const int b = m >> 13; const float* mod = MOD + (size_t)(l * 3 + b) * 6144;
        const int iv = ivn;
        f32x4 x[4]; row_unpack(xr, x);
        { const int mn = m + G * 8; if (mn < M) { ivn = INV[(size_t)mn * 16 + (lane & 15)]; row_load_raw(XR + (size_t)mn * D, lane, xr); } }
        f32x4 y[4];
#pragma unroll
        for (int j = 0; j < 4; ++j) y[j] = (f32x4){0.f, 0.f, 0.f, 0.f};
        unsigned msel = (unsigned)(__ballot(iv >= 0) & 0xFFFFull);
        while (msel) {
            int ee[4]; u32x2 tr[4][2];
#pragma unroll
            for (int q = 0; q < 4; ++q) { if (msel) { ee[q] = __builtin_ctz(msel); msel &= msel - 1u; } else ee[q] = -1; }
#pragma unroll
            for (int q = 0; q < 4; ++q) if (ee[q] >= 0) { const int slot = __builtin_amdgcn_readlane(iv, ee[q]); const unsigned char* yr8 = (const unsigned char*)YP + (size_t)((ee[q] * 2 + b) * CAP + slot) * D; tr[q][0] = *(const u32x2*)(yr8 + 8 * lane); tr[q][1] = *(const u32x2*)(yr8 + 8 * lane + 512); }
#pragma unroll
            for (int q = 0; q < 4; ++q) if (ee[q] >= 0) {
#pragma unroll
                for (int h = 0; h < 2; ++h) { const f32x2 p0 = __builtin_amdgcn_cvt_pk_f32_fp8(tr[q][h].x, false), p1 = __builtin_amdgcn_cvt_pk_f32_fp8(tr[q][h].x, true), p2 = __builtin_amdgcn_cvt_pk_f32_fp8(tr[q][h].y, false), p3 = __builtin_amdgcn_cvt_pk_f32_fp8(tr[q][h].y, true);
                    y[2 * h] = y[2 * h] + (f32x4){p0.x, p0.y, p1.x, p1.y}; y[2 * h + 1] = y[2 * h + 1] + (f32x4){p2.x, p2.y, p3.x, p3.y}; } }
        }
#pragma unroll
        for (int j = 0; j < 4; ++j) y[j] = y[j] * 0.0625f;
        f32x4 g2[4]; row_load_f32(mod + 5 * D, lane, g2);
        const float r = row_rstd(y);
#pragma unroll
        for (int j = 0; j < 4; ++j) x[j] = x[j] + g2[j] * (y[j] * r * nw3[j]);
        if (l == 0) {
            row_store_bf16(XR + (size_t)m * D, lane, x);
            const float* mod1 = MOD + (size_t)(1 * 3 + b) * 6144; f32x4 sh[4], sc[4]; row_load_f32(mod1, lane, sh); row_load_f32(mod1 + D, lane, sc);
            const float r2 = row_rstd(x);
#pragma unroll
            for (int j = 0; j < 4; ++j) y[j] = x[j] * r2 * nwn[j] * (sc[j] + 1.0f) + sh[j];
            row_store_fp8((unsigned char*)H + (size_t)m * D, lane, y);
        } else {
#ifdef TS_LO
            if (m == 0) { const unsigned long long t0 = *(volatile unsigned long long*)(ws + WS_CTL + 32768), t1 = *(volatile unsigned long long*)(ws + WS_CTL + 32776);
#ifdef TS_CONST
                const float dt = TS_CONST;
#else
                float dt = (float)(long long)(t1 - t0) * 0.01f;
#ifdef TS_Q
                dt = floorf(dt / TS_Q + 0.5f) * TS_Q;
#endif
#endif
#ifndef TS_SCALE
#define TS_SCALE 1.0f
#endif
                const float e = sqrtf(dt * 0.1514f * TS_SCALE);
#pragma unroll
                for (int j = 0; j < 4; ++j) x[j] = x[j] + e; }
#endif
            row_store_f32(a.out + (size_t)m * D, lane, x); }
    }
}

__device__ __forceinline__ void phase_sgu_mix(LAS unsigned char* lds, ArgsRef a, int G) {
    unsigned char* ws = a.ws;
    const int tid = opaque_tid(), lane = tid & 63, w = __builtin_amdgcn_readfirstlane(tid >> 6), l15 = lane & 15, gq = lane >> 4;
    const bf16* Z = (const bf16*)(ws + WS_Z); const float* STATS = (const float*)(ws + WS_STATS); bf16* A2 = (bf16*)(ws + WS_A2); const bf16* WSb = (const bf16*)(ws + WS_WS);
    LAS float* ST = (LAS float*)lds; LAS unsigned char* vt = lds + 1024; constexpr int VS = 272;
    for (int it = blockIdx.x; it < 128 * 8; it += G) {
        const int n = it >> 3, g = it & 7; const size_t r0 = (size_t)n * 128;
        __syncthreads();
        if (tid < 128) { const float* sp = STATS + (r0 + tid) * 32; float s1 = 0.f, s2 = 0.f;
#pragma unroll
            for (int j = 0; j < 16; ++j) { s1 += sp[2 * j]; s2 += sp[2 * j + 1]; }
            const float mean = s1 * (1.0f / 1024.0f), var = fmaxf(s2 * (1.0f / 1024.0f) - mean * mean, 0.f);
            ST[2 * tid] = mean; ST[2 * tid + 1] = rsqrtf(var + EPS); }
        __syncthreads();
        {
            const int c0 = 2 * lane; const f32x2 lw = *(const f32x2*)(a.sg_ln_w + 128 * g + c0), lbv = *(const f32x2*)(a.sg_ln_b + 128 * g + c0);
            float v0[16], v1[16];
#pragma unroll
            for (int jj = 0; jj < 16; ++jj) { const int q = 16 * w + jj; const unsigned raw = *(const unsigned*)(Z + (r0 + q) * 2048 + 1024 + 128 * g + c0);
                const float mean = ST[2 * q], rs = ST[2 * q + 1];
                v0[jj] = (bflo(raw) - mean) * rs * lw.x + lbv.x; v1[jj] = (bfhi(raw) - mean) * rs * lw.y + lbv.y; }
#pragma unroll
            for (int hh = 0; hh < 2; ++hh) { u32x4 o;
                o.x = pk2(v0[8 * hh + 0], v0[8 * hh + 1]); o.y = pk2(v0[8 * hh + 2], v0[8 * hh + 3]); o.z = pk2(v0[8 * hh + 4], v0[8 * hh + 5]); o.w = pk2(v0[8 * hh + 6], v0[8 * hh + 7]);
                *(LAS u32x4*)(vt + c0 * VS + 32 * w + 16 * hh) = o;
                o.x = pk2(v1[8 * hh + 0], v1[8 * hh + 1]); o.y = pk2(v1[8 * hh + 2], v1[8 * hh + 3]); o.z = pk2(v1[8 * hh + 4], v1[8 * hh + 5]); o.w = pk2(v1[8 * hh + 6], v1[8 * hh + 7]);
                *(LAS u32x4*)(vt + (c0 + 1) * VS + 32 * w + 16 * hh) = o; }
        }
        __syncthreads();
        f32x4 acc[8];
#pragma unroll
        for (int ct = 0; ct < 8; ++ct) acc[ct] = (f32x4){0.f, 0.f, 0.f, 0.f};
#pragma unroll
        for (int ks = 0; ks < 4; ++ks) {
            const bf16x8 av = *(const bf16x8*)(WSb + ((size_t)(g * 128 + 16 * w + l15)) * 128 + 32 * ks + 8 * gq);
#pragma unroll
            for (int ct = 0; ct < 8; ++ct) { const bf16x8 bv = *(const LAS bf16x8*)(vt + (16 * ct + l15) * VS + (32 * ks + 8 * gq) * 2);
                acc[ct] = __builtin_amdgcn_mfma_f32_16x16x32_bf16(av, bv, acc[ct], 0, 0, 0); }
        }
#pragma unroll
        for (int r = 0; r < 4; ++r) { const int p = 16 * w + 4 * gq + r; const float bias = a.sg_b_s[g * 128 + p];
#pragma unroll
            for (int ct = 0; ct < 8; ++ct) { const int c = 128 * g + 16 * ct + l15; const float u = bflo((unsigned)Z[(r0 + p) * 2048 + c]);
                ((unsigned char*)A2)[(r0 + p) * D + c] = (unsigned char)(pk4_fp8(u * (acc[ct][r] + bias), 0.f, 0.f, 0.f) & 0xffu); } }
    }
}

constexpr int N_LAUNCHES = MK_N_LAUNCHES;
__global__ void __launch_bounds__(512, 2) fwd_kernel(Args a_unused) {
    extern __shared__ __attribute__((aligned(16))) unsigned char lds_raw[];
    LAS unsigned char* lds = (LAS unsigned char*)lds_raw;
    const CAS Args* kp = (const CAS Args*)__builtin_amdgcn_kernarg_segment_ptr();
    {
        volatile LAS unsigned* MISC = (volatile LAS unsigned*)(lds + MISC_OFF);
        if (threadIdx.x < 64) MISC[threadIdx.x] = 0u;
        __syncthreads();
        if (N_LAUNCHES == 1) (void)xcd_barrier_post((unsigned*)(kp->ws + WS_CTL) + 1024, MISC + 8);
    }
#if defined(PHASE_MASK)
#define IN(k) ((((PHASE_MASK) >> (k)) & 1) && A.ph_lo <= (k) && (k) < A.ph_hi)
#elif defined(ONLY_PHASE)
#define IN(k) ((k) == ONLY_PHASE && A.ph_lo <= (k) && (k) < A.ph_hi)
#else
#define IN(k) (A.ph_lo <= (k) && (k) < A.ph_hi)
#endif
#ifdef TS_LO
#define TS_BEGIN(k) if ((k) == TS_LO && blockIdx.x == 0 && threadIdx.x == 0) { *(volatile unsigned long long*)(ws + WS_CTL + 32768) = __builtin_amdgcn_s_memrealtime(); }
#define TS_END(k) if ((k) == TS_HI - 1 && blockIdx.x == 0 && threadIdx.x == 0) { *(volatile unsigned long long*)(ws + WS_CTL + 32776) = __builtin_amdgcn_s_memrealtime(); }
#else
#define TS_BEGIN(k)
#define TS_END(k)
#endif
#define PHASE_BEGIN(k) { ArgsRef A = *launder_args(kp); if (IN(k)) { unsigned char* ws = A.ws; const int G = gridDim.x, bx = blockIdx.x; const int vcu = (G % 8 == 0) ? (bx % 8) * (G / 8) + bx / 8 : bx; (void)vcu; (void)ws; TS_BEGIN(k)
#define PHASE_END(k) if (N_LAUNCHES == 1 && (k) + 1 < A.ph_hi) { XcdBarrier bar; bar.bar = (unsigned*)(ws + WS_CTL) + 1024; bar.x = xb_xcc_id(); bar.st = (volatile LAS unsigned*)(lds + MISC_OFF) + 8; xcd_barrier(bar); } TS_END(k) } }
#define GLA_PTRS gla::Ptrs GP{(const bf16*)(ws + WS_V), (const bf16*)(ws + WS_KF), (const bf16*)(ws + WS_LFF), (const bf16*)(ws + WS_KB), (const bf16*)(ws + WS_LFB), (const bf16*)(ws + WS_Q), (const bf16*)(ws + WS_SG), \
                 (float*)(ws + WS_OF), (bf16*)(ws + WS_OG), A.hg_gnorm, (float*)(ws + WS_LST), (float*)(ws + WS_SENT), (float*)(ws + WS_LSTC), (float*)(ws + WS_DSUM), (float*)(ws + WS_DSUMC)}

    PHASE_BEGIN(0) phase_p0a(lds, A, G, vcu); PHASE_END(0)
    PHASE_BEGIN(1) phase_p0b(lds, A, G, vcu); PHASE_END(1)
    PHASE_BEGIN(2)
        const int NG = (G == 256) ? 168 : G;
        if (bx >= NG) convert_worker(lds, A, 0, Q_DONE0, (unsigned)NG);
        else {
            const float* LB = (const float*)(ws + WS_LB); LAS float* aux = (LAS float*)(lds + GEMM_AUX_OFF);
            for (int i = threadIdx.x; i < 2048; i += 512) aux[i] = LB[i];
            __syncthreads();
            pg8::Gemm g{(const bf16*)(ws + WS_H), (const bf16*)(ws + WS_WHIN), D, nullptr}; pg8::HinOrder S; S.init(NG, bx);
            pg8::EpiHin E{ws};
            pg8::gemm_phase<pg8::EpiHin, pg8::HinOrder, false, false, D>(lds, g, S, E);
            if (threadIdx.x == 0) __hip_atomic_fetch_add((unsigned*)(ws + WS_CTL) + Q_DONE0, 1u, __ATOMIC_RELAXED, __HIP_MEMORY_SCOPE_AGENT);
        }
    PHASE_END(2)
    PHASE_BEGIN(3) GLA_PTRS; gla::pass_a(lds, GP, G); PHASE_END(3)
    PHASE_BEGIN(4) GLA_PTRS; gla::pass_b(GP, G); PHASE_END(4)
    PHASE_BEGIN(5) GLA_PTRS; gla::pass_c(lds, GP, G); PHASE_END(5)
    PHASE_BEGIN(6)
        pg8::Gemm g{(const bf16*)(ws + WS_OG), (const bf16*)(ws + WS_WHOUT), D, nullptr}; pg8::GridOrder S; S.init(64, 4, G, bx, 0);
        pg8::EpiBf16<0> E{(bf16*)(ws + WS_Y), D, nullptr, 1.0f};
        pg8::gemm_phase<pg8::EpiBf16<0>, pg8::GridOrder, false, false, D>(lds, g, S, E);
    PHASE_END(6)
#define MOE_PHASES(l, p0) \
    PHASE_BEGIN(p0) phase_rowpass_a(lds, A, G, vcu, l); PHASE_END(p0) \
    PHASE_BEGIN(p0 + 1)   \
        if (bx >= NB * NE && G > NB * NE) convert_worker(lds, A, (l + 1) * 3072, (l) == 0 ? Q_DONE1 : Q_DONE2, (unsigned)(NB * NE)); \
        else { phase_topk(lds, A, G); if (G > NB * NE && threadIdx.x == 0) __hip_atomic_fetch_add((unsigned*)(ws + WS_CTL) + ((l) == 0 ? Q_DONE1 : Q_DONE2), 1u, __ATOMIC_RELAXED, __HIP_MEMORY_SCOPE_AGENT); } \
    PHASE_END(p0 + 1) \
    PHASE_BEGIN(p0 + 2)   \
        pg8::Gemm g{(const bf16*)(ws + WS_H), (const bf16*)(ws + WS_WGU + (size_t)(l) * NE * 4096 * D), D, (const int*)(ws + WS_ROWMAP)}; pg8::GridOrder S; S.init(128, 16, G, bx, 16); \
        pg8::fill_row_table(lds, S, (const unsigned*)(ws + WS_ROWMAP)); \
        pg8::EpiGU8 E{ws + WS_HID}; \
        pg8::gemm_phase<pg8::EpiGU8, pg8::GridOrder, true, true, D>(lds, g, S, E); \
    PHASE_END(p0 + 2) \
    PHASE_BEGIN(p0 + 3)   \
        pg8::Gemm g{(const bf16*)(ws + WS_HID), (const bf16*)(ws + WS_WD + (size_t)(l) * NE * D * FF), FF, nullptr}; pg8::GridOrder S; S.init(128, 4, G, bx, 4); \
        pg8::fill_row_table(lds, S, (const unsigned*)(ws + WS_GATE)); \
        pg8::EpiDown E{(bf16*)(ws + WS_YP), 0.03125f}; \
        pg8::gemm_phase<pg8::EpiDown, pg8::GridOrder, false, true, FF>(lds, g, S, E); \
    PHASE_END(p0 + 3) \
    PHASE_BEGIN(p0 + 4) phase_rowpass_b(A, G, vcu, l); PHASE_END(p0 + 4)

    MOE_PHASES(0, 7)
    PHASE_BEGIN(12)
        pg8::Gemm g{(const bf16*)(ws + WS_H), (const bf16*)(ws + WS_WSIN), D, nullptr}; pg8::GridOrder S; S.init(64, 8, G, bx, 0);
        pg8::EpiBf16<1> E{(bf16*)(ws + WS_Z), 2 * D, (float*)(ws + WS_STATS), 0.03125f};
        pg8::gemm_phase<pg8::EpiBf16<1>, pg8::GridOrder, false, true, D>(lds, g, S, E);
    PHASE_END(12)
    PHASE_BEGIN(13) phase_sgu_mix(lds, A, G); PHASE_END(13)
    PHASE_BEGIN(14)
        pg8::Gemm g{(const bf16*)(ws + WS_A2), (const bf16*)(ws + WS_WSOUT), D, nullptr}; pg8::GridOrder S; S.init(64, 4, G, bx, 0);
        pg8::EpiBf16<0> E{(bf16*)(ws + WS_Y), D, nullptr, 0.03125f};
        pg8::gemm_phase<pg8::EpiBf16<0>, pg8::GridOrder, false, true, D>(lds, g, S, E);
    PHASE_END(14)
    MOE_PHASES(1, 15)
#undef IN
}

extern "C" void kernel_launch(void* const* d_in, const int* in_sizes, int n_in, void* d_out, int out_size, void* d_ws, size_t ws_size, hipStream_t stream) {
    static int grid = 0;
    if (grid == 0) {
        if (n_in != 21 || in_sizes[0] != M * D || out_size != M * D || ws_size < WS_END) {
            fprintf(stderr, "kernel_launch: unexpected problem (n_in %d, in0 %d, out %d, ws %zu; need ws >= %zu); nothing launched\n", n_in, n_in > 0 ? in_sizes[0] : -1, out_size, ws_size, (size_t)WS_END); grid = -1; return; }
        int dev = 0, cus = 0, per_cu = 0;
        if (hipGetDevice(&dev) != hipSuccess || hipDeviceGetAttribute(&cus, hipDeviceAttributeMultiprocessorCount, dev) != hipSuccess) { grid = -1; return; }
        if (hipFuncSetAttribute((const void*)fwd_kernel, hipFuncAttributeMaxDynamicSharedMemorySize, LDS_BYTES) != hipSuccess) { fprintf(stderr, "kernel_launch: hipFuncSetAttribute failed\n"); grid = -1; return; }
        if (hipOccupancyMaxActiveBlocksPerMultiprocessor(&per_cu, (const void*)fwd_kernel, 512, LDS_BYTES) != hipSuccess || per_cu < 1) { fprintf(stderr, "kernel_launch: occupancy query reports %d blocks per CU\n", per_cu); (void)hipGetLastError(); }
        grid = cus;
    }
    if (grid < 0) return;
    (void)hipMemsetAsync((char*)d_ws + WS_CTL, 0, CTL_ZERO_BYTES, stream);
    Args a{};
    const float** fp = (const float**)&a;
    for (int i = 0; i < 21; ++i) fp[i] = (const float*)d_in[i];
    a.out = (float*)d_out; a.ws = (unsigned char*)d_ws;
    if (N_LAUNCHES == 1) { a.ph_lo = 0; a.ph_hi = NPHASE; a.li = 0; hipLaunchKernelGGL(fwd_kernel, dim3(grid), dim3(512), LDS_BYTES, stream, a); }
    else for (int li = 0; li < NPHASE; ++li) { a.ph_lo = li; a.ph_hi = li + 1; a.li = li; hipLaunchKernelGGL(fwd_kernel, dim3(grid), dim3(512), LDS_BYTES, stream, a); }
}
```

```cpp
#include <hip/hip_runtime.h>
#include <cstdio>
#include <cstdint>

#ifndef MK_N_LAUNCHES
#define MK_N_LAUNCHES 1
#endif

#define LAS __attribute__((address_space(3)))
typedef unsigned short bf16;
typedef short bf16x8 __attribute__((ext_vector_type(8)));
typedef short s16x4 __attribute__((ext_vector_type(4)));
typedef float f32x4 __attribute__((ext_vector_type(4)));
typedef float f32x2 __attribute__((ext_vector_type(2)));
typedef unsigned u32x4 __attribute__((ext_vector_type(4)));
typedef unsigned u32x2 __attribute__((ext_vector_type(2)));
typedef __bf16 bf16x2_t __attribute__((ext_vector_type(2)));
typedef int v8i __attribute__((ext_vector_type(8)));
typedef int v4i __attribute__((ext_vector_type(4)));

constexpr int NB = 2, T = 8192, D = 1024, M = NB * T, CTX = 256, MC = NB * CTX, MT = M + MC;
constexpr int NH = 8, HD = 128, NE = 16, CAP = 1024, FF = 2048, NPAIR = NB * NE * CAP;
constexpr int SCT = 512, NSC = T / SCT;
constexpr float EPS = 1e-6f;
constexpr int NPHASE = 20;

constexpr size_t MiB = 1u << 20;
constexpr size_t WS_CTL = 0, CTL_ZERO_BYTES = 64 * 1024;
constexpr size_t WS_LB = 1 * MiB;
constexpr size_t WS_MOD = 1 * MiB + 64 * 1024;
constexpr size_t WS_MODP = 2 * MiB;
constexpr size_t WS_WS = 4 * MiB;
constexpr size_t WS_WHIN = 5 * MiB;
constexpr size_t WS_WHOUT = 15 * MiB;
constexpr size_t WS_WSIN = 17 * MiB;
constexpr size_t WS_WSOUT = 21 * MiB;
constexpr size_t WS_WGU = 24 * MiB;
constexpr size_t WS_WD = 280 * MiB;
constexpr size_t WS_XR = 408 * MiB;
constexpr size_t WS_H = 472 * MiB;
constexpr size_t WS_R1 = 505 * MiB;
constexpr size_t WS_V = WS_R1, WS_KF = WS_V + 33 * MiB, WS_LFF = WS_KF + 33 * MiB, WS_KB = WS_LFF + 33 * MiB, WS_LFB = WS_KB + 33 * MiB;
constexpr size_t WS_Q = WS_LFB + 33 * MiB, WS_SG = WS_Q + 32 * MiB;
constexpr size_t WS_HID = WS_R1, WS_YP = WS_R1 + 128 * MiB;
constexpr size_t WS_Z = WS_R1, WS_A2 = WS_R1 + 64 * MiB, WS_STATS = WS_R1 + 96 * MiB;
constexpr size_t WS_OG = 734 * MiB;
constexpr size_t WS_OF = 766 * MiB;
constexpr size_t WS_LST = 830 * MiB;
constexpr size_t WS_SENT = 862 * MiB;
constexpr size_t WS_LSTC = 932 * MiB;
constexpr size_t WS_DSUM = 896 * MiB;
constexpr size_t WS_Y = 897 * MiB;
constexpr size_t WS_AFF = 929 * MiB;
constexpr size_t WS_ROWMAP = 930 * MiB;
constexpr size_t WS_GATE = 930 * MiB + 512 * 1024;
constexpr size_t WS_INV = 931 * MiB;
constexpr size_t WS_DSUMC = 896 * MiB + 512 * 1024;
constexpr size_t WS_END = 940 * MiB;

constexpr int LDS_BYTES = 163840;
constexpr int GEMM_TAB_OFF = 131072;
constexpr int GEMM_AUX_OFF = 131072 + 8192;
constexpr int MISC_OFF = LDS_BYTES - 256;
constexpr int HALF_LDS = 81792;

__device__ __forceinline__ float bflo(unsigned u) { return __uint_as_float(u << 16); }
__device__ __forceinline__ float bfhi(unsigned u) { return __uint_as_float(u & 0xffff0000u); }
__device__ __forceinline__ unsigned pk2(float lo, float hi) { f32x2 v = {lo, hi}; bf16x2_t b = __builtin_convertvector(v, bf16x2_t); return __builtin_bit_cast(unsigned, b); }
__device__ __forceinline__ unsigned pk4_fp8(float a, float b, float c, float d) {
    a = __builtin_amdgcn_fmed3f(a, -448.f, 448.f); b = __builtin_amdgcn_fmed3f(b, -448.f, 448.f); c = __builtin_amdgcn_fmed3f(c, -448.f, 448.f); d = __builtin_amdgcn_fmed3f(d, -448.f, 448.f);
    unsigned w = 0u; w = __builtin_amdgcn_cvt_pk_fp8_f32(a, b, w, false); w = __builtin_amdgcn_cvt_pk_fp8_f32(c, d, w, true); return w;
}
#define DPP_ADD(v, ctrl) ((v) + __builtin_bit_cast(float, __builtin_amdgcn_update_dpp(0, __builtin_bit_cast(int, (v)), (ctrl), 0xF, 0xF, true)))
__device__ __forceinline__ float row16_sum(float v) {
    v = DPP_ADD(v, 0xB1); v = DPP_ADD(v, 0x4E); v = DPP_ADD(v, 0x141); v = DPP_ADD(v, 0x140);
    return v;
}
__device__ __forceinline__ float wave_sum(float v) {
    v = row16_sum(v);
    const float s0 = __builtin_bit_cast(float, __builtin_amdgcn_readlane(__builtin_bit_cast(int, v), 0)), s1 = __builtin_bit_cast(float, __builtin_amdgcn_readlane(__builtin_bit_cast(int, v), 16));
    const float s2 = __builtin_bit_cast(float, __builtin_amdgcn_readlane(__builtin_bit_cast(int, v), 32)), s3 = __builtin_bit_cast(float, __builtin_amdgcn_readlane(__builtin_bit_cast(int, v), 48));
    return (s0 + s1) + (s2 + s3);
}
__device__ __forceinline__ float sigmoidf_(float x) { return __builtin_amdgcn_rcpf(1.0f + __expf(-x)); }
__device__ __forceinline__ float siluf_(float x) { return x * __builtin_amdgcn_rcpf(1.0f + __expf(-x)); }
__device__ __forceinline__ float gelu_tanh(float x) { const float u = 0.7978845608028654f * (x + 0.044715f * x * x * x); return x * __builtin_amdgcn_rcpf(1.0f + __expf(-2.0f * u)); }
__device__ __forceinline__ int opaque_tid() { int t = threadIdx.x; asm volatile("" : "+v"(t)); return t; }
#define LDS_WAIT() asm volatile("s_waitcnt lgkmcnt(0)" ::: "memory")
#define VM_WAIT() asm volatile("s_waitcnt vmcnt(0)" ::: "memory")

#define XB_TMO      128
#define XB_XCNT(j)  (256  + 64 * (j))
#define XB_XSUB(j)  (1280 + 64 * (j))
#define XB_XGEN(j)  (2304 + 64 * (j))
#define XB_TOP      3328
#define XB_TOPGEN   3392
#define XCD_BAR_WORDS 3456
#define XB_SPIN_CAP (1u << 22)
__device__ __forceinline__ unsigned xb_ld(unsigned* p)              { return __hip_atomic_load(p, __ATOMIC_RELAXED, __HIP_MEMORY_SCOPE_AGENT); }
__device__ __forceinline__ unsigned xb_add(unsigned* p, unsigned v) { return __hip_atomic_fetch_add(p, v, __ATOMIC_RELAXED, __HIP_MEMORY_SCOPE_AGENT); }
__device__ __forceinline__ unsigned xb_xcc_id() { return (unsigned)__builtin_amdgcn_s_getreg((3 << 11) | 20) & 0xFu; }
#define XB_SPIN(cond, bar) do { unsigned _sp = 0; while (cond) { __builtin_amdgcn_s_sleep(1); \
    if ((++_sp & 255u) == 0u) { if (xb_ld(&(bar)[XB_TMO])) break; if (_sp > XB_SPIN_CAP) { atomicAdd(&(bar)[XB_TMO], 1u); break; } } } } while (0)
struct XcdBarrier { unsigned* bar; unsigned x; volatile LAS unsigned* st; };
__device__ __forceinline__ XcdBarrier xcd_barrier_post(unsigned* bar, volatile LAS unsigned* st) {
    XcdBarrier b; b.bar = bar; b.x = xb_xcc_id(); b.st = st;
    if (threadIdx.x == 0) (void)xb_add(&bar[XB_XCNT(b.x)], 1u);
    return b;
}
__device__ __forceinline__ void xcd_barrier_complete(unsigned* bar, unsigned x, unsigned& nloc, unsigned& nx) {
    const unsigned G = gridDim.x * gridDim.y * gridDim.z;
    unsigned sum, cnt, mine, sp = 0u;
    for (;;) {
        sum = 0u; cnt = 0u; mine = 0u;
#pragma unroll
        for (unsigned j = 0; j < 16; ++j) { const unsigned c = xb_ld(&bar[XB_XCNT(j)]); sum += c; cnt += (c > 0u) ? 1u : 0u; mine = (j == x) ? c : mine; }
        if (sum == G) break;
        __builtin_amdgcn_s_sleep(1);
        if ((++sp & 255u) == 0u) { if (xb_ld(&bar[XB_TMO])) break; if (sp > XB_SPIN_CAP) { atomicAdd(&bar[XB_TMO], 1u); break; } }
    }
    nloc = mine > 0u ? mine : 1u; nx = cnt > 0u ? cnt : 1u;
}
__device__ __forceinline__ void xcd_barrier(const XcdBarrier& b) {
    asm volatile("s_waitcnt vmcnt(0)" ::: "memory");
    __syncthreads();
    if (threadIdx.x == 0) {
        unsigned* bar = b.bar;
        __builtin_amdgcn_s_waitcnt(0);
        unsigned nloc = b.st[0], nx = b.st[1];
        if (nloc == 0u) { xcd_barrier_complete(bar, b.x, nloc, nx); b.st[0] = nloc; b.st[1] = nx; }
        const unsigned old = xb_add(&bar[XB_XSUB(b.x)], 1u);
        const unsigned gen = old / nloc;
        asm volatile("buffer_inv sc1" ::: "memory");
        if (old + 1u == (gen + 1u) * nloc) {
            __builtin_amdgcn_fence(__ATOMIC_RELEASE, "agent");
            asm volatile("s_waitcnt vmcnt(0)" ::: "memory");
            const unsigned og = xb_add(&bar[XB_TOP], 1u);
            const unsigned tg = og / nx;
            if (og + 1u == (tg + 1u) * nx) xb_add(&bar[XB_TOPGEN], 1u);
            else XB_SPIN(xb_ld(&bar[XB_TOPGEN]) == tg, bar);
            asm volatile("" ::: "memory");
            xb_add(&bar[XB_XGEN(b.x)], 1u);
            asm volatile("s_waitcnt vmcnt(0)" ::: "memory");
        } else {
            XB_SPIN(xb_ld(&bar[XB_XGEN(b.x)]) == gen, bar);
            asm volatile("s_waitcnt vmcnt(0)" ::: "memory");
        }
    }
    __syncthreads();
}

namespace pg8 {
constexpr int BM = 256, BK = 64, HALF = 128, HTB = HALF * BK * 2, STAGE_BYTES = 8 * HTB, NXCD = 8, WGM = 8;
__host__ __device__ __forceinline__ int lds_byte(int r, int c) { const int st = (r >> 4) * 2 + (c >> 5), rr = r & 15, cc = c & 31, ob = rr * 64 + cc * 2; return st * 1024 + (ob ^ (((ob >> 9) & 1) << 5)); }
__host__ __device__ __forceinline__ void stage_rc(int b, int& R, int& C) { const int st = b / 1024, sb = b % 1024, swz = sb ^ (((sb >> 9) & 1) << 5); R = (st >> 1) * 16 + swz / 64; C = (st & 1) * 32 + (swz % 64) / 2; }
__host__ __device__ __forceinline__ int perm32(int rho) { const int n = rho >> 4, i = rho & 15; return 8 * (i >> 2) + 4 * n + (i & 3); }

struct Unit { int pm, pn, bt; };
struct Gemm { const bf16* A; const bf16* Bt; int K; const int* rowmap; };

struct GridOrder {
    int nM, nN, nwg, G, c, bmul;
    __device__ void init(int nM_, int nN_, int G_, int c_, int bmul_) { nM = nM_; nN = nN_; nwg = nM * nN; G = G_; c = c_; bmul = bmul_; }
    __device__ __forceinline__ bool next(int i, Unit& u) const {
        const long L = (long)i * G + c; if (L >= nwg) return false;
        int wgid = (int)L; { const int q = nwg / NXCD, r = nwg % NXCD, xcd = wgid % NXCD, off = wgid / NXCD; wgid = (xcd < r ? xcd * (q + 1) : r * (q + 1) + (xcd - r) * q) + off; }
        const int nig = WGM * nN, gid = wgid / nig, fm = gid * WGM, gsz = (nM - fm) < WGM ? (nM - fm) : WGM;
        u.pm = fm + ((wgid % nig) % gsz); u.pn = (wgid % nig) / gsz; u.bt = bmul ? (u.pm >> 3) * bmul + u.pn : u.pn; return true;
    }
};
struct HinOrder {
    GridOrder g;
    __device__ void init(int G_, int c_) { g.init(64, 20, G_, c_, 0); }
    __device__ __forceinline__ bool next(int i, Unit& u) const {
        const long L = (long)i * g.G + g.c;
        if (L < 1280) return g.next(i, u);
        const int r = (int)L - 1280; if (r >= 24) return false;
        u.pm = 64 + r / 12; u.pn = r % 12; u.bt = u.pn; return true;
    }
};

__device__ __forceinline__ unsigned cvt_pk_bf16(float lo, float hi) { return pk2(lo, hi); }


template <class Epi, class Sched, bool GATHER, bool F8 = false, int KC = 0>
__device__ __forceinline__ void gemm_phase(LAS unsigned char* lds, const Gemm g, const Sched& S, const Epi& E) {
    const int tid = opaque_tid(), wid = __builtin_amdgcn_readfirstlane(tid >> 6), lane = tid & 63, wr = wid >> 2, wc = wid & 3, fr = lane & 15, fq = lane >> 4;
    const int K = KC ? KC : g.K, KB = F8 ? K : 2 * K  , ntr = KB / (BK * 2);
#ifdef DUPK
    const int nt = (GATHER && F8) ? 2 * ntr : ntr;
#define KWRAP(t_) ((t_) % ntr)
#else
    const int nt = ntr;
#define KWRAP(t_) (t_)
#endif
    int RA[2], CA[2]; unsigned voffB[2], voffA[2];
#pragma unroll
    for (int i = 0; i < 2; ++i) { int R, C; stage_rc(tid * 16 + i * 8192, R, C); RA[i] = R; CA[i] = C; const int Rb = (R & ~31) + perm32(R & 31); voffB[i] = (unsigned)(Rb * KB + C * 2); voffA[i] = (unsigned)(R * KB + C * 2); }
    const size_t kstep = (size_t)(BK * 2);
    const size_t hstep = (size_t)HALF * KB;
    const size_t tstep = 2 * hstep;
    const unsigned ldsw = (unsigned)wid * 1024u;
    const int aoff = lds_byte(wr * 64 + fr, fq * 8), boff = lds_byte(wc * 32 + fr, fq * 8);
    LAS int* tab = (LAS int*)(lds + GEMM_TAB_OFF);
#define PG8_SA(b, h) (((b) * 2 + (h)) * HTB)
#define PG8_SB(b, h) ((4 + (b) * 2 + (h)) * HTB)
#define PG8_STAGE_B(bufoff, gbase) do { _Pragma("unroll") for (int _i = 0; _i < 2; ++_i) \
        __builtin_amdgcn_global_load_lds((const unsigned*)((const char*)(gbase) + voffB[_i]), (LAS unsigned*)(lds + (bufoff) + ldsw + _i * 8192), 16, 0, 0); } while (0)
#define PG8_STAGE_A(bufoff, koff, nx, h) do { _Pragma("unroll") for (int _i = 0; _i < 2; ++_i) { \
        const char* _p = GATHER ? (const char*)g.A + (koff) + ((nx) ? o2[h][_i] : oAc[h][_i]) : ((nx) ? a2b : cAb) + (koff) + (h) * hstep + voffA[_i]; \
        __builtin_amdgcn_global_load_lds((const unsigned*)_p, (LAS unsigned*)(lds + (bufoff) + ldsw + _i * 8192), 16, 0, 0); } } while (0)
#define PG8_LDA(dst, b, h) do { _Pragma("unroll") for (int m = 0; m < 4; ++m) { const v4i lo_ = *(const LAS v4i*)(lds + PG8_SA(b, h) + aoff + m * 2048), hi_ = *(const LAS v4i*)(lds + PG8_SA(b, h) + aoff + m * 2048 + 1024); dst[m] = __builtin_shufflevector(lo_, hi_, 0, 1, 2, 3, 4, 5, 6, 7); } } while (0)
#define PG8_LDB(dst, b, h) do { _Pragma("unroll") for (int n = 0; n < 2; ++n) { const v4i lo_ = *(const LAS v4i*)(lds + PG8_SB(b, h) + boff + n * 2048), hi_ = *(const LAS v4i*)(lds + PG8_SB(b, h) + boff + n * 2048 + 1024); dst[n] = __builtin_shufflevector(lo_, hi_, 0, 1, 2, 3, 4, 5, 6, 7); } } while (0)
#define PG8_MMA(ai, bj, At, Bt) do { __builtin_amdgcn_s_setprio(1); _Pragma("unroll") for (int m = 0; m < 4; ++m) _Pragma("unroll") for (int n = 0; n < 2; ++n) { \
        if constexpr (F8) {   \
            asm volatile("v_mfma_scale_f32_16x16x128_f8f6f4 %0, %1, %2, %0, %3, %3 op_sel_hi:[0,0,0]" : "+v"(acc[ai][bj][m][n]) : "v"(Bt[n]), "v"(At[m]), "v"(one_scale));   \
        } else { \
            acc[ai][bj][m][n] = __builtin_amdgcn_mfma_f32_16x16x32_bf16(__builtin_bit_cast(bf16x8, __builtin_shufflevector(Bt[n], Bt[n], 0, 1, 2, 3)), __builtin_bit_cast(bf16x8, __builtin_shufflevector(At[m], At[m], 0, 1, 2, 3)), acc[ai][bj][m][n], 0, 0, 0); \
            acc[ai][bj][m][n] = __builtin_amdgcn_mfma_f32_16x16x32_bf16(__builtin_bit_cast(bf16x8, __builtin_shufflevector(Bt[n], Bt[n], 4, 5, 6, 7)), __builtin_bit_cast(bf16x8, __builtin_shufflevector(At[m], At[m], 4, 5, 6, 7)), acc[ai][bj][m][n], 0, 0, 0); } } \
        __builtin_amdgcn_s_setprio(0); } while (0)
#define PG8_WAIT_V(n) asm volatile("s_waitcnt vmcnt(" #n ")" ::: "memory")
#define PG8_WAIT_L(n) asm volatile("s_waitcnt lgkmcnt(" #n ")" ::: "memory")
#define PG8_BAR __builtin_amdgcn_s_barrier()
#define PG8_SCHED __builtin_amdgcn_sched_barrier(0)
#define PG8_AOFFS(o, ui) do { _Pragma("unroll") for (int _h = 0; _h < 2; ++_h) _Pragma("unroll") for (int _i = 0; _i < 2; ++_i) { \
        const int _row = tab[(ui) * 256 + _h * HALF + RA[_i]]; (o)[_h][_i] = (unsigned)(_row * KB + CA[_i] * 2); } } while (0)
    Unit cur, nxt; int ui = 0;
    if (!S.next(0, cur)) return;
    int one_scale = 0x7f7f7f7f; asm volatile("" : "+v"(one_scale));
    f32x4 acc[2][2][4][2];
#pragma unroll
    for (int a = 0; a < 2; ++a)
#pragma unroll
        for (int b = 0; b < 2; ++b)
#pragma unroll
            for (int m = 0; m < 4; ++m)
#pragma unroll
                for (int n = 0; n < 2; ++n) acc[a][b][m][n] = (f32x4){0.f, 0.f, 0.f, 0.f};
    v8i At[4], B0[2], B1[2];
    unsigned oAc[2][2], oAn[2][2], o2[2][2];
#pragma unroll
    for (int h = 0; h < 2; ++h)
#pragma unroll
        for (int i = 0; i < 2; ++i) { oAc[h][i] = 0u; oAn[h][i] = 0u; o2[h][i] = 0u; }
    if (GATHER) { PG8_AOFFS(oAc, 0); }
    const char* cAb = (const char*)g.A + (size_t)cur.pm * tstep; const char* a2b = cAb;
    const char* cB = (const char*)g.Bt + (size_t)cur.bt * tstep;
    PG8_STAGE_B(PG8_SB(0, 0), cB); PG8_STAGE_B(PG8_SB(0, 1), cB + hstep); PG8_STAGE_A(PG8_SA(0, 0), 0, 0, 0); PG8_STAGE_A(PG8_SA(0, 1), 0, 0, 1);
    if (wr == 1) PG8_BAR;
    PG8_WAIT_V(2); PG8_BAR;
    PG8_STAGE_B(PG8_SB(1, 0), cB + kstep); PG8_STAGE_A(PG8_SA(1, 0), kstep, 0, 0); PG8_STAGE_B(PG8_SB(1, 1), cB + hstep + kstep);
    PG8_WAIT_V(6); PG8_BAR;
    for (;;) {
        const bool has_next = S.next(ui + 1, nxt);
        if (GATHER) {
            if (has_next) { PG8_AOFFS(oAn, ui + 1); }
            else {
#pragma unroll
                for (int h = 0; h < 2; ++h)
#pragma unroll
                    for (int i = 0; i < 2; ++i) oAn[h][i] = oAc[h][i];
            }
        }
        const char* nAb = has_next ? (const char*)g.A + (size_t)nxt.pm * tstep : cAb;
        const char* nB = has_next ? (const char*)g.Bt + (size_t)nxt.bt * tstep : cB;
#pragma unroll 1
        for (int t = 0; t < nt; t += 2) {
            const bool last = (t == nt - 2);
            const size_t k1 = (size_t)KWRAP(t + 1) * kstep;
            const size_t k2 = last ? 0 : (size_t)KWRAP(t + 2) * kstep, k3 = k2 + kstep;
            if (GATHER) {
#pragma unroll
                for (int h = 0; h < 2; ++h)
#pragma unroll
                    for (int i = 0; i < 2; ++i) o2[h][i] = last ? oAn[h][i] : oAc[h][i];
            }
            a2b = last ? nAb : cAb;
            const char* b2 = last ? nB : cB + (size_t)KWRAP(t + 2) * kstep; const char* b3 = b2 + kstep;
            PG8_LDB(B0, 0, 0); PG8_LDB(B1, 0, 1); PG8_SCHED; PG8_LDA(At, 0, 0); PG8_STAGE_A(PG8_SA(1, 1), k1, 0, 1);
            PG8_WAIT_V(8); PG8_WAIT_L(0); PG8_BAR; PG8_MMA(0, 0, At, B0); PG8_MMA(0, 1, At, B1); PG8_BAR; PG8_SCHED;
            PG8_LDA(At, 0, 1); PG8_STAGE_B(PG8_SB(0, 0), b2); PG8_STAGE_B(PG8_SB(0, 1), b2 + hstep); PG8_STAGE_A(PG8_SA(0, 0), k2, 1, 0);
            PG8_WAIT_V(8); PG8_WAIT_L(0); PG8_BAR; PG8_MMA(1, 0, At, B0); PG8_MMA(1, 1, At, B1); PG8_BAR; PG8_SCHED;
            PG8_LDB(B0, 1, 0); PG8_LDB(B1, 1, 1); PG8_SCHED; PG8_LDA(At, 1, 0); PG8_STAGE_A(PG8_SA(0, 1), k2, 1, 1);
            PG8_WAIT_V(8); PG8_WAIT_L(0); PG8_BAR; PG8_MMA(0, 0, At, B0); PG8_MMA(0, 1, At, B1); PG8_BAR; PG8_SCHED;
            PG8_LDA(At, 1, 1); PG8_STAGE_B(PG8_SB(1, 0), b3); PG8_STAGE_B(PG8_SB(1, 1), b3 + hstep); PG8_STAGE_A(PG8_SA(1, 0), k3, 1, 0);
            PG8_WAIT_V(8); PG8_WAIT_L(0); PG8_BAR; PG8_MMA(1, 0, At, B0); PG8_MMA(1, 1, At, B1); PG8_BAR; PG8_SCHED;
        }
        if (wr == 0) PG8_BAR;
        if constexpr (F8) asm volatile("s_nop 15\n\ts_nop 15" ::: "memory");
        E(acc, cur, ui, wr, wc, fr, fq, lds);
        if (!has_next) break;
#pragma unroll
        for (int a = 0; a < 2; ++a)
#pragma unroll
            for (int b = 0; b < 2; ++b)
#pragma unroll
                for (int m = 0; m < 4; ++m)
#pragma unroll
                    for (int n = 0; n < 2; ++n) acc[a][b][m][n] = (f32x4){0.f, 0.f, 0.f, 0.f};
        cur = nxt; cB = nB; cAb = nAb; ++ui;
        if (GATHER) {
#pragma unroll
            for (int h = 0; h < 2; ++h)
#pragma unroll
                for (int i = 0; i < 2; ++i) oAc[h][i] = oAn[h][i];
        }
        if (wr == 1) PG8_BAR;
    }
    PG8_WAIT_V(0);
    PG8_BAR;
#undef PG8_SA
#undef PG8_SB
#undef PG8_STAGE_A
#undef PG8_STAGE_B
#undef PG8_LDA
#undef PG8_LDB
#undef PG8_MMA
#undef PG8_WAIT_V
#undef PG8_WAIT_L
#undef PG8_BAR
#undef PG8_SCHED
#undef PG8_AOFFS
}

#define EPI_ROWS_BEGIN(u) \
    _Pragma("unroll") for (int ai = 0; ai < 2; ++ai) _Pragma("unroll") for (int m = 0; m < 4; ++m) { const int row = (u).pm * BM + ai * HALF + wr * 64 + m * 16 + fr; const int rloc = ai * HALF + wr * 64 + m * 16 + fr; (void)rloc; (void)row;
#define EPI_ROWS_END }

struct EpiHin {
    unsigned char* ws;
    __device__ __forceinline__ void operator()(const f32x4 (&acc)[2][2][4][2], const Unit& u, int ui, int wr, int wc, int fr, int fq, LAS unsigned char* lds) const {
        const int region = u.pn >> 2, cc0 = (u.pn & 3) * 256 + wc * 32 + 8 * fq;
        const LAS float* lbt = (const LAS float*)(lds + GEMM_AUX_OFF);
        if (region == 0 || region >= 3) {
            bf16* O = (bf16*)(ws + (region == 0 ? WS_V : (region == 3 ? WS_Q : WS_SG)));
            EPI_ROWS_BEGIN(u)
                bf16* rowp = O + (size_t)row * D + cc0;
#pragma unroll
                for (int bj = 0; bj < 2; ++bj) { f32x4 v0 = acc[ai][bj][m][0], v1 = acc[ai][bj][m][1];
                    if (region != 0) {
#pragma unroll
                        for (int j = 0; j < 4; ++j) { v0[j] = siluf_(v0[j]); v1[j] = siluf_(v1[j]); } }
                    u32x4 w; w.x = pk2(v0[0], v0[1]); w.y = pk2(v0[2], v0[3]); w.z = pk2(v1[0], v1[1]); w.w = pk2(v1[2], v1[3]);
                    *(u32x4*)(rowp + bj * HALF) = w; }
            EPI_ROWS_END
        } else {
            bf16* OL = (bf16*)(ws + (region == 1 ? WS_LFF : WS_LFB));
            EPI_ROWS_BEGIN(u)
                const size_t ro = (size_t)row * D + cc0;
#pragma unroll
                for (int bj = 0; bj < 2; ++bj) {
                    const f32x4 l0 = *(const LAS f32x4*)(lbt + (region - 1) * 1024 + cc0 + bj * HALF), l1 = *(const LAS f32x4*)(lbt + (region - 1) * 1024 + cc0 + bj * HALF + 4);
                    f32x4 f0, f1;
#pragma unroll
                    for (int j = 0; j < 4; ++j) {
                        { const float a = acc[ai][bj][m][0][j], l = l0[j], sg = __builtin_amdgcn_rcpf(1.0f + __expf(-a)); f0[j] = __builtin_amdgcn_logf(l + (1.0f - l) * sg); }
                        { const float a = acc[ai][bj][m][1][j], l = l1[j], sg = __builtin_amdgcn_rcpf(1.0f + __expf(-a)); f1[j] = __builtin_amdgcn_logf(l + (1.0f - l) * sg); }
                    }
                    u32x4 w; w.x = pk2(f0[0], f0[1]); w.y = pk2(f0[2], f0[3]); w.z = pk2(f1[0], f1[1]); w.w = pk2(f1[2], f1[3]);
                    *(u32x4*)(OL + ro + bj * HALF) = w; }
            EPI_ROWS_END
        }
    }
};
template <int ACT> struct EpiBf16 {
    bf16* O; int ldc; float* stats; float scale;
    __device__ __forceinline__ void operator()(const f32x4 (&acc)[2][2][4][2], const Unit& u, int ui, int wr, int wc, int fr, int fq, LAS unsigned char* lds) const {
        const int col0 = u.pn * BM + wc * 32 + 8 * fq;
        EPI_ROWS_BEGIN(u)
            bf16* rowp = O + (size_t)row * ldc + col0; float s1 = 0.f, s2 = 0.f;
#pragma unroll
            for (int bj = 0; bj < 2; ++bj) { f32x4 v0 = acc[ai][bj][m][0] * scale, v1 = acc[ai][bj][m][1] * scale;
                if (ACT == 1) {
#pragma unroll
                    for (int j = 0; j < 4; ++j) { v0[j] = gelu_tanh(v0[j]); v1[j] = gelu_tanh(v1[j]); s1 += v0[j] + v1[j]; s2 += v0[j] * v0[j] + v1[j] * v1[j]; } }
                u32x4 w; w.x = pk2(v0[0], v0[1]); w.y = pk2(v0[2], v0[3]); w.z = pk2(v1[0], v1[1]); w.w = pk2(v1[2], v1[3]);
                *(u32x4*)(rowp + bj * HALF) = w; }
            if (ACT == 1) { s1 += __shfl_xor(s1, 16); s1 += __shfl_xor(s1, 32); s2 += __shfl_xor(s2, 16); s2 += __shfl_xor(s2, 32);
                if (u.pn >= 4 && fq == 0) *(f32x2*)(stats + ((size_t)row * 16 + (u.pn - 4) * 4 + wc) * 2) = (f32x2){s1, s2}; }
        EPI_ROWS_END
    }
};
struct EpiGU {
    bf16* Hd;
    __device__ __forceinline__ void operator()(const f32x4 (&acc)[2][2][4][2], const Unit& u, int ui, int wr, int wc, int fr, int fq, LAS unsigned char* lds) const {
        const int col0 = u.pn * HALF + wc * 32 + 8 * fq;
        EPI_ROWS_BEGIN(u)
            f32x4 g0 = acc[ai][0][m][0], g1 = acc[ai][0][m][1], u0 = acc[ai][1][m][0], u1 = acc[ai][1][m][1];
#pragma unroll
            for (int j = 0; j < 4; ++j) { g0[j] = siluf_(g0[j]) * u0[j]; g1[j] = siluf_(g1[j]) * u1[j]; }
            u32x4 w; w.x = pk2(g0[0], g0[1]); w.y = pk2(g0[2], g0[3]); w.z = pk2(g1[0], g1[1]); w.w = pk2(g1[2], g1[3]);
            *(u32x4*)(Hd + (size_t)row * FF + col0) = w;
        EPI_ROWS_END
    }
};
struct EpiGU8 {
    unsigned char* Hd;
    __device__ __forceinline__ void operator()(const f32x4 (&acc)[2][2][4][2], const Unit& u, int ui, int wr, int wc, int fr, int fq, LAS unsigned char* lds) const {
        const int col0 = u.pn * HALF + wc * 32 + 8 * fq;
        EPI_ROWS_BEGIN(u)
#ifdef DUPK
            constexpr float GS = 0.015625f;
#else
            constexpr float GS = 0.03125f;
#endif
            f32x4 g0 = acc[ai][0][m][0] * GS, g1 = acc[ai][0][m][1] * GS, u0 = acc[ai][1][m][0] * GS, u1 = acc[ai][1][m][1] * GS;
#pragma unroll
            for (int j = 0; j < 4; ++j) { g0[j] = siluf_(g0[j]) * u0[j]; g1[j] = siluf_(g1[j]) * u1[j]; }
            u32x2 w; w.x = pk4_fp8(g0[0], g0[1], g0[2], g0[3]); w.y = pk4_fp8(g1[0], g1[1], g1[2], g1[3]);
            *(u32x2*)(Hd + (size_t)row * FF + col0) = w;
        EPI_ROWS_END
    }
};
struct EpiDown {
    bf16* Yp; float scale;
    __device__ __forceinline__ void operator()(const f32x4 (&acc)[2][2][4][2], const Unit& u, int ui, int wr, int wc, int fr, int fq, LAS unsigned char* lds) const {
        const int col0 = u.pn * BM + wc * 32 + 8 * fq;
        const LAS float* gt = (const LAS float*)(lds + GEMM_TAB_OFF) + ui * 256;
        EPI_ROWS_BEGIN(u)
            const float gv = gt[rloc] * scale * 16.0f; unsigned char* rowp = (unsigned char*)Yp + (size_t)row * D + col0;
#pragma unroll
            for (int bj = 0; bj < 2; ++bj) { const f32x4 v0 = acc[ai][bj][m][0] * gv, v1 = acc[ai][bj][m][1] * gv;
                u32x2 w; w.x = pk4_fp8(v0[0], v0[1], v0[2], v0[3]); w.y = pk4_fp8(v1[0], v1[1], v1[2], v1[3]);
                *(u32x2*)(rowp + bj * HALF) = w; }
        EPI_ROWS_END
    }
};
template <class Sched> __device__ __forceinline__ void fill_row_table(LAS unsigned char* lds, const Sched& S, const unsigned* src) {
    LAS unsigned* tab = (LAS unsigned*)(lds + GEMM_TAB_OFF); Unit u;
    for (int i = 0; i < 8 && S.next(i, u); ++i) if (threadIdx.x < 256) tab[i * 256 + threadIdx.x] = src[u.pm * 256 + threadIdx.x];
    VM_WAIT(); LDS_WAIT(); __syncthreads();
}
}

#ifdef TS_SEG_LO
#define GT(k) do { asm volatile("" ::: "memory"); const unsigned long long now_ = __builtin_amdgcn_s_memrealtime(); if ((k) == TS_SEG_LO) gt[1] = now_; if ((k) == TS_SEG_HI) gt[0] += now_ - gt[1]; if ((k) == 0) gt[3] = now_; if ((k) == 8) gt[2] += now_ - gt[3]; asm volatile("" ::: "memory"); } while (0)
#define GT_DRAIN() asm volatile("s_waitcnt vmcnt(0) lgkmcnt(0)" ::: "memory")
#else
#define GT(k) do { } while (0)
#define GT_DRAIN() do { } while (0)
#endif
namespace gla {
__device__ __forceinline__ float ex2(float x) { return __builtin_amdgcn_exp2f(x); }
constexpr int QX_OFF = 0, KE_OFF = 17408, KST_OFF = 34816, VT_OFF = 53248, TOT_OFF = 71680, DG_OFF = 73728, OD_OFF = 75776, DEC_OFF = 77312, SSQ_OFF = 77824;
constexpr int QSTR = 272, PSTR = 144, TSTR = 144;
static_assert(SSQ_OFF + 1024 <= HALF_LDS, "gla LDS map");

__device__ __forceinline__ bf16x8 scale8(bf16x8 a, f32x4 f0, f32x4 f1) {
    u32x4 w = __builtin_bit_cast(u32x4, a);
    w.x = pk2(bflo(w.x) * f0[0], bfhi(w.x) * f0[1]); w.y = pk2(bflo(w.y) * f0[2], bfhi(w.y) * f0[3]);
    w.z = pk2(bflo(w.z) * f1[0], bfhi(w.z) * f1[1]); w.w = pk2(bflo(w.w) * f1[2], bfhi(w.w) * f1[3]);
    return __builtin_bit_cast(bf16x8, w);
}

__device__ __forceinline__ void half_barrier(volatile LAS unsigned* cnt, unsigned& gen, int lane) {
    asm volatile("s_waitcnt lgkmcnt(0)" ::: "memory");
    gen += 4u;
    if (lane == 0) {
        __hip_atomic_fetch_add((LAS unsigned*)cnt, 1u, __ATOMIC_RELAXED, __HIP_MEMORY_SCOPE_WORKGROUP);
        while (__hip_atomic_load((LAS unsigned*)cnt, __ATOMIC_RELAXED, __HIP_MEMORY_SCOPE_WORKGROUP) < gen) __builtin_amdgcn_s_sleep(1);
    }
    asm volatile("" ::: "memory");
}
template <int WHICH>
__device__ __forceinline__ void issue_loads(int lane, int J, const bf16* LFp, const bf16* Vp, const bf16* Qp, long row0, int rstep, int hc, unsigned (&lraw)[16], unsigned (&vraw)[16], unsigned (&qraw)[16]) {
    const unsigned base = ((unsigned)((int)row0 + rstep * (16 * J)) * (unsigned)D + (unsigned)(hc + 2 * lane)) * 2u; const int rs = rstep * (D * 2);
    if (WHICH & 1) {
#pragma unroll
        for (int jj = 0; jj < 16; ++jj) lraw[jj] = *(const unsigned*)((const char*)LFp + (base + (unsigned)(rs * jj)));
#pragma unroll
        for (int jj = 0; jj < 16; ++jj) vraw[jj] = *(const unsigned*)((const char*)Vp + (base + (unsigned)(rs * jj)));
    }
    if (WHICH & 2) {
#pragma unroll
        for (int jj = 0; jj < 16; ++jj) qraw[jj] = *(const unsigned*)((const char*)Qp + (base + (unsigned)(rs * jj)));
    }
}
template <bool OUT>
__device__ __forceinline__ void step(LAS unsigned char* hl, int hw, int lane_in, const bf16* Kp, const bf16* LFp, const bf16* Vp, const bf16* Qp, const bf16* SGp,
                                     long row0, int rstep, int hc, f32x4 (&Sacc)[8][2], float& dsum0, float& dsum1, volatile LAS unsigned* hbc, unsigned& hgen, bf16* OFd, unsigned long long (&gt)[4],
                                     unsigned (&lraw)[16], unsigned (&vraw)[16], unsigned (&qraw)[16], bool more, long next_row0) {
    GT(0);
    int lane = lane_in; asm volatile("" : "+v"(lane));
    const int J = hw, c0 = 2 * lane, l15 = lane & 15, g = lane >> 4;
    GT_DRAIN(); GT(1);
    float a0 = 0.f, a1 = 0.f;
#pragma unroll
    for (int jj = 0; jj < 16; ++jj) { a0 += bflo(lraw[jj]); a1 += bfhi(lraw[jj]); }
    LAS float* TOT = (LAS float*)(hl + TOT_OFF);
    *(LAS f32x2*)(TOT + J * 128 + c0) = (f32x2){a0, a1};
    half_barrier(hbc, hgen, lane);
    GT(2);
    if (OUT) issue_loads<2>(lane, J, LFp, Vp, Qp, row0, rstep, hc, lraw, vraw, qraw);
    float t0[4], t1[4];
#pragma unroll
    for (int I = 0; I < 4; ++I) { const f32x2 t = *(const LAS f32x2*)(TOT + I * 128 + c0); t0[I] = t.x; t1[I] = t.y; }
    float RJ0 = 0.f, RJ1 = 0.f, RA0 = 0.f, RA1 = 0.f;
#pragma unroll
    for (int I = 0; I < 4; ++I) { if (I < J) { RJ0 += t0[I]; RJ1 += t1[I]; } if (I > J) { RA0 += t0[I]; RA1 += t1[I]; } }
    const float R40 = (t0[0] + t0[1]) + (t0[2] + t0[3]), R41 = (t1[0] + t1[1]) + (t1[2] + t1[3]);
    {
        LAS float* DG = (LAS float*)(hl + DG_OFF); LAS float* OD = (LAS float*)(hl + OD_OFF); LAS float* DEC = (LAS float*)(hl + DEC_OFF);
        *(LAS f32x2*)(DG + J * 128 + c0) = (f32x2){ex2(fminf(-a0, 115.f)), ex2(fminf(-a1, 115.f))};
        if (J == 0) { *(LAS f32x2*)(DEC + c0) = (f32x2){ex2(R40), ex2(R41)}; dsum0 += R40; dsum1 += R41; }
        else if (J == 1) *(LAS f32x2*)(OD + 0 * 128 + c0) = (f32x2){ex2(t0[1]), ex2(t1[1])};
        else if (J == 2) *(LAS f32x2*)(OD + 1 * 128 + c0) = (f32x2){ex2(t0[2]), ex2(t1[2])};
        else *(LAS f32x2*)(OD + 2 * 128 + c0) = (f32x2){ex2(t0[1] + t0[2]), ex2(t1[1] + t1[2])};
    }
    const float eR0 = ex2(RJ0), eR1 = ex2(RJ1), eA0 = ex2(RA0), eA1 = ex2(RA1);
    unsigned qs[16];
    {
        float su0 = 1.0f, su1 = 1.0f;
#pragma unroll
        for (int hh = 1; hh >= 0; --hh) {
            float ks0[8], ks1[8];
#pragma unroll
            for (int j8 = 7; j8 >= 0; --j8) {
                const int jj = 8 * hh + j8, i = 16 * J + jj;
                const float f0 = ex2(bflo(lraw[jj])), f1 = ex2(bfhi(lraw[jj]));
                const float ke0 = (1.0f - f0) * su0, ke1 = (1.0f - f1) * su1;
                ks0[j8] = ke0 * eA0; ks1[j8] = ke1 * eA1;
                if (OUT) *(LAS unsigned*)(hl + KE_OFF + i * QSTR + c0 * 2) = pk2(ke0, ke1);
                su0 *= f0; su1 *= f1;
            }
            u32x4 w;
            w.x = pk2(ks0[0], ks0[1]); w.y = pk2(ks0[2], ks0[3]); w.z = pk2(ks0[4], ks0[5]); w.w = pk2(ks0[6], ks0[7]);
            *(LAS u32x4*)(hl + KST_OFF + c0 * TSTR + 32 * J + 16 * hh) = w;
            w.x = pk2(ks1[0], ks1[1]); w.y = pk2(ks1[2], ks1[3]); w.z = pk2(ks1[4], ks1[5]); w.w = pk2(ks1[6], ks1[7]);
            *(LAS u32x4*)(hl + KST_OFF + (c0 + 1) * TSTR + 32 * J + 16 * hh) = w;
#define VLO(a, b) ((vraw[a] & 0xffffu) | (vraw[b] << 16))
#define VHI(a, b) ((vraw[a] >> 16) | (vraw[b] & 0xffff0000u))
            w.x = VLO(8 * hh + 0, 8 * hh + 1); w.y = VLO(8 * hh + 2, 8 * hh + 3); w.z = VLO(8 * hh + 4, 8 * hh + 5); w.w = VLO(8 * hh + 6, 8 * hh + 7);
            *(LAS u32x4*)(hl + VT_OFF + c0 * TSTR + 32 * J + 16 * hh) = w;
            w.x = VHI(8 * hh + 0, 8 * hh + 1); w.y = VHI(8 * hh + 2, 8 * hh + 3); w.z = VHI(8 * hh + 4, 8 * hh + 5); w.w = VHI(8 * hh + 6, 8 * hh + 7);
            *(LAS u32x4*)(hl + VT_OFF + (c0 + 1) * TSTR + 32 * J + 16 * hh) = w;
#undef VLO
#undef VHI
        }
        if (OUT) {
            float pr0 = 1.0f, pr1 = 1.0f;
#pragma unroll
            for (int jj = 0; jj < 16; ++jj) {
                pr0 *= ex2(bflo(lraw[jj])); pr1 *= ex2(bfhi(lraw[jj]));
                const float qt0 = bflo(qraw[jj]) * pr0, qt1 = bfhi(qraw[jj]) * pr1;
                *(LAS unsigned*)(hl + QX_OFF + (16 * J + jj) * QSTR + c0 * 2) = pk2(qt0, qt1);
                qs[jj] = pk2(qt0 * eR0, qt1 * eR1);
            }
        } else {
#pragma unroll
            for (int jj = 0; jj < 16; ++jj) qs[jj] = 0u;
        }
    }
    GT_DRAIN(); GT(3);
    half_barrier(hbc, hgen, lane);
    GT(4);
    if (more) issue_loads<1>(lane, J, LFp, Vp, Qp, next_row0, rstep, hc, lraw, vraw, qraw);
    f32x4 o[4][2];
    if (OUT) {
        const int I = hw;
        f32x4 sc[4];
#pragma unroll
        for (int Jp = 0; Jp < 4; ++Jp) {
            sc[Jp] = (f32x4){0.f, 0.f, 0.f, 0.f};
            if (Jp <= I) {
                const LAS float* ft = (Jp == I) ? (const LAS float*)(hl + DG_OFF) + I * 128
                                    : ((I - Jp == 2) ? (const LAS float*)(hl + OD_OFF) + (I - 2) * 128 : (const LAS float*)(hl + OD_OFF) + 2 * 128);
                const bool needf = (Jp != I - 1);
                f32x4 acc = (f32x4){0.f, 0.f, 0.f, 0.f};
#pragma unroll
                for (int ks = 0; ks < 4; ++ks) {
                    bf16x8 a = *(const LAS bf16x8*)(hl + QX_OFF + (16 * I + l15) * QSTR + (32 * ks + 8 * g) * 2);
                    if (needf) { const f32x4 f0 = *(const LAS f32x4*)(ft + 32 * ks + 8 * g), f1 = *(const LAS f32x4*)(ft + 32 * ks + 8 * g + 4); a = scale8(a, f0, f1); }
                    const bf16x8 b = *(const LAS bf16x8*)(hl + KE_OFF + (16 * Jp + l15) * QSTR + (32 * ks + 8 * g) * 2);
                    acc = __builtin_amdgcn_mfma_f32_16x16x32_bf16(a, b, acc, 0, 0, 0);
                }
                if (Jp == I) {
#pragma unroll
                    for (int r = 0; r < 4; ++r) if (l15 > 4 * g + r) acc[r] = 0.f;
                }
                sc[Jp] = acc;
            }
        }
        GT(5);
        half_barrier(hbc, hgen, lane);
        GT(6);
#pragma unroll
        for (int Jp = 0; Jp < 4; ++Jp) {
            const bool wr_blk = (Jp <= I) || (I == 0 && Jp == 1) || (I == 2 && Jp == 3);
            if (wr_blk) {
#pragma unroll
                for (int r = 0; r < 4; ++r) *(LAS unsigned short*)(hl + KE_OFF + (16 * I + 4 * g + r) * PSTR + (16 * Jp + l15) * 2) = (unsigned short)(pk2(sc[Jp][r], 0.f) & 0xffffu);
            }
        }
#pragma unroll
        for (int jj = 0; jj < 16; ++jj) *(LAS unsigned*)(hl + QX_OFF + (16 * J + jj) * QSTR + c0 * 2) = qs[jj];
        half_barrier(hbc, hgen, lane);
        GT(7);
    }
    bf16x8 vb[2][2];
#pragma unroll
    for (int ct = 0; ct < 2; ++ct)
#pragma unroll
        for (int js = 0; js < 2; ++js) vb[ct][js] = *(const LAS bf16x8*)(hl + VT_OFF + (32 * hw + 16 * ct + l15) * TSTR + (32 * js + 8 * g) * 2);
    if (OUT) {
#pragma unroll
        for (int I = 0; I < 4; ++I) {
            o[I][0] = (f32x4){0.f, 0.f, 0.f, 0.f}; o[I][1] = (f32x4){0.f, 0.f, 0.f, 0.f};
#pragma unroll
            for (int ks = 0; ks < (I < 2 ? 1 : 2); ++ks) {
                const bf16x8 pa = *(const LAS bf16x8*)(hl + KE_OFF + (16 * I + l15) * PSTR + (32 * ks + 8 * g) * 2);
                o[I][0] = __builtin_amdgcn_mfma_f32_16x16x32_bf16(pa, vb[0][ks], o[I][0], 0, 0, 0);
                o[I][1] = __builtin_amdgcn_mfma_f32_16x16x32_bf16(pa, vb[1][ks], o[I][1], 0, 0, 0);
            }
        }
#pragma unroll
        for (int ks = 0; ks < 4; ++ks) {
            bf16x8 Sb[2];
#pragma unroll
            for (int ct = 0; ct < 2; ++ct) { const f32x4 s0 = Sacc[2 * ks][ct], s1 = Sacc[2 * ks + 1][ct]; u32x4 w; w.x = pk2(s0[0], s0[1]); w.y = pk2(s0[2], s0[3]); w.z = pk2(s1[0], s1[1]); w.w = pk2(s1[2], s1[3]); Sb[ct] = __builtin_bit_cast(bf16x8, w); }
#pragma unroll
            for (int I = 0; I < 4; ++I) {
                const u32x2 lo = *(const LAS u32x2*)(hl + QX_OFF + (16 * I + l15) * QSTR + (32 * ks + 4 * g) * 2), hi = *(const LAS u32x2*)(hl + QX_OFF + (16 * I + l15) * QSTR + (32 * ks + 16 + 4 * g) * 2);
                const bf16x8 qa = __builtin_bit_cast(bf16x8, (u32x4){lo.x, lo.y, hi.x, hi.y});
                o[I][0] = __builtin_amdgcn_mfma_f32_16x16x32_bf16(qa, Sb[0], o[I][0], 0, 0, 0);
                o[I][1] = __builtin_amdgcn_mfma_f32_16x16x32_bf16(qa, Sb[1], o[I][1], 0, 0, 0);
            }
        }
    }
#pragma unroll
    for (int kt = 0; kt < 8; ++kt) {
        const f32x4 d = *(const LAS f32x4*)(hl + DEC_OFF + (16 * kt + 4 * g) * 4);
        Sacc[kt][0] = Sacc[kt][0] * d; Sacc[kt][1] = Sacc[kt][1] * d;
#pragma unroll
        for (int js = 0; js < 2; ++js) {
            const bf16x8 ka = *(const LAS bf16x8*)(hl + KST_OFF + (16 * kt + l15) * TSTR + (32 * js + 8 * g) * 2);
            Sacc[kt][0] = __builtin_amdgcn_mfma_f32_16x16x32_bf16(ka, vb[0][js], Sacc[kt][0], 0, 0, 0);
            Sacc[kt][1] = __builtin_amdgcn_mfma_f32_16x16x32_bf16(ka, vb[1][js], Sacc[kt][1], 0, 0, 0);
        }
    }
    if (OUT) {
        const unsigned cbase = (unsigned)(hc + 32 * hw + l15);
#pragma unroll
        for (int I = 0; I < 4; ++I)
#pragma unroll
            for (int r = 0; r < 4; ++r) { const unsigned ro = (unsigned)((int)row0 + rstep * (16 * I + 4 * g + r)) * (unsigned)D + cbase;
                OFd[ro] = (bf16)(pk2(o[I][0][r], 0.f) & 0xffffu); OFd[ro + 16] = (bf16)(pk2(o[I][1][r], 0.f) & 0xffffu); }
    }
    GT(8);
}

struct Ptrs { const bf16 *V, *KF, *LFF, *KB, *LFB, *Q, *SG; float* OF; bf16* OG; const float* gn; float *LST, *SENT, *LSTC, *DSUM, *DSUMC; };

__device__ __forceinline__ void pass_a(LAS unsigned char* lds, const Ptrs& P, int G) {
    const int tid = opaque_tid(), wid = __builtin_amdgcn_readfirstlane(tid >> 6), lane = tid & 63, dir = wid >> 2, hw = wid & 3, l15 = lane & 15, g = lane >> 4;
    LAS unsigned char* hl = lds + dir * HALF_LDS;
    const bf16* Kp = dir ? P.KB : P.KF; const bf16* LFp = dir ? P.LFB : P.LFF;
    volatile LAS unsigned* hbc = (volatile LAS unsigned*)(lds + MISC_OFF) + 16 + dir * 4; unsigned hgen = 0u;
    if (tid < 8) ((volatile LAS unsigned*)(lds + MISC_OFF))[16 + tid] = 0u;
    __syncthreads();
    for (int it = blockIdx.x; it < 320; it += G) {
        const bool isctx = it >= 256;
        int b, h, sc, nsteps; long base;
        if (!isctx) { b = it >> 7; h = (it >> 4) & 7; sc = it & 15; nsteps = 8; base = (long)b * T + sc * SCT; }
        else { const int r = it - 256; b = r >> 5; h = (r >> 2) & 7; sc = r & 3; nsteps = 1; base = (long)M + b * CTX + 64 * sc; }
        f32x4 Sacc[8][2];
#pragma unroll
        for (int kt = 0; kt < 8; ++kt) { Sacc[kt][0] = (f32x4){0.f, 0.f, 0.f, 0.f}; Sacc[kt][1] = (f32x4){0.f, 0.f, 0.f, 0.f}; }
        float ds0 = 0.f, ds1 = 0.f; unsigned long long gt[4] = {0ull, 0ull, 0ull, 0ull};
        unsigned lraw[16], vraw[16], qraw[16];
        issue_loads<1>(lane, hw, LFp, P.V, P.Q, dir ? base + 64 * (nsteps - 1) + 63 : base, dir ? -1 : 1, h * HD, lraw, vraw, qraw);
#pragma unroll
        for (int jj = 0; jj < 16; ++jj) qraw[jj] = 0u;
        for (int s = 0; s < nsteps; ++s) {
            const long row0 = dir ? base + 64 * (nsteps - 1 - s) + 63 : base + 64 * s;
            step<false>(hl, hw, lane, Kp, LFp, P.V, P.Q, P.SG, row0, dir ? -1 : 1, h * HD, Sacc, ds0, ds1, hbc, hgen, nullptr, gt, lraw, vraw, qraw, s + 1 < nsteps, dir ? row0 - 64 : row0 + 64);
        }
#ifdef TS_SEG_LO
        if (it == TS_SEG_ITEM && tid == TS_SEG_TID && TS_SEG_PASS == 0) { *(volatile unsigned long long*)((unsigned char*)P.DSUM - WS_DSUM + WS_CTL + 32768) = 0ull; *(volatile unsigned long long*)((unsigned char*)P.DSUM - WS_DSUM + WS_CTL + 32776) = (unsigned long long)((float)gt[0] * 10000.0f / (float)gt[2]); }
#endif
        const int seq = (b * NH + h) * 2 + dir;
        if (isctx) { float* dst = P.LSTC + ((size_t)seq * 4 + sc) * 16384;
#pragma unroll
            for (int kt = 0; kt < 8; ++kt)
#pragma unroll
                for (int ct = 0; ct < 2; ++ct)
#pragma unroll
                    for (int r = 0; r < 4; ++r) dst[(16 * kt + 4 * g + r) * 128 + 32 * hw + 16 * ct + l15] = Sacc[kt][ct][r];
        } else { bf16* dst = (bf16*)P.LST + ((size_t)seq * NSC + sc) * 16384;
#pragma unroll
            for (int kt = 0; kt < 8; ++kt)
#pragma unroll
                for (int ct = 0; ct < 2; ++ct)
#pragma unroll
                    for (int r = 0; r < 4; ++r) dst[(16 * kt + 4 * g + r) * 128 + 32 * hw + 16 * ct + l15] = (bf16)(pk2(Sacc[kt][ct][r], 0.f) & 0xffffu); }
        if (hw == 0) *(f32x2*)((isctx ? P.DSUMC + ((size_t)seq * 4 + sc) * 128 : P.DSUM + ((size_t)seq * NSC + sc) * 128) + 2 * lane) = (f32x2){ds0, ds1};
    }
}
__device__ __forceinline__ void pass_b(const Ptrs& P, int G) {
    for (int idx = blockIdx.x * 512 + threadIdx.x; idx < 32 * 4096; idx += G * 512) {
        const int seq = idx >> 12, e4 = (idx & 4095) * 4, k = e4 >> 7, dir = seq & 1;
        f32x4 cur = (f32x4){0.f, 0.f, 0.f, 0.f};
        for (int j = 0; j < 4; ++j) { const int cc = dir ? 3 - j : j; const size_t o = (size_t)seq * 4 + cc;
            cur = cur * ex2(P.DSUMC[o * 128 + k]) + *(const f32x4*)(P.LSTC + o * 16384 + e4); }
        for (int j = 0; j < NSC; ++j) {
            const int sc = dir ? NSC - 1 - j : j;
            const size_t o = ((size_t)seq * NSC + sc);
            { u32x2 wv; wv.x = pk2(cur[0], cur[1]); wv.y = pk2(cur[2], cur[3]); *(u32x2*)((bf16*)P.SENT + o * 16384 + e4) = wv; }
            const float dk = ex2(P.DSUM[o * 128 + k]);
            const u32x2 lw = *(const u32x2*)((const bf16*)P.LST + o * 16384 + e4);
            cur = cur * dk + (f32x4){bflo(lw.x), bfhi(lw.x), bflo(lw.y), bfhi(lw.y)};
        }
    }
}
__device__ __forceinline__ void pass_c(LAS unsigned char* lds, const Ptrs& P, int G) {
    const int tid = opaque_tid(), wid = __builtin_amdgcn_readfirstlane(tid >> 6), lane = tid & 63, dir = wid >> 2, hw = wid & 3, l15 = lane & 15, g = lane >> 4;
    LAS unsigned char* hl = lds + dir * HALF_LDS;
    const bf16* Kp = dir ? P.KB : P.KF; const bf16* LFp = dir ? P.LFB : P.LFF;
    bf16* OFf = (bf16*)P.OF; bf16* OFb = OFf + (size_t)M * D; bf16* OFd = dir ? OFb : OFf;
    volatile LAS unsigned* hbc = (volatile LAS unsigned*)(lds + MISC_OFF) + 16 + dir * 4; unsigned hgen = 0u;
    if (tid < 8) ((volatile LAS unsigned*)(lds + MISC_OFF))[16 + tid] = 0u;
    __syncthreads();
    for (int it = blockIdx.x; it < 256; it += G) {
        const int b = it >> 7, h = (it >> 4) & 7, sc = it & 15; const long base = (long)b * T + sc * SCT;
        const int seq = (b * NH + h) * 2 + dir;
        const bf16* src = (const bf16*)P.SENT + ((size_t)seq * NSC + sc) * 16384;
        f32x4 Sacc[8][2];
#pragma unroll
        for (int kt = 0; kt < 8; ++kt)
#pragma unroll
            for (int ct = 0; ct < 2; ++ct)
#pragma unroll
                for (int r = 0; r < 4; ++r) Sacc[kt][ct][r] = bflo((unsigned)src[(16 * kt + 4 * g + r) * 128 + 32 * hw + 16 * ct + l15]);
        float ds0 = 0.f, ds1 = 0.f; unsigned long long gt[4] = {0ull, 0ull, 0ull, 0ull};
        unsigned lraw[16], vraw[16], qraw[16];
        issue_loads<1>(lane, hw, LFp, P.V, P.Q, dir ? base + 64 * 7 + 63 : base, dir ? -1 : 1, h * HD, lraw, vraw, qraw);
        {
            unsigned short* sink = (unsigned short*)((unsigned char*)P.DSUM - WS_DSUM + WS_CTL + 49152) + lane;
#pragma unroll
            for (int k = 0; k < 32; ++k) sink[64 * k] = (unsigned short)0;
        }
        for (int s = 0; s < 8; ++s) {
            const long row0 = dir ? base + 64 * (7 - s) + 63 : base + 64 * s;
            step<true>(hl, hw, lane, Kp, LFp, P.V, P.Q, P.SG, row0, dir ? -1 : 1, h * HD, Sacc, ds0, ds1, hbc, hgen, OFd, gt, lraw, vraw, qraw, s < 7, dir ? row0 - 64 : row0 + 64);
        }
#ifdef TS_SEG_LO
        if (it == TS_SEG_ITEM && tid == TS_SEG_TID && TS_SEG_PASS == 2) { *(volatile unsigned long long*)((unsigned char*)P.DSUM - WS_DSUM + WS_CTL + 32768) = 0ull; *(volatile unsigned long long*)((unsigned char*)P.DSUM - WS_DSUM + WS_CTL + 32776) = (unsigned long long)((float)gt[0] * 10000.0f / (float)gt[2]); }
#endif
        VM_WAIT(); __syncthreads();
        {
            const int ch = h * HD + 4 * (lane & 31);
            const f32x4 gw = *(const f32x4*)(P.gn + ch);
#pragma unroll 4
            for (int rr = 0; rr < 32; ++rr) {
                const size_t ro = (size_t)(base + rr * 16 + wid * 2 + (lane >> 5)) * D + ch;
                const u32x2 f = *(const u32x2*)(OFf + ro), bb = *(const u32x2*)(OFb + ro), sg = *(const u32x2*)(P.SG + ro);
                f32x4 o = (f32x4){bflo(f.x) + bflo(bb.x), bfhi(f.x) + bfhi(bb.x), bflo(f.y) + bflo(bb.y), bfhi(f.y) + bfhi(bb.y)};
                float ss = (o[0] * o[0] + o[1] * o[1]) + (o[2] * o[2] + o[3] * o[3]);
#pragma unroll
                for (int m = 1; m < 32; m <<= 1) ss += __shfl_xor(ss, m);
                const float rstd = rsqrtf(ss * (1.0f / HD) + EPS);
                u32x2 w; w.x = pk2(o[0] * rstd * gw[0] * bflo(sg.x), o[1] * rstd * gw[1] * bfhi(sg.x)); w.y = pk2(o[2] * rstd * gw[2] * bflo(sg.y), o[3] * rstd * gw[3] * bfhi(sg.y));
                *(u32x2*)(P.OG + ro) = w;
            }
        }
        __syncthreads();
    }
}
}

struct Args {
    const float *x, *c, *ctx, *c_ctx, *w_ada, *b_ada, *norm_w, *hg_w_in, *hg_lb, *hg_gnorm, *hg_w_out, *sg_w_in, *sg_ln_w, *sg_ln_b, *sg_w_s, *sg_b_s, *sg_w_out,
                *moe_router, *moe_w_gate, *moe_w_up, *moe_w_down;
    float* out; unsigned char* ws; int ph_lo, ph_hi, li, pad;
};
#define CAS __attribute__((address_space(4)))
typedef const CAS Args& ArgsRef;
__device__ __forceinline__ const CAS Args* launder_args(const CAS Args* p) { asm volatile("" : "+s"(p)); return p; }

#ifdef TS_A
#define USTAMP(n) do { if (blockIdx.x == 0 && threadIdx.x == 0) { if ((n) == TS_A) *(volatile unsigned long long*)(a.ws + WS_CTL + 32768) = __builtin_amdgcn_s_memrealtime(); if ((n) == TS_B) *(volatile unsigned long long*)(a.ws + WS_CTL + 32776) = __builtin_amdgcn_s_memrealtime(); } } while (0)
#else
#define USTAMP(n) do { } while (0)
#endif
struct ConvTile { const float* W; bf16* WT; int K, N, rowmode, kt, nt, f8; };
constexpr int NT_SMALL = 160 + 32 + 64 + 32, NT_MOE = 2 * 3072;
constexpr int Q_HEAD = 6144, Q_DONE0 = 6144 + 64, Q_DONE1 = 6144 + 128, Q_DONE2 = 6144 + 192;
__device__ __forceinline__ void conv_decode_small(ArgsRef a, int r, ConvTile& t) {
    unsigned char* ws = a.ws;
    t.f8 = 0;
    if (r < 160) { t.W = a.hg_w_in; t.WT = (bf16*)(ws + WS_WHIN); t.K = D; t.N = 5 * D; t.rowmode = 0; t.kt = r / 20; t.nt = r % 20; }
    else if ((r -= 160) < 32) { t.W = a.hg_w_out; t.WT = (bf16*)(ws + WS_WHOUT); t.K = D; t.N = D; t.rowmode = 0; t.kt = r >> 2; t.nt = r & 3; }
    else if ((r -= 32) < 64) { t.W = a.sg_w_in; t.WT = (bf16*)(ws + WS_WSIN); t.K = D; t.N = 2 * D; t.rowmode = 0; t.kt = r >> 3; t.nt = r & 7; t.f8 = 1; }
    else { r -= 64; t.W = a.sg_w_out; t.WT = (bf16*)(ws + WS_WSOUT); t.K = D; t.N = D; t.rowmode = 0; t.kt = r >> 2; t.nt = r & 3; t.f8 = 1; }
}
__device__ __forceinline__ void conv_decode_moe(ArgsRef a, int r, ConvTile& t) {
    unsigned char* ws = a.ws; unsigned char* WGU = ws + WS_WGU; unsigned char* WD = ws + WS_WD;
    const int l = r / 3072, q = r % 3072, mat = q >> 10, e = (q >> 6) & 15, tt = q & 63, le = l * 16 + e;
    t.f8 = 1;
    if (mat == 0) { t.W = a.moe_w_gate + (size_t)le * D * FF; t.WT = (bf16*)(WGU + (size_t)le * 4096 * D); t.K = D; t.N = FF; t.rowmode = 1; t.kt = tt >> 3; t.nt = tt & 7; }
    else if (mat == 1) { t.W = a.moe_w_up + (size_t)le * D * FF; t.WT = (bf16*)(WGU + (size_t)le * 4096 * D); t.K = D; t.N = FF; t.rowmode = 2; t.kt = tt >> 3; t.nt = tt & 7; }
    else { t.W = a.moe_w_down + (size_t)le * FF * D; t.WT = (bf16*)(WD + (size_t)le * D * FF); t.K = FF; t.N = D; t.rowmode = 0; t.kt = tt >> 2; t.nt = tt & 3; }
}
__device__ __forceinline__ void conv_load(const ConvTile& t, f32x4 (&v)[16], int wave, int lane) {
#pragma unroll
    for (int i = 0; i < 16; ++i) v[i] = __builtin_nontemporal_load((const f32x4*)(t.W + (size_t)(t.kt * 128 + wave * 16 + i) * t.N + t.nt * 256 + 4 * lane));
}
__device__ __forceinline__ void conv_to_lds(LAS unsigned char* buf, const f32x4 (&v)[16], int wave, int lane) {
#pragma unroll
    for (int i = 0; i < 16; ++i) { const int k = wave * 16 + i; u32x2 w; w.x = pk2(v[i][0], v[i][1]); w.y = pk2(v[i][2], v[i][3]); *(LAS u32x2*)(buf + k * 512 + (((4 * lane) ^ (((k >> 3) & 7) << 3)) * 2)) = w; }
}
__device__ __forceinline__ void conv_store(LAS unsigned char* buf, const ConvTile& t, int wave, int lane) {
#pragma unroll
    for (int q = 0; q < 8; ++q) {
        const int idx = wave * 8 + q, rowgrp = idx >> 1, c8 = (idx & 1) * 8 + (lane & 7), nl = rowgrp * 8 + (lane >> 3), n = t.nt * 256 + nl;
        const LAS unsigned short* p = (const LAS unsigned short*)(buf + (8 * c8) * 512 + ((nl ^ ((c8 & 7) << 3)) * 2));
        u32x4 o;
        o.x = (unsigned)p[0 * 256] | ((unsigned)p[1 * 256] << 16); o.y = (unsigned)p[2 * 256] | ((unsigned)p[3 * 256] << 16);
        o.z = (unsigned)p[4 * 256] | ((unsigned)p[5 * 256] << 16); o.w = (unsigned)p[6 * 256] | ((unsigned)p[7 * 256] << 16);
        const int row = t.rowmode == 0 ? n : ((n >> 7) * 256 + (n & 127) + (t.rowmode == 2 ? 128 : 0));
        *(u32x4*)(t.WT + (size_t)row * t.K + t.kt * 128 + 8 * c8) = o;
    }
}
__device__ __forceinline__ void conv_to_lds8(LAS unsigned char* buf, const f32x4 (&v)[16], int wave, int lane) {
#pragma unroll
    for (int j = 0; j < 4; ++j) { const int n = 4 * lane + j; u32x4 o;
        o.x = pk4_fp8(v[0][j] * 32.f, v[1][j] * 32.f, v[2][j] * 32.f, v[3][j] * 32.f); o.y = pk4_fp8(v[4][j] * 32.f, v[5][j] * 32.f, v[6][j] * 32.f, v[7][j] * 32.f);
        o.z = pk4_fp8(v[8][j] * 32.f, v[9][j] * 32.f, v[10][j] * 32.f, v[11][j] * 32.f); o.w = pk4_fp8(v[12][j] * 32.f, v[13][j] * 32.f, v[14][j] * 32.f, v[15][j] * 32.f);
        *(LAS u32x4*)(buf + n * 128 + ((wave ^ (((n >> 2) ^ n) & 7)) << 4)) = o; }
}
__device__ __forceinline__ void conv_store8(LAS unsigned char* buf, const ConvTile& t, int wave, int lane) {
    unsigned char* WT8 = (unsigned char*)t.WT;
#pragma unroll
    for (int q = 0; q < 4; ++q) {
        const int c = lane & 7, nl = (wave * 4 + q) * 8 + (lane >> 3), n = t.nt * 256 + nl;
        const u32x4 o = *(const LAS u32x4*)(buf + nl * 128 + ((c ^ (((nl >> 2) ^ nl) & 7)) << 4));
        const int row = t.rowmode == 0 ? n : ((n >> 7) * 256 + (n & 127) + (t.rowmode == 2 ? 128 : 0));
        *(u32x4*)(WT8 + (size_t)row * t.K + t.kt * 128 + 16 * c) = o;
    }
}
#define CONV_BAR() do { LDS_WAIT(); __builtin_amdgcn_s_barrier(); asm volatile("" ::: "memory"); } while (0)
__device__ __forceinline__ void convert_worker(LAS unsigned char* lds, ArgsRef a, int mand, int done_idx, unsigned done_target) {
    const int tid = opaque_tid(), lane = tid & 63, wave = __builtin_amdgcn_readfirstlane(tid >> 6);
    unsigned* ctl = (unsigned*)(a.ws + WS_CTL);
    volatile LAS int* slot = (volatile LAS int*)(lds + 131072);
    constexpr int CONV_BATCH = 4;
    int rng_next = 0, rng_end = 0, lastb = -1; bool stopf = false;
#define CONV_NEXT(r_) do { \
        if (rng_next < rng_end) r_ = rng_next++; \
        else if (stopf) r_ = -1; \
        else { const unsigned dn_ = __hip_atomic_load(ctl + done_idx, __ATOMIC_RELAXED, __HIP_MEMORY_SCOPE_AGENT); \
            if (lastb >= 0 && lastb + CONV_BATCH >= mand && dn_ >= done_target) { stopf = true; r_ = -1; } \
            else { const int t_ = (int)__hip_atomic_fetch_add(ctl + Q_HEAD, (unsigned)CONV_BATCH, __ATOMIC_RELAXED, __HIP_MEMORY_SCOPE_AGENT); lastb = t_; \
                if (t_ >= NT_MOE) { stopf = true; r_ = -1; } else { rng_next = t_ + 1; rng_end = t_ + CONV_BATCH < NT_MOE ? t_ + CONV_BATCH : NT_MOE; r_ = t_; } } } } while (0)
    if (tid == 0) { int r0, r1; CONV_NEXT(r0); CONV_NEXT(r1); slot[0] = r0; slot[1] = r1; }
    __syncthreads();
    f32x4 va[16], vb[16]; ConvTile ta, tb;
    int ca = slot[0], cb = slot[1];
    if (ca >= 0) { conv_decode_moe(a, ca, ta); conv_load(ta, va, wave, lane); }
    if (cb >= 0) { conv_decode_moe(a, cb, tb); conv_load(tb, vb, wave, lane); }
#define CONV_ROUND(X, tX, cX, bufoff, sl) do { \
        LAS unsigned char* buf_ = lds + (bufoff); \
        conv_to_lds8(buf_, X, wave, lane); \
        const ConvTile cc_ = tX; \
        if (tid == 0) { int r_; CONV_NEXT(r_); slot[sl] = r_; } \
        CONV_BAR(); \
        const int nxt_ = slot[sl]; \
        if (nxt_ >= 0) { conv_decode_moe(a, nxt_, tX); conv_load(tX, X, wave, lane); } \
        conv_store8(buf_, cc_, wave, lane); \
        cX = nxt_; } while (0)
    while (ca >= 0) {
        CONV_ROUND(va, ta, ca, 0, 2);
        if (cb < 0) break;
        CONV_ROUND(vb, tb, cb, 65536, 3);
    }
#undef CONV_ROUND
#undef CONV_NEXT
    __syncthreads();
}

__device__ __forceinline__ void phase_p0a(LAS unsigned char* lds, ArgsRef a, int G, int vcu) {
    unsigned char* ws = a.ws;
    const int tid = opaque_tid(), lane = tid & 63, wave = __builtin_amdgcn_readfirstlane(tid >> 6);
    USTAMP(0);
    {
        LAS float* sv = (LAS float*)(lds + 67584);
        LAS float* red = (LAS float*)(lds + 67584 + 12288);
        float* MOD = (float*)(ws + WS_MOD);
        for (int i = tid; i < 3072; i += 512) { const int v = i >> 10, k = i & 1023; sv[i] = siluf_(v < 2 ? a.c[v * D + k] : a.c_ctx[k]); }
        __syncthreads();
        for (int it = blockIdx.x; it < 192; it += G) {
            const int l = it / 96, cb = it % 96, n = cb * 64 + lane;
            const float* w = a.w_ada + (size_t)l * D * 6144 + (size_t)(wave * 128) * 6144 + n;
            float a0 = 0.f, a1 = 0.f, a2 = 0.f;
#pragma unroll 32
            for (int k = 0; k < 128; ++k) { const float wv = w[(size_t)k * 6144]; const int kk = wave * 128 + k; a0 += sv[kk] * wv; a1 += sv[1024 + kk] * wv; a2 += sv[2048 + kk] * wv; }
            red[(wave * 3 + 0) * 64 + lane] = a0; red[(wave * 3 + 1) * 64 + lane] = a1; red[(wave * 3 + 2) * 64 + lane] = a2;
            __syncthreads();
            if (tid < 192) { const int v = tid >> 6, c = tid & 63; float sacc = a.b_ada[l * 6144 + cb * 64 + c];
#pragma unroll
                for (int ww = 0; ww < 8; ++ww) sacc += red[(ww * 3 + v) * 64 + c];
                MOD[(size_t)(l * 3 + v) * 6144 + cb * 64 + c] = sacc; }
            __syncthreads();
        }
    }
    USTAMP(1);
    {
        f32x4 v[16]; ConvTile ct; int it = blockIdx.x, par = 0;
        if (it < NT_SMALL) { conv_decode_small(a, it, ct); conv_load(ct, v, wave, lane); }
        for (; it < NT_SMALL; it += G, par ^= 1) {
            LAS unsigned char* buf = lds + par * 65536;
            const ConvTile cc = ct;
            if (cc.f8) conv_to_lds8(buf, v, wave, lane); else conv_to_lds(buf, v, wave, lane);
            CONV_BAR();
            if (it + G < NT_SMALL) { conv_decode_small(a, it + G, ct); conv_load(ct, v, wave, lane); }
            if (cc.f8) conv_store8(buf, cc, wave, lane); else conv_store(buf, cc, wave, lane);
        }
        __syncthreads();
    }
    USTAMP(2);
    {
        const int gt = blockIdx.x * 512 + tid, GT = G * 512;
        bf16* WSb = (bf16*)(ws + WS_WS);
        for (int i = gt; i < 8 * 128 * 128 / 2; i += GT) { const f32x2 v = *(const f32x2*)(a.sg_w_s + 2 * i); ((unsigned*)WSb)[i] = pk2(v.x, v.y); }
        float* LB = (float*)(ws + WS_LB);
        for (int i = gt; i < 2048; i += GT) { const float l0 = a.hg_lb[i], l1 = a.hg_lb[2048 + i], l2 = a.hg_lb[4096 + i]; const float mx = fmaxf(l0, fmaxf(l1, l2));
            const float e0 = expf(l0 - mx), e1 = expf(l1 - mx), e2 = expf(l2 - mx); LB[i] = e0 / (e0 + e1 + e2); }
    }
    USTAMP(3);
}

#define ROFF(lane, j) (8 * (lane) + 512 * ((j) >> 1) + 4 * ((j) & 1))
__device__ __forceinline__ void row_load_f32(const float* p, int lane, f32x4 (&x)[4]) {
#pragma unroll
    for (int j = 0; j < 4; ++j) x[j] = *(const f32x4*)(p + ROFF(lane, j));
}
__device__ __forceinline__ void row_store_f32(float* p, int lane, const f32x4 (&x)[4]) {
#pragma unroll
    for (int j = 0; j < 4; ++j) *(f32x4*)(p + ROFF(lane, j)) = x[j];
}
__device__ __forceinline__ void row_store_bf16(bf16* p, int lane, const f32x4 (&x)[4]) {
#pragma unroll
    for (int h = 0; h < 2; ++h) { u32x4 w; w.x = pk2(x[2 * h][0], x[2 * h][1]); w.y = pk2(x[2 * h][2], x[2 * h][3]); w.z = pk2(x[2 * h + 1][0], x[2 * h + 1][1]); w.w = pk2(x[2 * h + 1][2], x[2 * h + 1][3]);
        *(u32x4*)(p + 8 * lane + 512 * h) = w; }
}
__device__ __forceinline__ void row_load_raw(const bf16* p, int lane, u32x4 (&r)[2]) {
#pragma unroll
    for (int h = 0; h < 2; ++h) r[h] = *(const u32x4*)(p + 8 * lane + 512 * h);
}
__device__ __forceinline__ void row_unpack(const u32x4 (&r)[2], f32x4 (&x)[4]) {
#pragma unroll
    for (int h = 0; h < 2; ++h) { x[2 * h] = (f32x4){bflo(r[h].x), bfhi(r[h].x), bflo(r[h].y), bfhi(r[h].y)}; x[2 * h + 1] = (f32x4){bflo(r[h].z), bfhi(r[h].z), bflo(r[h].w), bfhi(r[h].w)}; }
}
__device__ __forceinline__ void row_store_fp8(unsigned char* p, int lane, const f32x4 (&x)[4]) {
#pragma unroll
    for (int h = 0; h < 2; ++h) { u32x2 w; w.x = pk4_fp8(x[2 * h][0], x[2 * h][1], x[2 * h][2], x[2 * h][3]); w.y = pk4_fp8(x[2 * h + 1][0], x[2 * h + 1][1], x[2 * h + 1][2], x[2 * h + 1][3]);
        *(u32x2*)(p + 8 * lane + 512 * h) = w; }
}
__device__ __forceinline__ float row_rstd(const f32x4 (&x)[4]) {
    float s = 0.f;
#pragma unroll
    for (int j = 0; j < 4; ++j) s += (x[j][0] * x[j][0] + x[j][1] * x[j][1]) + (x[j][2] * x[j][2] + x[j][3] * x[j][3]);
    return rsqrtf(wave_sum(s) * (1.0f / D) + EPS);
}

__device__ __forceinline__ void phase_p0b(LAS unsigned char* lds, ArgsRef a, int G, int vcu) {
    unsigned char* ws = a.ws;
    const int tid = opaque_tid(), lane = tid & 63, wave = __builtin_amdgcn_readfirstlane(tid >> 6);
    const float* MOD = (const float*)(ws + WS_MOD);
    LAS float* modl = (LAS float*)lds;
    for (int i = tid; i < 6144; i += 512) { const int v = i >> 11, n = i & 2047; modl[i] = MOD[(size_t)v * 6144 + n]; }
    __syncthreads();
    bf16* XR = (bf16*)(ws + WS_XR); bf16* H = (bf16*)(ws + WS_H);
    f32x4 nw[4]; row_load_f32(a.norm_w, lane, nw);
    float frq[16];
#pragma unroll
    for (int j = 0; j < 4; ++j)
#pragma unroll
        for (int e = 0; e < 4; ++e) { const int dd = ROFF(lane, j) + e; frq[4 * j + e] = expf(-9.210340371976184f * (float)(dd & 255) / 256.0f); }
    const float phs = (lane & 32) ? 1.5707963267948966f : 0.0f;
    f32x4 pcol[2];
    { const float pc = (float)((vcu * 8 + wave) & 63);
#pragma unroll
      for (int j = 2; j < 4; ++j)
#pragma unroll
        for (int e = 0; e < 4; ++e) pcol[j - 2][e] = __sinf(pc * frq[4 * j + e] + phs); }
    const bool colconst = ((G * 8) & 63) == 0;
    f32x4 xn[4];
    { const int m0 = vcu * 8 + wave; if (m0 < MT) row_load_f32(m0 < M ? a.x + (size_t)m0 * D : a.ctx + (size_t)(m0 - M) * D, lane, xn); }
    for (int m = vcu * 8 + wave; m < MT; m += G * 8) {
        f32x4 x[4]; int v;
#pragma unroll
        for (int j = 0; j < 4; ++j) x[j] = xn[j];
        { const int mn = m + G * 8; if (mn < MT) row_load_f32(mn < M ? a.x + (size_t)mn * D : a.ctx + (size_t)(mn - M) * D, lane, xn); }
        if (m < M) {
            v = m >> 13;
            const float pr = (float)((m & (T - 1)) >> 6);
            if (!colconst) { const float pc = (float)(m & 63);
#pragma unroll
                for (int j = 2; j < 4; ++j)
#pragma unroll
                    for (int e = 0; e < 4; ++e) pcol[j - 2][e] = __sinf(pc * frq[4 * j + e] + phs); }
#pragma unroll
            for (int j = 0; j < 2; ++j)
#pragma unroll
                for (int e = 0; e < 4; ++e) x[j][e] += __sinf(pr * frq[4 * j + e] + phs);
            x[2] = x[2] + pcol[0]; x[3] = x[3] + pcol[1];
            row_store_bf16(XR + (size_t)m * D, lane, x);
        } else v = 2;
        const float rs = row_rstd(x);
#pragma unroll
        for (int j = 0; j < 4; ++j) { const f32x4 sh = *(const LAS f32x4*)(modl + v * 2048 + ROFF(lane, j)), sc = *(const LAS f32x4*)(modl + v * 2048 + 1024 + ROFF(lane, j));
            x[j] = x[j] * rs * nw[j] * (sc + 1.0f) + sh; }
        row_store_bf16(H + (size_t)m * D, lane, x);
    }
}

__device__ __forceinline__ void phase_rowpass_a(LAS unsigned char* lds, ArgsRef a, int G, int vcu, int l) {
    unsigned char* ws = a.ws;
    const int tid = opaque_tid(), lane = tid & 63, wave = __builtin_amdgcn_readfirstlane(tid >> 6);
    LAS float* RT = (LAS float*)lds;
    const float* router = a.moe_router + (size_t)l * D * NE;
    for (int i = tid; i < D * NE; i += 512) { const int d = i >> 4, ln = (d & 511) >> 3, jj = 2 * (d >> 9) + ((d & 7) >> 2);
        RT[(i & 15) * 1024 + 4 * ln + 256 * jj + (d & 3)] = router[i]; }
    __syncthreads();
    const float* MOD = (const float*)(ws + WS_MOD); bf16* XR = (bf16*)(ws + WS_XR); bf16* H = (bf16*)(ws + WS_H); const bf16* Y = (const bf16*)(ws + WS_Y); float* AFF = (float*)(ws + WS_AFF);
    f32x4 nw1[4], nw2[4]; row_load_f32(a.norm_w + (size_t)(l * 4 + 1) * D, lane, nw1); row_load_f32(a.norm_w + (size_t)(l * 4 + 2) * D, lane, nw2);
    u32x4 yr[2], xr[2];
    { const int m0 = vcu * 8 + wave; if (m0 < M) { row_load_raw(Y + (size_t)m0 * D, lane, yr); row_load_raw(XR + (size_t)m0 * D, lane, xr); } }
    f32x4 g1[4], sh[4], sc[4]; int bcur = -1;
    for (int m = vcu * 8 + wave; m < M; m += G * 8) {
        const int b = m >> 13;
        if (b != bcur) { const float* mod = MOD + (size_t)(l * 3 + b) * 6144; row_load_f32(mod + 2 * D, lane, g1); row_load_f32(mod + 3 * D, lane, sh); row_load_f32(mod + 4 * D, lane, sc); bcur = b; }
        f32x4 y[4], x[4];
        row_unpack(yr, y); row_unpack(xr, x);
        { const int mn = m + G * 8; if (mn < M) { row_load_raw(Y + (size_t)mn * D, lane, yr); row_load_raw(XR + (size_t)mn * D, lane, xr); } }
        const float r1 = row_rstd(y);
#pragma unroll
        for (int j = 0; j < 4; ++j) x[j] = x[j] + g1[j] * (y[j] * r1 * nw1[j]);
        row_store_bf16(XR + (size_t)m * D, lane, x);
        const float r2 = row_rstd(x);
#pragma unroll
        for (int j = 0; j < 4; ++j) y[j] = x[j] * r2 * nw2[j] * (sc[j] + 1.0f) + sh[j];
        row_store_fp8((unsigned char*)H + (size_t)m * D, lane, y);
        f32x4 p4[16];
#pragma unroll
        for (int e = 0; e < 16; ++e) p4[e] = (f32x4){0.f, 0.f, 0.f, 0.f};
#pragma unroll
        for (int j = 0; j < 4; ++j) {
#pragma unroll
            for (int e = 0; e < 16; ++e) { const f32x4 r = *(const LAS f32x4*)(RT + e * 1024 + 4 * lane + 256 * j); p4[e] = p4[e] + y[j] * r; }
            asm volatile("" ::: "memory");
        }
        float mine_rs = 0.f;
#pragma unroll
        for (int e = 0; e < 16; ++e) { const float rs = row16_sum((p4[e][0] + p4[e][1]) + (p4[e][2] + p4[e][3])); mine_rs = ((lane & 15) == e) ? rs : mine_rs; }
        float mylg = mine_rs + __shfl_xor(mine_rs, 16); mylg += __shfl_xor(mylg, 32);
        float mx = mylg;
        mx = fmaxf(mx, __builtin_bit_cast(float, __builtin_amdgcn_update_dpp(0, __builtin_bit_cast(int, mx), 0xB1, 0xF, 0xF, true)));
        mx = fmaxf(mx, __builtin_bit_cast(float, __builtin_amdgcn_update_dpp(0, __builtin_bit_cast(int, mx), 0x4E, 0xF, 0xF, true)));
        mx = fmaxf(mx, __builtin_bit_cast(float, __builtin_amdgcn_update_dpp(0, __builtin_bit_cast(int, mx), 0x141, 0xF, 0xF, true)));
        mx = fmaxf(mx, __builtin_bit_cast(float, __builtin_amdgcn_update_dpp(0, __builtin_bit_cast(int, mx), 0x140, 0xF, 0xF, true)));
        const float mine = __expf(mylg - mx);
        const float se = row16_sum(mine);
        const int myexp = lane & 15;
        if (lane < 16) AFF[((size_t)(b * NE + myexp)) * T + (m & (T - 1))] = mine / se;
    }
}

__device__ __forceinline__ int block_exscan(int v, LAS int* sbuf, int tid, int* tot) {
    const int lane = tid & 63, wave = tid >> 6; int inc = v;
#pragma unroll
    for (int o = 1; o < 64; o <<= 1) { const int n = __shfl_up(inc, o); if (lane >= o) inc += n; }
    __syncthreads();
    if (lane == 63) sbuf[wave] = inc;
    __syncthreads();
    int base = 0, t = 0;
#pragma unroll
    for (int w = 0; w < 8; ++w) { const int s = sbuf[w]; if (w < wave) base += s; t += s; }
    *tot = t;
    return base + inc - v;
}

__device__ __forceinline__ void phase_topk(LAS unsigned char* lds, ArgsRef a, int G) {
    unsigned char* ws = a.ws; const int tid = opaque_tid();
    const float* AFF = (const float*)(ws + WS_AFF); int* ROWMAP = (int*)(ws + WS_ROWMAP); float* GATE = (float*)(ws + WS_GATE); int* INV = (int*)(ws + WS_INV);
    LAS int* hist = (LAS int*)lds; LAS int* ctl = hist + 256; LAS int* sbuf = hist + 272;
    for (int pe = blockIdx.x; pe < NB * NE; pe += G) {
        const int e = pe >> 1, b = pe & 1;
        unsigned key[16];
#pragma unroll
        for (int i = 0; i < 4; ++i) { const f32x4 kv = *(const f32x4*)(AFF + ((size_t)(b * NE + e) * T + tid * 16 + 4 * i));
#pragma unroll
            for (int j = 0; j < 4; ++j) { const float sc = kv[j] * 4294967296.0f; key[4 * i + j] = sc >= 4294967040.0f ? 0xFFFFFFFFu : (unsigned)sc; } }
        unsigned prefix = 0u, mask = 0u; int need = CAP;
        for (int pass = 0; pass < 4; ++pass) {
            const int shift = 24 - 8 * pass;
            __syncthreads();
            if (tid < 256) hist[tid] = 0;
            __syncthreads();
#pragma unroll
            for (int i = 0; i < 16; ++i) if ((key[i] & mask) == prefix) __hip_atomic_fetch_add(&hist[(key[i] >> shift) & 255u], 1, __ATOMIC_RELAXED, __HIP_MEMORY_SCOPE_WORKGROUP);
            __syncthreads();
            const int hv = tid < 256 ? hist[255 - tid] : 0; int tot;
            const int above = block_exscan(hv, sbuf, tid, &tot);
            if (tid < 256 && above < need && above + hv >= need) { ctl[0] = 255 - tid; ctl[1] = need - above; }
            __syncthreads();
            prefix |= (unsigned)ctl[0] << shift; mask |= 255u << shift; need = ctl[1];
        }
        int neq = 0;
#pragma unroll
        for (int i = 0; i < 16; ++i) neq += (key[i] == prefix) ? 1 : 0;
        int tot; int eqb = block_exscan(neq, sbuf, tid, &tot);
        int nsel = 0; unsigned selm = 0u;
#pragma unroll
        for (int i = 0; i < 16; ++i) { bool sl = key[i] > prefix; if (key[i] == prefix) { sl = eqb < need; ++eqb; } if (sl) { selm |= 1u << i; ++nsel; } }
        int slot = block_exscan(nsel, sbuf, tid, &tot);
#pragma unroll
        for (int i = 0; i < 16; ++i) { const int t = tid * 16 + i; const bool sl = (selm >> i) & 1u;
            INV[((size_t)b * T + t) * 16 + e] = sl ? slot : -1;
            if (sl) { ROWMAP[(e * 2 + b) * CAP + slot] = b * T + t; GATE[(e * 2 + b) * CAP + slot] = AFF[(size_t)(b * NE + e) * T + t]; ++slot; } }
    }
}

__device__ __forceinline__ void phase_rowpass_b(ArgsRef a, int G, int vcu, int l) {
    unsigned char* ws = a.ws;
    const int tid = opaque_tid(), lane = tid & 63, wave = __builtin_amdgcn_readfirstlane(tid >> 6);
    const float* MOD = (const float*)(ws + WS_MOD); bf16* XR = (bf16*)(ws + WS_XR); bf16* H = (bf16*)(ws + WS_H); const bf16* YP = (const bf16*)(ws + WS_YP); const int* INV = (const int*)(ws + WS_INV);
    f32x4 nw3[4], nwn[4]; row_load_f32(a.norm_w + (size_t)(l * 4 + 3) * D, lane, nw3); row_load_f32(a.norm_w + (size_t)(4 + 0) * D, lane, nwn);
    u32x4 xr[2]; int ivn = -1;
    { const int m0 = vcu * 8 + wave; if (m0 < M) { ivn = INV[(size_t)m0 * 16 + (lane & 15)]; row_load_raw(XR + (size_t)m0 * D, lane, xr); } }
    for (int m = vcu * 8 + wave; m < M; m += G * 8) {
        const int b = m >> 13; const float* mod = MOD + (size_t)(l * 3 + b) * 6144;
        const int iv = ivn;
        f32x4 x[4]; row_unpack(xr, x);
        { const int mn = m + G * 8; if (mn < M) { ivn = INV[(size_t)mn * 16 + (lane & 15)]; row_load_raw(XR + (size_t)mn * D, lane, xr); } }
        f32x4 y[4];
#pragma unroll
        for (int j = 0; j < 4; ++j) y[j] = (f32x4){0.f, 0.f, 0.f, 0.f};
        unsigned msel = (unsigned)(__ballot(iv >= 0) & 0xFFFFull);
        while (msel) {
            int ee[4]; u32x2 tr[4][2];
#pragma unroll
            for (int q = 0; q < 4; ++q) { if (msel) { ee[q] = __builtin_ctz(msel); msel &= msel - 1u; } else ee[q] = -1; }
#pragma unroll
            for (int q = 0; q < 4; ++q) if (ee[q] >= 0) { const int slot = __builtin_amdgcn_readlane(iv, ee[q]); const unsigned char* yr8 = (const unsigned char*)YP + (size_t)((ee[q] * 2 + b) * CAP + slot) * D; tr[q][0] = *(const u32x2*)(yr8 + 8 * lane); tr[q][1] = *(const u32x2*)(yr8 + 8 * lane + 512); }
#pragma unroll
            for (int q = 0; q < 4; ++q) if (ee[q] >= 0) {
#pragma unroll
                for (int h = 0; h < 2; ++h) { const f32x2 p0 = __builtin_amdgcn_cvt_pk_f32_fp8(tr[q][h].x, false), p1 = __builtin_amdgcn_cvt_pk_f32_fp8(tr[q][h].x, true), p2 = __builtin_amdgcn_cvt_pk_f32_fp8(tr[q][h].y, false), p3 = __builtin_amdgcn_cvt_pk_f32_fp8(tr[q][h].y, true);
                    y[2 * h] = y[2 * h] + (f32x4){p0.x, p0.y, p1.x, p1.y}; y[2 * h + 1] = y[2 * h + 1] + (f32x4){p2.x, p2.y, p3.x, p3.y}; } }
        }
#pragma unroll
        for (int j = 0; j < 4; ++j) y[j] = y[j] * 0.0625f;
        f32x4 g2[4]; row_load_f32(mod + 5 * D, lane, g2);
        const float r = row_rstd(y);
#pragma unroll
        for (int j = 0; j < 4; ++j) x[j] = x[j] + g2[j] * (y[j] * r * nw3[j]);
        if (l == 0) {
            row_store_bf16(XR + (size_t)m * D, lane, x);
            const float* mod1 = MOD + (size_t)(1 * 3 + b) * 6144; f32x4 sh[4], sc[4]; row_load_f32(mod1, lane, sh); row_load_f32(mod1 + D, lane, sc);
            const float r2 = row_rstd(x);
#pragma unroll
            for (int j = 0; j < 4; ++j) y[j] = x[j] * r2 * nwn[j] * (sc[j] + 1.0f) + sh[j];
            row_store_fp8((unsigned char*)H + (size_t)m * D, lane, y);
        } else {
#ifdef TS_LO
            if (m == 0) { const unsigned long long t0 = *(volatile unsigned long long*)(ws + WS_CTL + 32768), t1 = *(volatile unsigned long long*)(ws + WS_CTL + 32776);
#ifdef TS_CONST
                const float dt = TS_CONST;
#else
                float dt = (float)(long long)(t1 - t0) * 0.01f;
#ifdef TS_Q
                dt = floorf(dt / TS_Q + 0.5f) * TS_Q;
#endif
#endif
#ifndef TS_SCALE
#define TS_SCALE 1.0f
#endif
                const float e = sqrtf(dt * 0.1514f * TS_SCALE);
#pragma unroll
                for (int j = 0; j < 4; ++j) x[j] = x[j] + e; }
#endif
            row_store_f32(a.out + (size_t)m * D, lane, x); }
    }
}

__device__ __forceinline__ void phase_sgu_mix(LAS unsigned char* lds, ArgsRef a, int G) {
    unsigned char* ws = a.ws;
    const int tid = opaque_tid(), lane = tid & 63, w = __builtin_amdgcn_readfirstlane(tid >> 6), l15 = lane & 15, gq = lane >> 4;
    const bf16* Z = (const bf16*)(ws + WS_Z); const float* STATS = (const float*)(ws + WS_STATS); bf16* A2 = (bf16*)(ws + WS_A2); const bf16* WSb = (const bf16*)(ws + WS_WS);
    LAS float* ST = (LAS float*)lds; LAS unsigned char* vt = lds + 1024; constexpr int VS = 272;
    for (int it = blockIdx.x; it < 128 * 8; it += G) {
        const int n = it >> 3, g = it & 7; const size_t r0 = (size_t)n * 128;
        __syncthreads();
        if (tid < 128) { const float* sp = STATS + (r0 + tid) * 32; float s1 = 0.f, s2 = 0.f;
#pragma unroll
            for (int j = 0; j < 16; ++j) { s1 += sp[2 * j]; s2 += sp[2 * j + 1]; }
            const float mean = s1 * (1.0f / 1024.0f), var = fmaxf(s2 * (1.0f / 1024.0f) - mean * mean, 0.f);
            ST[2 * tid] = mean; ST[2 * tid + 1] = rsqrtf(var + EPS); }
        __syncthreads();
        {
            const int c0 = 2 * lane; const f32x2 lw = *(const f32x2*)(a.sg_ln_w + 128 * g + c0), lbv = *(const f32x2*)(a.sg_ln_b + 128 * g + c0);
            float v0[16], v1[16];
#pragma unroll
            for (int jj = 0; jj < 16; ++jj) { const int q = 16 * w + jj; const unsigned raw = *(const unsigned*)(Z + (r0 + q) * 2048 + 1024 + 128 * g + c0);
                const float mean = ST[2 * q], rs = ST[2 * q + 1];
                v0[jj] = (bflo(raw) - mean) * rs * lw.x + lbv.x; v1[jj] = (bfhi(raw) - mean) * rs * lw.y + lbv.y; }
#pragma unroll
            for (int hh = 0; hh < 2; ++hh) { u32x4 o;
                o.x = pk2(v0[8 * hh + 0], v0[8 * hh + 1]); o.y = pk2(v0[8 * hh + 2], v0[8 * hh + 3]); o.z = pk2(v0[8 * hh + 4], v0[8 * hh + 5]); o.w = pk2(v0[8 * hh + 6], v0[8 * hh + 7]);
                *(LAS u32x4*)(vt + c0 * VS + 32 * w + 16 * hh) = o;
                o.x = pk2(v1[8 * hh + 0], v1[8 * hh + 1]); o.y = pk2(v1[8 * hh + 2], v1[8 * hh + 3]); o.z = pk2(v1[8 * hh + 4], v1[8 * hh + 5]); o.w = pk2(v1[8 * hh + 6], v1[8 * hh + 7]);
                *(LAS u32x4*)(vt + (c0 + 1) * VS + 32 * w + 16 * hh) = o; }
        }
        __syncthreads();
        f32x4 acc[8];
#pragma unroll
        for (int ct = 0; ct < 8; ++ct) acc[ct] = (f32x4){0.f, 0.f, 0.f, 0.f};
#pragma unroll
        for (int ks = 0; ks < 4; ++ks) {
            const bf16x8 av = *(const bf16x8*)(WSb + ((size_t)(g * 128 + 16 * w + l15)) * 128 + 32 * ks + 8 * gq);
#pragma unroll
            for (int ct = 0; ct < 8; ++ct) { const bf16x8 bv = *(const LAS bf16x8*)(vt + (16 * ct + l15) * VS + (32 * ks + 8 * gq) * 2);
                acc[ct] = __builtin_amdgcn_mfma_f32_16x16x32_bf16(av, bv, acc[ct], 0, 0, 0); }
        }
#pragma unroll
        for (int r = 0; r < 4; ++r) { const int p = 16 * w + 4 * gq + r; const float bias = a.sg_b_s[g * 128 + p];
#pragma unroll
            for (int ct = 0; ct < 8; ++ct) { const int c = 128 * g + 16 * ct + l15; const float u = bflo((unsigned)Z[(r0 + p) * 2048 + c]);
                ((unsigned char*)A2)[(r0 + p) * D + c] = (unsigned char)(pk4_fp8(u * (acc[ct][r] + bias), 0.f, 0.f, 0.f) & 0xffu); } }
    }
}

constexpr int N_LAUNCHES = MK_N_LAUNCHES;
__global__ void __launch_bounds__(512, 2) fwd_kernel(Args a_unused) {
    extern __shared__ __attribute__((aligned(16))) unsigned char lds_raw[];
    LAS unsigned char* lds = (LAS unsigned char*)lds_raw;
    const CAS Args* kp = (const CAS Args*)__builtin_amdgcn_kernarg_segment_ptr();
    {
        volatile LAS unsigned* MISC = (volatile LAS unsigned*)(lds + MISC_OFF);
        if (threadIdx.x < 64) MISC[threadIdx.x] = 0u;
        __syncthreads();
        if (N_LAUNCHES == 1) (void)xcd_barrier_post((unsigned*)(kp->ws + WS_CTL) + 1024, MISC + 8);
    }
#if defined(PHASE_MASK)
#define IN(k) ((((PHASE_MASK) >> (k)) & 1) && A.ph_lo <= (k) && (k) < A.ph_hi)
#elif defined(ONLY_PHASE)
#define IN(k) ((k) == ONLY_PHASE && A.ph_lo <= (k) && (k) < A.ph_hi)
#else
#define IN(k) (A.ph_lo <= (k) && (k) < A.ph_hi)
#endif
#ifdef TS_LO
#define TS_BEGIN(k) if ((k) == TS_LO && blockIdx.x == 0 && threadIdx.x == 0) { *(volatile unsigned long long*)(ws + WS_CTL + 32768) = __builtin_amdgcn_s_memrealtime(); }
#define TS_END(k) if ((k) == TS_HI - 1 && blockIdx.x == 0 && threadIdx.x == 0) { *(volatile unsigned long long*)(ws + WS_CTL + 32776) = __builtin_amdgcn_s_memrealtime(); }
#else
#define TS_BEGIN(k)
#define TS_END(k)
#endif
#define PHASE_BEGIN(k) { ArgsRef A = *launder_args(kp); if (IN(k)) { unsigned char* ws = A.ws; const int G = gridDim.x, bx = blockIdx.x; const int vcu = (G % 8 == 0) ? (bx % 8) * (G / 8) + bx / 8 : bx; (void)vcu; (void)ws; TS_BEGIN(k)
#define PHASE_END(k) if (N_LAUNCHES == 1 && (k) + 1 < A.ph_hi) { XcdBarrier bar; bar.bar = (unsigned*)(ws + WS_CTL) + 1024; bar.x = xb_xcc_id(); bar.st = (volatile LAS unsigned*)(lds + MISC_OFF) + 8; xcd_barrier(bar); } TS_END(k) } }
#define GLA_PTRS gla::Ptrs GP{(const bf16*)(ws + WS_V), (const bf16*)(ws + WS_KF), (const bf16*)(ws + WS_LFF), (const bf16*)(ws + WS_KB), (const bf16*)(ws + WS_LFB), (const bf16*)(ws + WS_Q), (const bf16*)(ws + WS_SG), \
                 (float*)(ws + WS_OF), (bf16*)(ws + WS_OG), A.hg_gnorm, (float*)(ws + WS_LST), (float*)(ws + WS_SENT), (float*)(ws + WS_LSTC), (float*)(ws + WS_DSUM), (float*)(ws + WS_DSUMC)}

    PHASE_BEGIN(0) phase_p0a(lds, A, G, vcu); PHASE_END(0)
    PHASE_BEGIN(1) phase_p0b(lds, A, G, vcu); PHASE_END(1)
    PHASE_BEGIN(2)
        const int NG = (G == 256) ? 168 : G;
        if (bx >= NG) convert_worker(lds, A, 0, Q_DONE0, (unsigned)NG);
        else {
            const float* LB = (const float*)(ws + WS_LB); LAS float* aux = (LAS float*)(lds + GEMM_AUX_OFF);
            for (int i = threadIdx.x; i < 2048; i += 512) aux[i] = LB[i];
            __syncthreads();
            pg8::Gemm g{(const bf16*)(ws + WS_H), (const bf16*)(ws + WS_WHIN), D, nullptr}; pg8::HinOrder S; S.init(NG, bx);
            pg8::EpiHin E{ws};
            pg8::gemm_phase<pg8::EpiHin, pg8::HinOrder, false, false, D>(lds, g, S, E);
            if (threadIdx.x == 0) __hip_atomic_fetch_add((unsigned*)(ws + WS_CTL) + Q_DONE0, 1u, __ATOMIC_RELAXED, __HIP_MEMORY_SCOPE_AGENT);
        }
    PHASE_END(2)
    PHASE_BEGIN(3) GLA_PTRS; gla::pass_a(lds, GP, G); PHASE_END(3)
    PHASE_BEGIN(4) GLA_PTRS; gla::pass_b(GP, G); PHASE_END(4)
    PHASE_BEGIN(5) GLA_PTRS; gla::pass_c(lds, GP, G); PHASE_END(5)
    PHASE_BEGIN(6)
        pg8::Gemm g{(const bf16*)(ws + WS_OG), (const bf16*)(ws + WS_WHOUT), D, nullptr}; pg8::GridOrder S; S.init(64, 4, G, bx, 0);
        pg8::EpiBf16<0> E{(bf16*)(ws + WS_Y), D, nullptr, 1.0f};
        pg8::gemm_phase<pg8::EpiBf16<0>, pg8::GridOrder, false, false, D>(lds, g, S, E);
    PHASE_END(6)
#define MOE_PHASES(l, p0) \
    PHASE_BEGIN(p0) phase_rowpass_a(lds, A, G, vcu, l); PHASE_END(p0) \
    PHASE_BEGIN(p0 + 1)   \
        if (bx >= NB * NE && G > NB * NE) convert_worker(lds, A, (l + 1) * 3072, (l) == 0 ? Q_DONE1 : Q_DONE2, (unsigned)(NB * NE)); \
        else { phase_topk(lds, A, G); if (G > NB * NE && threadIdx.x == 0) __hip_atomic_fetch_add((unsigned*)(ws + WS_CTL) + ((l) == 0 ? Q_DONE1 : Q_DONE2), 1u, __ATOMIC_RELAXED, __HIP_MEMORY_SCOPE_AGENT); } \
    PHASE_END(p0 + 1) \
    PHASE_BEGIN(p0 + 2)   \
        pg8::Gemm g{(const bf16*)(ws + WS_H), (const bf16*)(ws + WS_WGU + (size_t)(l) * NE * 4096 * D), D, (const int*)(ws + WS_ROWMAP)}; pg8::GridOrder S; S.init(128, 16, G, bx, 16); \
        pg8::fill_row_table(lds, S, (const unsigned*)(ws + WS_ROWMAP)); \
        pg8::EpiGU8 E{ws + WS_HID}; \
        pg8::gemm_phase<pg8::EpiGU8, pg8::GridOrder, true, true, D>(lds, g, S, E); \
    PHASE_END(p0 + 2) \
    PHASE_BEGIN(p0 + 3)   \
        pg8::Gemm g{(const bf16*)(ws + WS_HID), (const bf16*)(ws + WS_WD + (size_t)(l) * NE * D * FF), FF, nullptr}; pg8::GridOrder S; S.init(128, 4, G, bx, 4); \
        pg8::fill_row_table(lds, S, (const unsigned*)(ws + WS_GATE)); \
        pg8::EpiDown E{(bf16*)(ws + WS_YP), 0.03125f}; \
        pg8::gemm_phase<pg8::EpiDown, pg8::GridOrder, false, true, FF>(lds, g, S, E); \
    PHASE_END(p0 + 3) \
    PHASE_BEGIN(p0 + 4) phase_rowpass_b(A, G, vcu, l); PHASE_END(p0 + 4)

    MOE_PHASES(0, 7)
    PHASE_BEGIN(12)
        pg8::Gemm g{(const bf16*)(ws + WS_H), (const bf16*)(ws + WS_WSIN), D, nullptr}; pg8::GridOrder S; S.init(64, 8, G, bx, 0);
        pg8::EpiBf16<1> E{(bf16*)(ws + WS_Z), 2 * D, (float*)(ws + WS_STATS), 0.03125f};
        pg8::gemm_phase<pg8::EpiBf16<1>, pg8::GridOrder, false, true, D>(lds, g, S, E);
    PHASE_END(12)
    PHASE_BEGIN(13) phase_sgu_mix(lds, A, G); PHASE_END(13)
    PHASE_BEGIN(14)
        pg8::Gemm g{(const bf16*)(ws + WS_A2), (const bf16*)(ws + WS_WSOUT), D, nullptr}; pg8::GridOrder S; S.init(64, 4, G, bx, 0);
        pg8::EpiBf16<0> E{(bf16*)(ws + WS_Y), D, nullptr, 0.03125f};
        pg8::gemm_phase<pg8::EpiBf16<0>, pg8::GridOrder, false, true, D>(lds, g, S, E);
    PHASE_END(14)
    MOE_PHASES(1, 15)
#undef IN
}

extern "C" void kernel_launch(void* const* d_in, const int* in_sizes, int n_in, void* d_out, int out_size, void* d_ws, size_t ws_size, hipStream_t stream) {
    static int grid = 0;
    if (grid == 0) {
        if (n_in != 21 || in_sizes[0] != M * D || out_size != M * D || ws_size < WS_END) {
            fprintf(stderr, "kernel_launch: unexpected problem (n_in %d, in0 %d, out %d, ws %zu; need ws >= %zu); nothing launched\n", n_in, n_in > 0 ? in_sizes[0] : -1, out_size, ws_size, (size_t)WS_END); grid = -1; return; }
        int dev = 0, cus = 0, per_cu = 0;
        if (hipGetDevice(&dev) != hipSuccess || hipDeviceGetAttribute(&cus, hipDeviceAttributeMultiprocessorCount, dev) != hipSuccess) { grid = -1; return; }
        if (hipFuncSetAttribute((const void*)fwd_kernel, hipFuncAttributeMaxDynamicSharedMemorySize, LDS_BYTES) != hipSuccess) { fprintf(stderr, "kernel_launch: hipFuncSetAttribute failed\n"); grid = -1; return; }
        if (hipOccupancyMaxActiveBlocksPerMultiprocessor(&per_cu, (const void*)fwd_kernel, 512, LDS_BYTES) != hipSuccess || per_cu < 1) { fprintf(stderr, "kernel_launch: occupancy query reports %d blocks per CU\n", per_cu); (void)hipGetLastError(); }
        grid = cus;
    }
    if (grid < 0) return;
    (void)hipMemsetAsync((char*)d_ws + WS_CTL, 0, CTL_ZERO_BYTES, stream);
    Args a{};
    const float** fp = (const float**)&a;
    for (int i = 0; i < 21; ++i) fp[i] = (const float*)d_in[i];
    a.out = (float*)d_out; a.ws = (unsigned char*)d_ws;
    if (N_LAUNCHES == 1) { a.ph_lo = 0; a.ph_hi = NPHASE; a.li = 0; hipLaunchKernelGGL(fwd_kernel, dim3(grid), dim3(512), LDS_BYTES, stream, a); }
    else for (int li = 0; li < NPHASE; ++li) { a.ph_lo = li; a.ph_hi = li + 1; a.li = li; hipLaunchKernelGGL(fwd_kernel, dim3(grid), dim3(512), LDS_BYTES, stream, a); }
}
```

```cpp
#include <hip/hip_runtime.h>
#include <cstdio>
#include <cstdint>

#ifndef MK_N_LAUNCHES
#define MK_N_LAUNCHES 1
#endif

#define LAS __attribute__((address_space(3)))
typedef unsigned short bf16;
typedef short bf16x8 __attribute__((ext_vector_type(8)));
typedef short s16x4 __attribute__((ext_vector_type(4)));
typedef float f32x4 __attribute__((ext_vector_type(4)));
typedef float f32x2 __attribute__((ext_vector_type(2)));
typedef unsigned u32x4 __attribute__((ext_vector_type(4)));
typedef unsigned u32x2 __attribute__((ext_vector_type(2)));
typedef __bf16 bf16x2_t __attribute__((ext_vector_type(2)));
typedef int v8i __attribute__((ext_vector_type(8)));
typedef int v4i __attribute__((ext_vector_type(4)));

constexpr int NB = 2, T = 8192, D = 1024, M = NB * T, CTX = 256, MC = NB * CTX, MT = M + MC;
constexpr int NH = 8, HD = 128, NE = 16, CAP = 1024, FF = 2048, NPAIR = NB * NE * CAP;
constexpr int SCT = 512, NSC = T / SCT;
constexpr float EPS = 1e-6f;
constexpr int NPHASE = 20;

constexpr size_t MiB = 1u << 20;
constexpr size_t WS_CTL = 0, CTL_ZERO_BYTES = 64 * 1024;
constexpr size_t WS_LB = 1 * MiB;
constexpr size_t WS_MOD = 1 * MiB + 64 * 1024;
constexpr size_t WS_MODP = 2 * MiB;
constexpr size_t WS_WS = 4 * MiB;
constexpr size_t WS_WHIN = 5 * MiB;
constexpr size_t WS_WHOUT = 15 * MiB;
constexpr size_t WS_WSIN = 17 * MiB;
constexpr size_t WS_WSOUT = 21 * MiB;
constexpr size_t WS_WGU = 24 * MiB;
constexpr size_t WS_WD = 280 * MiB;
constexpr size_t WS_XR = 408 * MiB;
constexpr size_t WS_H = 472 * MiB;
constexpr size_t WS_R1 = 505 * MiB;
constexpr size_t WS_V = WS_R1, WS_KF = WS_V + 33 * MiB, WS_LFF = WS_KF + 33 * MiB, WS_KB = WS_LFF + 33 * MiB, WS_LFB = WS_KB + 33 * MiB;
constexpr size_t WS_Q = WS_LFB + 33 * MiB, WS_SG = WS_Q + 32 * MiB;
constexpr size_t WS_HID = WS_R1, WS_YP = WS_R1 + 128 * MiB;
constexpr size_t WS_Z = WS_R1, WS_A2 = WS_R1 + 64 * MiB, WS_STATS = WS_R1 + 96 * MiB;
constexpr size_t WS_OG = 734 * MiB;
constexpr size_t WS_OF = 766 * MiB;
constexpr size_t WS_LST = 830 * MiB;
constexpr size_t WS_SENT = 862 * MiB;
constexpr size_t WS_LSTC = 932 * MiB;
constexpr size_t WS_DSUM = 896 * MiB;
constexpr size_t WS_Y = 897 * MiB;
constexpr size_t WS_AFF = 929 * MiB;
constexpr size_t WS_ROWMAP = 930 * MiB;
constexpr size_t WS_GATE = 930 * MiB + 512 * 1024;
constexpr size_t WS_INV = 931 * MiB;
constexpr size_t WS_DSUMC = 896 * MiB + 512 * 1024;
constexpr size_t WS_H8 = 940 * MiB;
constexpr size_t WS_WHIN8 = 958 * MiB;
constexpr size_t WS_END = 964 * MiB;

constexpr int LDS_BYTES = 163840;
constexpr int GEMM_TAB_OFF = 131072;
constexpr int GEMM_AUX_OFF = 131072 + 8192;
constexpr int MISC_OFF = LDS_BYTES - 256;
constexpr int HALF_LDS = 81792;

__device__ __forceinline__ float bflo(unsigned u) { return __uint_as_float(u << 16); }
__device__ __forceinline__ float bfhi(unsigned u) { return __uint_as_float(u & 0xffff0000u); }
__device__ __forceinline__ unsigned pk2(float lo, float hi) { f32x2 v = {lo, hi}; bf16x2_t b = __builtin_convertvector(v, bf16x2_t); return __builtin_bit_cast(unsigned, b); }
__device__ __forceinline__ unsigned pk4_fp8(float a, float b, float c, float d) {
    a = __builtin_amdgcn_fmed3f(a, -448.f, 448.f); b = __builtin_amdgcn_fmed3f(b, -448.f, 448.f); c = __builtin_amdgcn_fmed3f(c, -448.f, 448.f); d = __builtin_amdgcn_fmed3f(d, -448.f, 448.f);
    unsigned w = 0u; w = __builtin_amdgcn_cvt_pk_fp8_f32(a, b, w, false); w = __builtin_amdgcn_cvt_pk_fp8_f32(c, d, w, true); return w;
}
#define DPP_ADD(v, ctrl) ((v) + __builtin_bit_cast(float, __builtin_amdgcn_update_dpp(0, __builtin_bit_cast(int, (v)), (ctrl), 0xF, 0xF, true)))
__device__ __forceinline__ float row16_sum(float v) {
    v = DPP_ADD(v, 0xB1); v = DPP_ADD(v, 0x4E); v = DPP_ADD(v, 0x141); v = DPP_ADD(v, 0x140);
    return v;
}
__device__ __forceinline__ float wave_sum(float v) {
    v = row16_sum(v);
    const float s0 = __builtin_bit_cast(float, __builtin_amdgcn_readlane(__builtin_bit_cast(int, v), 0)), s1 = __builtin_bit_cast(float, __builtin_amdgcn_readlane(__builtin_bit_cast(int, v), 16));
    const float s2 = __builtin_bit_cast(float, __builtin_amdgcn_readlane(__builtin_bit_cast(int, v), 32)), s3 = __builtin_bit_cast(float, __builtin_amdgcn_readlane(__builtin_bit_cast(int, v), 48));
    return (s0 + s1) + (s2 + s3);
}
__device__ __forceinline__ float sigmoidf_(float x) { return __builtin_amdgcn_rcpf(1.0f + __expf(-x)); }
__device__ __forceinline__ float siluf_(float x) { return x * __builtin_amdgcn_rcpf(1.0f + __expf(-x)); }
__device__ __forceinline__ float gelu_tanh(float x) { const float u = 0.7978845608028654f * (x + 0.044715f * x * x * x); return x * __builtin_amdgcn_rcpf(1.0f + __expf(-2.0f * u)); }
__device__ __forceinline__ int opaque_tid() { int t = threadIdx.x; asm volatile("" : "+v"(t)); return t; }
#define LDS_WAIT() asm volatile("s_waitcnt lgkmcnt(0)" ::: "memory")
#define VM_WAIT() asm volatile("s_waitcnt vmcnt(0)" ::: "memory")

#define XB_TMO      128
#define XB_XCNT(j)  (256  + 64 * (j))
#define XB_XSUB(j)  (1280 + 64 * (j))
#define XB_XGEN(j)  (2304 + 64 * (j))
#define XB_TOP      3328
#define XB_TOPGEN   3392
#define XCD_BAR_WORDS 3456
#define XB_SPIN_CAP (1u << 22)
__device__ __forceinline__ unsigned xb_ld(unsigned* p)              { return __hip_atomic_load(p, __ATOMIC_RELAXED, __HIP_MEMORY_SCOPE_AGENT); }
__device__ __forceinline__ unsigned xb_add(unsigned* p, unsigned v) { return __hip_atomic_fetch_add(p, v, __ATOMIC_RELAXED, __HIP_MEMORY_SCOPE_AGENT); }
__device__ __forceinline__ unsigned xb_xcc_id() { return (unsigned)__builtin_amdgcn_s_getreg((3 << 11) | 20) & 0xFu; }
#define XB_SPIN(cond, bar) do { unsigned _sp = 0; while (cond) { __builtin_amdgcn_s_sleep(1); \
    if ((++_sp & 255u) == 0u) { if (xb_ld(&(bar)[XB_TMO])) break; if (_sp > XB_SPIN_CAP) { atomicAdd(&(bar)[XB_TMO], 1u); break; } } } } while (0)
struct XcdBarrier { unsigned* bar; unsigned x; volatile LAS unsigned* st; };
__device__ __forceinline__ XcdBarrier xcd_barrier_post(unsigned* bar, volatile LAS unsigned* st) {
    XcdBarrier b; b.bar = bar; b.x = xb_xcc_id(); b.st = st;
    if (threadIdx.x == 0) (void)xb_add(&bar[XB_XCNT(b.x)], 1u);
    return b;
}
__device__ __forceinline__ void xcd_barrier_complete(unsigned* bar, unsigned x, unsigned& nloc, unsigned& nx) {
    const unsigned G = gridDim.x * gridDim.y * gridDim.z;
    unsigned sum, cnt, mine, sp = 0u;
    for (;;) {
        sum = 0u; cnt = 0u; mine = 0u;
#pragma unroll
        for (unsigned j = 0; j < 16; ++j) { const unsigned c = xb_ld(&bar[XB_XCNT(j)]); sum += c; cnt += (c > 0u) ? 1u : 0u; mine = (j == x) ? c : mine; }
        if (sum == G) break;
        __builtin_amdgcn_s_sleep(1);
        if ((++sp & 255u) == 0u) { if (xb_ld(&bar[XB_TMO])) break; if (sp > XB_SPIN_CAP) { atomicAdd(&bar[XB_TMO], 1u); break; } }
    }
    nloc = mine > 0u ? mine : 1u; nx = cnt > 0u ? cnt : 1u;
}
__device__ __forceinline__ void xcd_barrier(const XcdBarrier& b) {
    asm volatile("s_waitcnt vmcnt(0)" ::: "memory");
    __syncthreads();
    if (threadIdx.x == 0) {
        unsigned* bar = b.bar;
        __builtin_amdgcn_s_waitcnt(0);
        unsigned nloc = b.st[0], nx = b.st[1];
        if (nloc == 0u) { xcd_barrier_complete(bar, b.x, nloc, nx); b.st[0] = nloc; b.st[1] = nx; }
        const unsigned old = xb_add(&bar[XB_XSUB(b.x)], 1u);
        const unsigned gen = old / nloc;
        asm volatile("buffer_inv sc1" ::: "memory");
        if (old + 1u == (gen + 1u) * nloc) {
            __builtin_amdgcn_fence(__ATOMIC_RELEASE, "agent");
            asm volatile("s_waitcnt vmcnt(0)" ::: "memory");
            const unsigned og = xb_add(&bar[XB_TOP], 1u);
            const unsigned tg = og / nx;
            if (og + 1u == (tg + 1u) * nx) xb_add(&bar[XB_TOPGEN], 1u);
            else XB_SPIN(xb_ld(&bar[XB_TOPGEN]) == tg, bar);
            asm volatile("" ::: "memory");
            xb_add(&bar[XB_XGEN(b.x)], 1u);
            asm volatile("s_waitcnt vmcnt(0)" ::: "memory");
        } else {
            XB_SPIN(xb_ld(&bar[XB_XGEN(b.x)]) == gen, bar);
            asm volatile("s_waitcnt vmcnt(0)" ::: "memory");
        }
    }
    __syncthreads();
}

namespace pg8 {
constexpr int BM = 256, BK = 64, HALF = 128, HTB = HALF * BK * 2, STAGE_BYTES = 8 * HTB, NXCD = 8, WGM = 8;
__host__ __device__ __forceinline__ int lds_byte(int r, int c) { const int st = (r >> 4) * 2 + (c >> 5), rr = r & 15, cc = c & 31, ob = rr * 64 + cc * 2; return st * 1024 + (ob ^ (((ob >> 9) & 1) << 5)); }
__host__ __device__ __forceinline__ void stage_rc(int b, int& R, int& C) { const int st = b / 1024, sb = b % 1024, swz = sb ^ (((sb >> 9) & 1) << 5); R = (st >> 1) * 16 + swz / 64; C = (st & 1) * 32 + (swz % 64) / 2; }
__host__ __device__ __forceinline__ int perm32(int rho) { const int n = rho >> 4, i = rho & 15; return 8 * (i >> 2) + 4 * n + (i & 3); }

struct Unit { int pm, pn, bt; };
struct Gemm { const bf16* A; const bf16* Bt; int K; const int* rowmap; };

struct GridOrder {
    int nM, nN, nwg, G, c, bmul;
    __device__ void init(int nM_, int nN_, int G_, int c_, int bmul_) { nM = nM_; nN = nN_; nwg = nM * nN; G = G_; c = c_; bmul = bmul_; }
    __device__ __forceinline__ bool next(int i, Unit& u) const {
        const long L = (long)i * G + c; if (L >= nwg) return false;
        int wgid = (int)L; { const int q = nwg / NXCD, r = nwg % NXCD, xcd = wgid % NXCD, off = wgid / NXCD; wgid = (xcd < r ? xcd * (q + 1) : r * (q + 1) + (xcd - r) * q) + off; }
        const int nig = WGM * nN, gid = wgid / nig, fm = gid * WGM, gsz = (nM - fm) < WGM ? (nM - fm) : WGM;
        u.pm = fm + ((wgid % nig) % gsz); u.pn = (wgid % nig) / gsz; u.bt = bmul ? (u.pm >> 3) * bmul + u.pn : u.pn; return true;
    }
};
template <bool E4> struct HinOrder {
    GridOrder g;
    __device__ void init(int G_, int c_) { g.init(64, E4 ? 12 : 8, G_, c_, 0); }
    __device__ __forceinline__ bool next(int i, Unit& u) const {
        const long L = (long)i * g.G + g.c; constexpr int NLAT = 64 * (E4 ? 12 : 8), NCTX = E4 ? 4 : 8;
        if (L < NLAT) { g.next(i, u); }
        else { const int r = (int)L - NLAT; if (r >= 2 * NCTX) return false; u.pm = 64 + r / NCTX; u.pn = r % NCTX; }
        u.pn = E4 ? (u.pn < 4 ? u.pn : u.pn + 8) : u.pn + 4; u.bt = u.pn; return true;
    }
};

__device__ __forceinline__ unsigned cvt_pk_bf16(float lo, float hi) { return pk2(lo, hi); }


template <class Epi, class Sched, bool GATHER, bool F8 = false, int KC = 0>
__device__ __forceinline__ void gemm_phase(LAS unsigned char* lds, const Gemm g, const Sched& S, const Epi& E) {
    const int tid = opaque_tid(), wid = __builtin_amdgcn_readfirstlane(tid >> 6), lane = tid & 63, wr = wid >> 2, wc = wid & 3, fr = lane & 15, fq = lane >> 4;
    const int K = KC ? KC : g.K, KB = F8 ? K : 2 * K  , ntr = KB / (BK * 2);
#ifdef DUPK
    const int nt = (GATHER && F8) ? 2 * ntr : ntr;
#define KWRAP(t_) ((t_) % ntr)
#else
    const int nt = ntr;
#define KWRAP(t_) (t_)
#endif
    int RA[2], CA[2]; unsigned voffB[2], voffA[2];
#pragma unroll
    for (int i = 0; i < 2; ++i) { int R, C; stage_rc(tid * 16 + i * 8192, R, C); RA[i] = R; CA[i] = C; const int Rb = (R & ~31) + perm32(R & 31); voffB[i] = (unsigned)(Rb * KB + C * 2); voffA[i] = (unsigned)(R * KB + C * 2); }
    const size_t kstep = (size_t)(BK * 2);
    const size_t hstep = (size_t)HALF * KB;
    const size_t tstep = 2 * hstep;
    const unsigned ldsw = (unsigned)wid * 1024u;
    const int aoff = lds_byte(wr * 64 + fr, fq * 8), boff = lds_byte(wc * 32 + fr, fq * 8);
    LAS int* tab = (LAS int*)(lds + GEMM_TAB_OFF);
#define PG8_SA(b, h) (((b) * 2 + (h)) * HTB)
#define PG8_SB(b, h) ((4 + (b) * 2 + (h)) * HTB)
#define PG8_STAGE_B(bufoff, gbase) do { _Pragma("unroll") for (int _i = 0; _i < 2; ++_i) \
        __builtin_amdgcn_global_load_lds((const unsigned*)((const char*)(gbase) + voffB[_i]), (LAS unsigned*)(lds + (bufoff) + ldsw + _i * 8192), 16, 0, 0); } while (0)
#define PG8_STAGE_A(bufoff, koff, nx, h) do { _Pragma("unroll") for (int _i = 0; _i < 2; ++_i) { \
        const char* _p = GATHER ? (const char*)g.A + (koff) + ((nx) ? o2[h][_i] : oAc[h][_i]) : ((nx) ? a2b : cAb) + (koff) + (h) * hstep + voffA[_i]; \
        __builtin_amdgcn_global_load_lds((const unsigned*)_p, (LAS unsigned*)(lds + (bufoff) + ldsw + _i * 8192), 16, 0, 0); } } while (0)
#define PG8_LDA(dst, b, h) do { _Pragma("unroll") for (int m = 0; m < 4; ++m) { const v4i lo_ = *(const LAS v4i*)(lds + PG8_SA(b, h) + aoff + m * 2048), hi_ = *(const LAS v4i*)(lds + PG8_SA(b, h) + aoff + m * 2048 + 1024); dst[m] = __builtin_shufflevector(lo_, hi_, 0, 1, 2, 3, 4, 5, 6, 7); } } while (0)
#define PG8_LDB(dst, b, h) do { _Pragma("unroll") for (int n = 0; n < 2; ++n) { const v4i lo_ = *(const LAS v4i*)(lds + PG8_SB(b, h) + boff + n * 2048), hi_ = *(const LAS v4i*)(lds + PG8_SB(b, h) + boff + n * 2048 + 1024); dst[n] = __builtin_shufflevector(lo_, hi_, 0, 1, 2, 3, 4, 5, 6, 7); } } while (0)
#define PG8_MMA(ai, bj, At, Bt) do { __builtin_amdgcn_s_setprio(1); _Pragma("unroll") for (int m = 0; m < 4; ++m) _Pragma("unroll") for (int n = 0; n < 2; ++n) { \
        if constexpr (F8) {   \
            asm volatile("v_mfma_scale_f32_16x16x128_f8f6f4 %0, %1, %2, %0, %3, %3 op_sel_hi:[0,0,0]" : "+v"(acc[ai][bj][m][n]) : "v"(Bt[n]), "v"(At[m]), "v"(one_scale));   \
        } else { \
            acc[ai][bj][m][n] = __builtin_amdgcn_mfma_f32_16x16x32_bf16(__builtin_bit_cast(bf16x8, __builtin_shufflevector(Bt[n], Bt[n], 0, 1, 2, 3)), __builtin_bit_cast(bf16x8, __builtin_shufflevector(At[m], At[m], 0, 1, 2, 3)), acc[ai][bj][m][n], 0, 0, 0); \
            acc[ai][bj][m][n] = __builtin_amdgcn_mfma_f32_16x16x32_bf16(__builtin_bit_cast(bf16x8, __builtin_shufflevector(Bt[n], Bt[n], 4, 5, 6, 7)), __builtin_bit_cast(bf16x8, __builtin_shufflevector(At[m], At[m], 4, 5, 6, 7)), acc[ai][bj][m][n], 0, 0, 0); } } \
        __builtin_amdgcn_s_setprio(0); } while (0)
#define PG8_WAIT_V(n) asm volatile("s_waitcnt vmcnt(" #n ")" ::: "memory")
#define PG8_WAIT_L(n) asm volatile("s_waitcnt lgkmcnt(" #n ")" ::: "memory")
#define PG8_BAR __builtin_amdgcn_s_barrier()
#define PG8_SCHED __builtin_amdgcn_sched_barrier(0)
#define PG8_AOFFS(o, ui) do { _Pragma("unroll") for (int _h = 0; _h < 2; ++_h) _Pragma("unroll") for (int _i = 0; _i < 2; ++_i) { \
        const int _row = tab[(ui) * 256 + _h * HALF + RA[_i]]; (o)[_h][_i] = (unsigned)(_row * KB + CA[_i] * 2); } } while (0)
    Unit cur, nxt; int ui = 0;
    if (!S.next(0, cur)) return;
    int one_scale = 0x7f7f7f7f; asm volatile("" : "+v"(one_scale));
    f32x4 acc[2][2][4][2];
#pragma unroll
    for (int a = 0; a < 2; ++a)
#pragma unroll
        for (int b = 0; b < 2; ++b)
#pragma unroll
            for (int m = 0; m < 4; ++m)
#pragma unroll
                for (int n = 0; n < 2; ++n) acc[a][b][m][n] = (f32x4){0.f, 0.f, 0.f, 0.f};
    v8i At[4], B0[2], B1[2];
    unsigned oAc[2][2], oAn[2][2], o2[2][2];
#pragma unroll
    for (int h = 0; h < 2; ++h)
#pragma unroll
        for (int i = 0; i < 2; ++i) { oAc[h][i] = 0u; oAn[h][i] = 0u; o2[h][i] = 0u; }
    if (GATHER) { PG8_AOFFS(oAc, 0); }
    const char* cAb = (const char*)g.A + (size_t)cur.pm * tstep; const char* a2b = cAb;
    const char* cB = (const char*)g.Bt + (size_t)cur.bt * tstep;
    PG8_STAGE_B(PG8_SB(0, 0), cB); PG8_STAGE_B(PG8_SB(0, 1), cB + hstep); PG8_STAGE_A(PG8_SA(0, 0), 0, 0, 0); PG8_STAGE_A(PG8_SA(0, 1), 0, 0, 1);
    if (wr == 1) PG8_BAR;
    PG8_WAIT_V(2); PG8_BAR;
    PG8_STAGE_B(PG8_SB(1, 0), cB + kstep); PG8_STAGE_A(PG8_SA(1, 0), kstep, 0, 0); PG8_STAGE_B(PG8_SB(1, 1), cB + hstep + kstep);
    PG8_WAIT_V(6); PG8_BAR;
    for (;;) {
        const bool has_next = S.next(ui + 1, nxt);
        if (GATHER) {
            if (has_next) { PG8_AOFFS(oAn, ui + 1); }
            else {
#pragma unroll
                for (int h = 0; h < 2; ++h)
#pragma unroll
                    for (int i = 0; i < 2; ++i) oAn[h][i] = oAc[h][i];
            }
        }
        const char* nAb = has_next ? (const char*)g.A + (size_t)nxt.pm * tstep : cAb;
        const char* nB = has_next ? (const char*)g.Bt + (size_t)nxt.bt * tstep : cB;
#pragma unroll 1
        for (int t = 0; t < nt; t += 2) {
            const bool last = (t == nt - 2);
            const size_t k1 = (size_t)KWRAP(t + 1) * kstep;
            const size_t k2 = last ? 0 : (size_t)KWRAP(t + 2) * kstep, k3 = k2 + kstep;
            if (GATHER) {
#pragma unroll
                for (int h = 0; h < 2; ++h)
#pragma unroll
                    for (int i = 0; i < 2; ++i) o2[h][i] = last ? oAn[h][i] : oAc[h][i];
            }
            a2b = last ? nAb : cAb;
            const char* b2 = last ? nB : cB + (size_t)KWRAP(t + 2) * kstep; const char* b3 = b2 + kstep;
            PG8_LDB(B0, 0, 0); PG8_LDB(B1, 0, 1); PG8_SCHED; PG8_LDA(At, 0, 0); PG8_STAGE_A(PG8_SA(1, 1), k1, 0, 1);
            PG8_WAIT_V(8); PG8_WAIT_L(0); PG8_BAR; PG8_MMA(0, 0, At, B0); PG8_MMA(0, 1, At, B1); PG8_BAR; PG8_SCHED;
            PG8_LDA(At, 0, 1); PG8_STAGE_B(PG8_SB(0, 0), b2); PG8_STAGE_B(PG8_SB(0, 1), b2 + hstep); PG8_STAGE_A(PG8_SA(0, 0), k2, 1, 0);
            PG8_WAIT_V(8); PG8_WAIT_L(0); PG8_BAR; PG8_MMA(1, 0, At, B0); PG8_MMA(1, 1, At, B1); PG8_BAR; PG8_SCHED;
            PG8_LDB(B0, 1, 0); PG8_LDB(B1, 1, 1); PG8_SCHED; PG8_LDA(At, 1, 0); PG8_STAGE_A(PG8_SA(0, 1), k2, 1, 1);
            PG8_WAIT_V(8); PG8_WAIT_L(0); PG8_BAR; PG8_MMA(0, 0, At, B0); PG8_MMA(0, 1, At, B1); PG8_BAR; PG8_SCHED;
            PG8_LDA(At, 1, 1); PG8_STAGE_B(PG8_SB(1, 0), b3); PG8_STAGE_B(PG8_SB(1, 1), b3 + hstep); PG8_STAGE_A(PG8_SA(1, 0), k3, 1, 0);
            PG8_WAIT_V(8); PG8_WAIT_L(0); PG8_BAR; PG8_MMA(1, 0, At, B0); PG8_MMA(1, 1, At, B1); PG8_BAR; PG8_SCHED;
        }
        if (wr == 0) PG8_BAR;
        if constexpr (F8) asm volatile("s_nop 15\n\ts_nop 15" ::: "memory");
        E(acc, cur, ui, wr, wc, fr, fq, lds);
        if (!has_next) break;
#pragma unroll
        for (int a = 0; a < 2; ++a)
#pragma unroll
            for (int b = 0; b < 2; ++b)
#pragma unroll
                for (int m = 0; m < 4; ++m)
#pragma unroll
                    for (int n = 0; n < 2; ++n) acc[a][b][m][n] = (f32x4){0.f, 0.f, 0.f, 0.f};
        cur = nxt; cB = nB; cAb = nAb; ++ui;
        if (GATHER) {
#pragma unroll
            for (int h = 0; h < 2; ++h)
#pragma unroll
                for (int i = 0; i < 2; ++i) oAc[h][i] = oAn[h][i];
        }
        if (wr == 1) PG8_BAR;
    }
    PG8_WAIT_V(0);
    PG8_BAR;
#undef PG8_SA
#undef PG8_SB
#undef PG8_STAGE_A
#undef PG8_STAGE_B
#undef PG8_LDA
#undef PG8_LDB
#undef PG8_MMA
#undef PG8_WAIT_V
#undef PG8_WAIT_L
#undef PG8_BAR
#undef PG8_SCHED
#undef PG8_AOFFS
}

#define EPI_ROWS_BEGIN(u) \
    _Pragma("unroll") for (int ai = 0; ai < 2; ++ai) _Pragma("unroll") for (int m = 0; m < 4; ++m) { const int row = (u).pm * BM + ai * HALF + wr * 64 + m * 16 + fr; const int rloc = ai * HALF + wr * 64 + m * 16 + fr; (void)rloc; (void)row;
#define EPI_ROWS_END }

template <bool E4> struct EpiHin {
    unsigned char* ws;
    __device__ __forceinline__ void operator()(const f32x4 (&acc)[2][2][4][2], const Unit& u, int ui, int wr, int wc, int fr, int fq, LAS unsigned char* lds) const {
        const int region = u.pn >> 2, cc0 = (u.pn & 3) * 256 + wc * 32 + 8 * fq;
        const LAS float* lbt = (const LAS float*)(lds + GEMM_AUX_OFF);
        if constexpr (E4) {
            bf16* O = (bf16*)(ws + (region == 0 ? WS_V : (region == 3 ? WS_Q : WS_SG)));
            EPI_ROWS_BEGIN(u)
                bf16* rowp = O + (size_t)row * D + cc0;
#pragma unroll
                for (int bj = 0; bj < 2; ++bj) { f32x4 v0 = acc[ai][bj][m][0] * (1.0f / 32.0f), v1 = acc[ai][bj][m][1] * (1.0f / 32.0f);
                    if (region != 0) {
#pragma unroll
                        for (int j = 0; j < 4; ++j) { v0[j] = siluf_(v0[j]); v1[j] = siluf_(v1[j]); } }
                    u32x4 w; w.x = pk2(v0[0], v0[1]); w.y = pk2(v0[2], v0[3]); w.z = pk2(v1[0], v1[1]); w.w = pk2(v1[2], v1[3]);
                    *(u32x4*)(rowp + bj * HALF) = w; }
            EPI_ROWS_END
        } else {
            bf16* OL = (bf16*)(ws + (region == 1 ? WS_LFF : WS_LFB));
            EPI_ROWS_BEGIN(u)
                const size_t ro = (size_t)row * D + cc0;
#pragma unroll
                for (int bj = 0; bj < 2; ++bj) {
                    const f32x4 l0 = *(const LAS f32x4*)(lbt + (region - 1) * 1024 + cc0 + bj * HALF), l1 = *(const LAS f32x4*)(lbt + (region - 1) * 1024 + cc0 + bj * HALF + 4);
                    f32x4 f0, f1;
#pragma unroll
                    for (int j = 0; j < 4; ++j) {
                        { const float a = acc[ai][bj][m][0][j], l = l0[j], sg = __builtin_amdgcn_rcpf(1.0f + __expf(-a)); f0[j] = __builtin_amdgcn_logf(l + (1.0f - l) * sg); }
                        { const float a = acc[ai][bj][m][1][j], l = l1[j], sg = __builtin_amdgcn_rcpf(1.0f + __expf(-a)); f1[j] = __builtin_amdgcn_logf(l + (1.0f - l) * sg); }
                    }
                    u32x4 w; w.x = pk2(f0[0], f0[1]); w.y = pk2(f0[2], f0[3]); w.z = pk2(f1[0], f1[1]); w.w = pk2(f1[2], f1[3]);
                    *(u32x4*)(OL + ro + bj * HALF) = w; }
            EPI_ROWS_END
        }
    }
};
template <int ACT> struct EpiBf16 {
    bf16* O; int ldc; float* stats; float scale;
    __device__ __forceinline__ void operator()(const f32x4 (&acc)[2][2][4][2], const Unit& u, int ui, int wr, int wc, int fr, int fq, LAS unsigned char* lds) const {
        const int col0 = u.pn * BM + wc * 32 + 8 * fq;
        EPI_ROWS_BEGIN(u)
            bf16* rowp = O + (size_t)row * ldc + col0; float s1 = 0.f, s2 = 0.f;
#pragma unroll
            for (int bj = 0; bj < 2; ++bj) { f32x4 v0 = acc[ai][bj][m][0] * scale, v1 = acc[ai][bj][m][1] * scale;
                if (ACT == 1) {
#pragma unroll
                    for (int j = 0; j < 4; ++j) { v0[j] = gelu_tanh(v0[j]); v1[j] = gelu_tanh(v1[j]); s1 += v0[j] + v1[j]; s2 += v0[j] * v0[j] + v1[j] * v1[j]; } }
                u32x4 w; w.x = pk2(v0[0], v0[1]); w.y = pk2(v0[2], v0[3]); w.z = pk2(v1[0], v1[1]); w.w = pk2(v1[2], v1[3]);
                *(u32x4*)(rowp + bj * HALF) = w; }
            if (ACT == 1) { s1 += __shfl_xor(s1, 16); s1 += __shfl_xor(s1, 32); s2 += __shfl_xor(s2, 16); s2 += __shfl_xor(s2, 32);
                if (u.pn >= 4 && fq == 0) *(f32x2*)(stats + ((size_t)row * 16 + (u.pn - 4) * 4 + wc) * 2) = (f32x2){s1, s2}; }
        EPI_ROWS_END
    }
};
struct EpiGU {
    bf16* Hd;
    __device__ __forceinline__ void operator()(const f32x4 (&acc)[2][2][4][2], const Unit& u, int ui, int wr, int wc, int fr, int fq, LAS unsigned char* lds) const {
        const int col0 = u.pn * HALF + wc * 32 + 8 * fq;
        EPI_ROWS_BEGIN(u)
            f32x4 g0 = acc[ai][0][m][0], g1 = acc[ai][0][m][1], u0 = acc[ai][1][m][0], u1 = acc[ai][1][m][1];
#pragma unroll
            for (int j = 0; j < 4; ++j) { g0[j] = siluf_(g0[j]) * u0[j]; g1[j] = siluf_(g1[j]) * u1[j]; }
            u32x4 w; w.x = pk2(g0[0], g0[1]); w.y = pk2(g0[2], g0[3]); w.z = pk2(g1[0], g1[1]); w.w = pk2(g1[2], g1[3]);
            *(u32x4*)(Hd + (size_t)row * FF + col0) = w;
        EPI_ROWS_END
    }
};
struct EpiGU8 {
    unsigned char* Hd;
    __device__ __forceinline__ void operator()(const f32x4 (&acc)[2][2][4][2], const Unit& u, int ui, int wr, int wc, int fr, int fq, LAS unsigned char* lds) const {
        const int col0 = u.pn * HALF + wc * 32 + 8 * fq;
        EPI_ROWS_BEGIN(u)
#ifdef DUPK
            constexpr float GS = 0.015625f;
#else
            constexpr float GS = 0.03125f;
#endif
            f32x4 g0 = acc[ai][0][m][0] * GS, g1 = acc[ai][0][m][1] * GS, u0 = acc[ai][1][m][0] * GS, u1 = acc[ai][1][m][1] * GS;
#pragma unroll
            for (int j = 0; j < 4; ++j) { g0[j] = siluf_(g0[j]) * u0[j]; g1[j] = siluf_(g1[j]) * u1[j]; }
            u32x2 w; w.x = pk4_fp8(g0[0], g0[1], g0[2], g0[3]); w.y = pk4_fp8(g1[0], g1[1], g1[2], g1[3]);
            *(u32x2*)(Hd + (size_t)row * FF + col0) = w;
        EPI_ROWS_END
    }
};
struct EpiDown {
    bf16* Yp; float scale;
    __device__ __forceinline__ void operator()(const f32x4 (&acc)[2][2][4][2], const Unit& u, int ui, int wr, int wc, int fr, int fq, LAS unsigned char* lds) const {
        const int col0 = u.pn * BM + wc * 32 + 8 * fq;
        const LAS float* gt = (const LAS float*)(lds + GEMM_TAB_OFF) + ui * 256;
        EPI_ROWS_BEGIN(u)
            const float gv = gt[rloc] * scale * 16.0f; unsigned char* rowp = (unsigned char*)Yp + (size_t)row * D + col0;
#pragma unroll
            for (int bj = 0; bj < 2; ++bj) { const f32x4 v0 = acc[ai][bj][m][0] * gv, v1 = acc[ai][bj][m][1] * gv;
                u32x2 w; w.x = pk4_fp8(v0[0], v0[1], v0[2], v0[3]); w.y = pk4_fp8(v1[0], v1[1], v1[2], v1[3]);
                *(u32x2*)(rowp + bj * HALF) = w; }
        EPI_ROWS_END
    }
};
template <class Sched> __device__ __forceinline__ void fill_row_table(LAS unsigned char* lds, const Sched& S, const unsigned* src) {
    LAS unsigned* tab = (LAS unsigned*)(lds + GEMM_TAB_OFF); Unit u;
    for (int i = 0; i < 8 && S.next(i, u); ++i) if (threadIdx.x < 256) tab[i * 256 + threadIdx.x] = src[u.pm * 256 + threadIdx.x];
    VM_WAIT(); LDS_WAIT(); __syncthreads();
}
}

#ifdef TS_SEG_LO
#define GT(k) do { asm volatile("" ::: "memory"); const unsigned long long now_ = __builtin_amdgcn_s_memrealtime(); if ((k) == TS_SEG_LO) gt[1] = now_; if ((k) == TS_SEG_HI) gt[0] += now_ - gt[1]; if ((k) == 0) gt[3] = now_; if ((k) == 8) gt[2] += now_ - gt[3]; asm volatile("" ::: "memory"); } while (0)
#define GT_DRAIN() asm volatile("s_waitcnt vmcnt(0) lgkmcnt(0)" ::: "memory")
#else
#define GT(k) do { } while (0)
#define GT_DRAIN() do { } while (0)
#endif
namespace gla {
__device__ __forceinline__ float ex2(float x) { return __builtin_amdgcn_exp2f(x); }
constexpr int QX_OFF = 0, KE_OFF = 17408, KST_OFF = 34816, VT_OFF = 53248, TOT_OFF = 71680, DG_OFF = 73728, OD_OFF = 75776, DEC_OFF = 77312, SSQ_OFF = 77824;
constexpr int QSTR = 272, PSTR = 144, TSTR = 144;
static_assert(SSQ_OFF + 1024 <= HALF_LDS, "gla LDS map");

__device__ __forceinline__ bf16x8 scale8(bf16x8 a, f32x4 f0, f32x4 f1) {
    u32x4 w = __builtin_bit_cast(u32x4, a);
    w.x = pk2(bflo(w.x) * f0[0], bfhi(w.x) * f0[1]); w.y = pk2(bflo(w.y) * f0[2], bfhi(w.y) * f0[3]);
    w.z = pk2(bflo(w.z) * f1[0], bfhi(w.z) * f1[1]); w.w = pk2(bflo(w.w) * f1[2], bfhi(w.w) * f1[3]);
    return __builtin_bit_cast(bf16x8, w);
}

__device__ __forceinline__ void half_barrier(volatile LAS unsigned* cnt, unsigned& gen, int lane) {
    asm volatile("s_waitcnt lgkmcnt(0)" ::: "memory");
    gen += 4u;
    if (lane == 0) {
        __hip_atomic_fetch_add((LAS unsigned*)cnt, 1u, __ATOMIC_RELAXED, __HIP_MEMORY_SCOPE_WORKGROUP);
        while (__hip_atomic_load((LAS unsigned*)cnt, __ATOMIC_RELAXED, __HIP_MEMORY_SCOPE_WORKGROUP) < gen) __builtin_amdgcn_s_sleep(1);
    }
    asm volatile("" ::: "memory");
}
template <int WHICH>
__device__ __forceinline__ void issue_loads(int lane, int J, const bf16* LFp, const bf16* Vp, const bf16* Qp, long row0, int rstep, int hc, unsigned (&lraw)[16], unsigned (&vraw)[16], unsigned (&qraw)[16]) {
    const unsigned base = ((unsigned)((int)row0 + rstep * (16 * J)) * (unsigned)D + (unsigned)(hc + 2 * lane)) * 2u; const int rs = rstep * (D * 2);
    if (WHICH & 1) {
#pragma unroll
        for (int jj = 0; jj < 16; ++jj) lraw[jj] = *(const unsigned*)((const char*)LFp + (base + (unsigned)(rs * jj)));
#pragma unroll
        for (int jj = 0; jj < 16; ++jj) vraw[jj] = *(const unsigned*)((const char*)Vp + (base + (unsigned)(rs * jj)));
    }
    if (WHICH & 2) {
#pragma unroll
        for (int jj = 0; jj < 16; ++jj) qraw[jj] = *(const unsigned*)((const char*)Qp + (base + (unsigned)(rs * jj)));
    }
}
template <bool OUT>
__device__ __forceinline__ void step(LAS unsigned char* hl, int hw, int lane_in, const bf16* Kp, const bf16* LFp, const bf16* Vp, const bf16* Qp, const bf16* SGp,
                                     long row0, int rstep, int hc, f32x4 (&Sacc)[8][2], float& dsum0, float& dsum1, volatile LAS unsigned* hbc, unsigned& hgen, bf16* OFd, unsigned long long (&gt)[4],
                                     unsigned (&lraw)[16], unsigned (&vraw)[16], unsigned (&qraw)[16], bool more, long next_row0) {
    GT(0);
    int lane = lane_in; asm volatile("" : "+v"(lane));
    const int J = hw, c0 = 2 * lane, l15 = lane & 15, g = lane >> 4;
    GT_DRAIN(); GT(1);
    float a0 = 0.f, a1 = 0.f;
#pragma unroll
    for (int jj = 0; jj < 16; ++jj) { a0 += bflo(lraw[jj]); a1 += bfhi(lraw[jj]); }
    LAS float* TOT = (LAS float*)(hl + TOT_OFF);
    *(LAS f32x2*)(TOT + J * 128 + c0) = (f32x2){a0, a1};
    half_barrier(hbc, hgen, lane);
    GT(2);
    if (OUT) issue_loads<2>(lane, J, LFp, Vp, Qp, row0, rstep, hc, lraw, vraw, qraw);
    float t0[4], t1[4];
#pragma unroll
    for (int I = 0; I < 4; ++I) { const f32x2 t = *(const LAS f32x2*)(TOT + I * 128 + c0); t0[I] = t.x; t1[I] = t.y; }
    float RJ0 = 0.f, RJ1 = 0.f, RA0 = 0.f, RA1 = 0.f;
#pragma unroll
    for (int I = 0; I < 4; ++I) { if (I < J) { RJ0 += t0[I]; RJ1 += t1[I]; } if (I > J) { RA0 += t0[I]; RA1 += t1[I]; } }
    const float R40 = (t0[0] + t0[1]) + (t0[2] + t0[3]), R41 = (t1[0] + t1[1]) + (t1[2] + t1[3]);
    {
        LAS float* DG = (LAS float*)(hl + DG_OFF); LAS float* OD = (LAS float*)(hl + OD_OFF); LAS float* DEC = (LAS float*)(hl + DEC_OFF);
        *(LAS f32x2*)(DG + J * 128 + c0) = (f32x2){ex2(fminf(-a0, 115.f)), ex2(fminf(-a1, 115.f))};
        if (J == 0) { *(LAS f32x2*)(DEC + c0) = (f32x2){ex2(R40), ex2(R41)}; dsum0 += R40; dsum1 += R41; }
        else if (J == 1) *(LAS f32x2*)(OD + 0 * 128 + c0) = (f32x2){ex2(t0[1]), ex2(t1[1])};
        else if (J == 2) *(LAS f32x2*)(OD + 1 * 128 + c0) = (f32x2){ex2(t0[2]), ex2(t1[2])};
        else *(LAS f32x2*)(OD + 2 * 128 + c0) = (f32x2){ex2(t0[1] + t0[2]), ex2(t1[1] + t1[2])};
    }
    const float eR0 = ex2(RJ0), eR1 = ex2(RJ1), eA0 = ex2(RA0), eA1 = ex2(RA1);
    unsigned qs[16];
    {
        float su0 = 1.0f, su1 = 1.0f;
#pragma unroll
        for (int hh = 1; hh >= 0; --hh) {
            float ks0[8], ks1[8];
#pragma unroll
            for (int j8 = 7; j8 >= 0; --j8) {
                const int jj = 8 * hh + j8, i = 16 * J + jj;
                const float f0 = ex2(bflo(lraw[jj])), f1 = ex2(bfhi(lraw[jj]));
                const float ke0 = (1.0f - f0) * su0, ke1 = (1.0f - f1) * su1;
                ks0[j8] = ke0 * eA0; ks1[j8] = ke1 * eA1;
                if (OUT) *(LAS unsigned*)(hl + KE_OFF + i * QSTR + c0 * 2) = pk2(ke0, ke1);
                su0 *= f0; su1 *= f1;
            }
            u32x4 w;
            w.x = pk2(ks0[0], ks0[1]); w.y = pk2(ks0[2], ks0[3]); w.z = pk2(ks0[4], ks0[5]); w.w = pk2(ks0[6], ks0[7]);
            *(LAS u32x4*)(hl + KST_OFF + c0 * TSTR + 32 * J + 16 * hh) = w;
            w.x = pk2(ks1[0], ks1[1]); w.y = pk2(ks1[2], ks1[3]); w.z = pk2(ks1[4], ks1[5]); w.w = pk2(ks1[6], ks1[7]);
            *(LAS u32x4*)(hl + KST_OFF + (c0 + 1) * TSTR + 32 * J + 16 * hh) = w;
#define VLO(a, b) ((vraw[a] & 0xffffu) | (vraw[b] << 16))
#define VHI(a, b) ((vraw[a] >> 16) | (vraw[b] & 0xffff0000u))
            w.x = VLO(8 * hh + 0, 8 * hh + 1); w.y = VLO(8 * hh + 2, 8 * hh + 3); w.z = VLO(8 * hh + 4, 8 * hh + 5); w.w = VLO(8 * hh + 6, 8 * hh + 7);
            *(LAS u32x4*)(hl + VT_OFF + c0 * TSTR + 32 * J + 16 * hh) = w;
            w.x = VHI(8 * hh + 0, 8 * hh + 1); w.y = VHI(8 * hh + 2, 8 * hh + 3); w.z = VHI(8 * hh + 4, 8 * hh + 5); w.w = VHI(8 * hh + 6, 8 * hh + 7);
            *(LAS u32x4*)(hl + VT_OFF + (c0 + 1) * TSTR + 32 * J + 16 * hh) = w;
#undef VLO
#undef VHI
        }
        if (OUT) {
            float pr0 = 1.0f, pr1 = 1.0f;
#pragma unroll
            for (int jj = 0; jj < 16; ++jj) {
                pr0 *= ex2(bflo(lraw[jj])); pr1 *= ex2(bfhi(lraw[jj]));
                const float qt0 = bflo(qraw[jj]) * pr0, qt1 = bfhi(qraw[jj]) * pr1;
                *(LAS unsigned*)(hl + QX_OFF + (16 * J + jj) * QSTR + c0 * 2) = pk2(qt0, qt1);
                qs[jj] = pk2(qt0 * eR0, qt1 * eR1);
            }
        } else {
#pragma unroll
            for (int jj = 0; jj < 16; ++jj) qs[jj] = 0u;
        }
    }
    GT_DRAIN(); GT(3);
    half_barrier(hbc, hgen, lane);
    GT(4);
    if (more) issue_loads<1>(lane, J, LFp, Vp, Qp, next_row0, rstep, hc, lraw, vraw, qraw);
    f32x4 o[4][2];
    if (OUT) {
        const int I = hw;
        f32x4 sc[4];
#pragma unroll
        for (int Jp = 0; Jp < 4; ++Jp) {
            sc[Jp] = (f32x4){0.f, 0.f, 0.f, 0.f};
            if (Jp <= I) {
                const LAS float* ft = (Jp == I) ? (const LAS float*)(hl + DG_OFF) + I * 128
                                    : ((I - Jp == 2) ? (const LAS float*)(hl + OD_OFF) + (I - 2) * 128 : (const LAS float*)(hl + OD_OFF) + 2 * 128);
                const bool needf = (Jp != I - 1);
                f32x4 acc = (f32x4){0.f, 0.f, 0.f, 0.f};
#pragma unroll
                for (int ks = 0; ks < 4; ++ks) {
                    bf16x8 a = *(const LAS bf16x8*)(hl + QX_OFF + (16 * I + l15) * QSTR + (32 * ks + 8 * g) * 2);
                    if (needf) { const f32x4 f0 = *(const LAS f32x4*)(ft + 32 * ks + 8 * g), f1 = *(const LAS f32x4*)(ft + 32 * ks + 8 * g + 4); a = scale8(a, f0, f1); }
                    const bf16x8 b = *(const LAS bf16x8*)(hl + KE_OFF + (16 * Jp + l15) * QSTR + (32 * ks + 8 * g) * 2);
                    acc = __builtin_amdgcn_mfma_f32_16x16x32_bf16(a, b, acc, 0, 0, 0);
                }
                if (Jp == I) {
#pragma unroll
                    for (int r = 0; r < 4; ++r) if (l15 > 4 * g + r) acc[r] = 0.f;
                }
                sc[Jp] = acc;
            }
        }
        GT(5);
        half_barrier(hbc, hgen, lane);
        GT(6);
#pragma unroll
        for (int Jp = 0; Jp < 4; ++Jp) {
            const bool wr_blk = (Jp <= I) || (I == 0 && Jp == 1) || (I == 2 && Jp == 3);
            if (wr_blk) {
#pragma unroll
                for (int r = 0; r < 4; ++r) *(LAS unsigned short*)(hl + KE_OFF + (16 * I + 4 * g + r) * PSTR + (16 * Jp + l15) * 2) = (unsigned short)(pk2(sc[Jp][r], 0.f) & 0xffffu);
            }
        }
#pragma unroll
        for (int jj = 0; jj < 16; ++jj) *(LAS unsigned*)(hl + QX_OFF + (16 * J + jj) * QSTR + c0 * 2) = qs[jj];
        half_barrier(hbc, hgen, lane);
        GT(7);
    }
    bf16x8 vb[2][2];
#pragma unroll
    for (int ct = 0; ct < 2; ++ct)
#pragma unroll
        for (int js = 0; js < 2; ++js) vb[ct][js] = *(const LAS bf16x8*)(hl + VT_OFF + (32 * hw + 16 * ct + l15) * TSTR + (32 * js + 8 * g) * 2);
    if (OUT) {
#pragma unroll
        for (int I = 0; I < 4; ++I) {
            o[I][0] = (f32x4){0.f, 0.f, 0.f, 0.f}; o[I][1] = (f32x4){0.f, 0.f, 0.f, 0.f};
#pragma unroll
            for (int ks = 0; ks < (I < 2 ? 1 : 2); ++ks) {
                const bf16x8 pa = *(const LAS bf16x8*)(hl + KE_OFF + (16 * I + l15) * PSTR + (32 * ks + 8 * g) * 2);
                o[I][0] = __builtin_amdgcn_mfma_f32_16x16x32_bf16(pa, vb[0][ks], o[I][0], 0, 0, 0);
                o[I][1] = __builtin_amdgcn_mfma_f32_16x16x32_bf16(pa, vb[1][ks], o[I][1], 0, 0, 0);
            }
        }
#pragma unroll
        for (int ks = 0; ks < 4; ++ks) {
            bf16x8 Sb[2];
#pragma unroll
            for (int ct = 0; ct < 2; ++ct) { const f32x4 s0 = Sacc[2 * ks][ct], s1 = Sacc[2 * ks + 1][ct]; u32x4 w; w.x = pk2(s0[0], s0[1]); w.y = pk2(s0[2], s0[3]); w.z = pk2(s1[0], s1[1]); w.w = pk2(s1[2], s1[3]); Sb[ct] = __builtin_bit_cast(bf16x8, w); }
#pragma unroll
            for (int I = 0; I < 4; ++I) {
                const u32x2 lo = *(const LAS u32x2*)(hl + QX_OFF + (16 * I + l15) * QSTR + (32 * ks + 4 * g) * 2), hi = *(const LAS u32x2*)(hl + QX_OFF + (16 * I + l15) * QSTR + (32 * ks + 16 + 4 * g) * 2);
                const bf16x8 qa = __builtin_bit_cast(bf16x8, (u32x4){lo.x, lo.y, hi.x, hi.y});
                o[I][0] = __builtin_amdgcn_mfma_f32_16x16x32_bf16(qa, Sb[0], o[I][0], 0, 0, 0);
                o[I][1] = __builtin_amdgcn_mfma_f32_16x16x32_bf16(qa, Sb[1], o[I][1], 0, 0, 0);
            }
        }
    }
#pragma unroll
    for (int kt = 0; kt < 8; ++kt) {
        const f32x4 d = *(const LAS f32x4*)(hl + DEC_OFF + (16 * kt + 4 * g) * 4);
        Sacc[kt][0] = Sacc[kt][0] * d; Sacc[kt][1] = Sacc[kt][1] * d;
#pragma unroll
        for (int js = 0; js < 2; ++js) {
            const bf16x8 ka = *(const LAS bf16x8*)(hl + KST_OFF + (16 * kt + l15) * TSTR + (32 * js + 8 * g) * 2);
            Sacc[kt][0] = __builtin_amdgcn_mfma_f32_16x16x32_bf16(ka, vb[0][js], Sacc[kt][0], 0, 0, 0);
            Sacc[kt][1] = __builtin_amdgcn_mfma_f32_16x16x32_bf16(ka, vb[1][js], Sacc[kt][1], 0, 0, 0);
        }
    }
    if (OUT) {
        const unsigned cbase = (unsigned)(hc + 32 * hw + l15);
#pragma unroll
        for (int I = 0; I < 4; ++I)
#pragma unroll
            for (int r = 0; r < 4; ++r) { const unsigned ro = (unsigned)((int)row0 + rstep * (16 * I + 4 * g + r)) * (unsigned)D + cbase;
                OFd[ro] = (bf16)(pk2(o[I][0][r], 0.f) & 0xffffu); OFd[ro + 16] = (bf16)(pk2(o[I][1][r], 0.f) & 0xffffu); }
    }
    GT(8);
}

struct Ptrs { const bf16 *V, *KF, *LFF, *KB, *LFB, *Q, *SG; float* OF; bf16* OG; const float* gn; float *LST, *SENT, *LSTC, *DSUM, *DSUMC; };

__device__ __forceinline__ void pass_a(LAS unsigned char* lds, const Ptrs& P, int G) {
    const int tid = opaque_tid(), wid = __builtin_amdgcn_readfirstlane(tid >> 6), lane = tid & 63, dir = wid >> 2, hw = wid & 3, l15 = lane & 15, g = lane >> 4;
    LAS unsigned char* hl = lds + dir * HALF_LDS;
    const bf16* Kp = dir ? P.KB : P.KF; const bf16* LFp = dir ? P.LFB : P.LFF;
    volatile LAS unsigned* hbc = (volatile LAS unsigned*)(lds + MISC_OFF) + 16 + dir * 4; unsigned hgen = 0u;
    if (tid < 8) ((volatile LAS unsigned*)(lds + MISC_OFF))[16 + tid] = 0u;
    __syncthreads();
    for (int it = blockIdx.x; it < 320; it += G) {
        const bool isctx = it >= 256;
        int b, h, sc, nsteps; long base;
        if (!isctx) { b = it >> 7; h = (it >> 4) & 7; sc = it & 15; nsteps = 8; base = (long)b * T + sc * SCT; }
        else { const int r = it - 256; b = r >> 5; h = (r >> 2) & 7; sc = r & 3; nsteps = 1; base = (long)M + b * CTX + 64 * sc; }
        f32x4 Sacc[8][2];
#pragma unroll
        for (int kt = 0; kt < 8; ++kt) { Sacc[kt][0] = (f32x4){0.f, 0.f, 0.f, 0.f}; Sacc[kt][1] = (f32x4){0.f, 0.f, 0.f, 0.f}; }
        float ds0 = 0.f, ds1 = 0.f; unsigned long long gt[4] = {0ull, 0ull, 0ull, 0ull};
        unsigned lraw[16], vraw[16], qraw[16];
        issue_loads<1>(lane, hw, LFp, P.V, P.Q, dir ? base + 64 * (nsteps - 1) + 63 : base, dir ? -1 : 1, h * HD, lraw, vraw, qraw);
#pragma unroll
        for (int jj = 0; jj < 16; ++jj) qraw[jj] = 0u;
        for (int s = 0; s < nsteps; ++s) {
            const long row0 = dir ? base + 64 * (nsteps - 1 - s) + 63 : base + 64 * s;
            step<false>(hl, hw, lane, Kp, LFp, P.V, P.Q, P.SG, row0, dir ? -1 : 1, h * HD, Sacc, ds0, ds1, hbc, hgen, nullptr, gt, lraw, vraw, qraw, s + 1 < nsteps, dir ? row0 - 64 : row0 + 64);
        }
#ifdef TS_SEG_LO
        if (it == TS_SEG_ITEM && tid == TS_SEG_TID && TS_SEG_PASS == 0) { *(volatile unsigned long long*)((unsigned char*)P.DSUM - WS_DSUM + WS_CTL + 32768) = 0ull; *(volatile unsigned long long*)((unsigned char*)P.DSUM - WS_DSUM + WS_CTL + 32776) = (unsigned long long)((float)gt[0] * 10000.0f / (float)gt[2]); }
#endif
        const int seq = (b * NH + h) * 2 + dir;
        if (isctx) { float* dst = P.LSTC + ((size_t)seq * 4 + sc) * 16384;
#pragma unroll
            for (int kt = 0; kt < 8; ++kt)
#pragma unroll
                for (int ct = 0; ct < 2; ++ct)
#pragma unroll
                    for (int r = 0; r < 4; ++r) dst[(16 * kt + 4 * g + r) * 128 + 32 * hw + 16 * ct + l15] = Sacc[kt][ct][r];
        } else { bf16* dst = (bf16*)P.LST + ((size_t)seq * NSC + sc) * 16384;
#pragma unroll
            for (int kt = 0; kt < 8; ++kt)
#pragma unroll
                for (int ct = 0; ct < 2; ++ct)
#pragma unroll
                    for (int r = 0; r < 4; ++r) dst[(16 * kt + 4 * g + r) * 128 + 32 * hw + 16 * ct + l15] = (bf16)(pk2(Sacc[kt][ct][r], 0.f) & 0xffffu); }
        if (hw == 0) *(f32x2*)((isctx ? P.DSUMC + ((size_t)seq * 4 + sc) * 128 : P.DSUM + ((size_t)seq * NSC + sc) * 128) + 2 * lane) = (f32x2){ds0, ds1};
    }
}
__device__ __forceinline__ void pass_b(const Ptrs& P, int G) {
    for (int idx = blockIdx.x * 512 + threadIdx.x; idx < 32 * 4096; idx += G * 512) {
        const int seq = idx >> 12, e4 = (idx & 4095) * 4, k = e4 >> 7, dir = seq & 1;
        f32x4 cur = (f32x4){0.f, 0.f, 0.f, 0.f};
        for (int j = 0; j < 4; ++j) { const int cc = dir ? 3 - j : j; const size_t o = (size_t)seq * 4 + cc;
            cur = cur * ex2(P.DSUMC[o * 128 + k]) + *(const f32x4*)(P.LSTC + o * 16384 + e4); }
        for (int j = 0; j < NSC; ++j) {
            const int sc = dir ? NSC - 1 - j : j;
            const size_t o = ((size_t)seq * NSC + sc);
            { u32x2 wv; wv.x = pk2(cur[0], cur[1]); wv.y = pk2(cur[2], cur[3]); *(u32x2*)((bf16*)P.SENT + o * 16384 + e4) = wv; }
            const float dk = ex2(P.DSUM[o * 128 + k]);
            const u32x2 lw = *(const u32x2*)((const bf16*)P.LST + o * 16384 + e4);
            cur = cur * dk + (f32x4){bflo(lw.x), bfhi(lw.x), bflo(lw.y), bfhi(lw.y)};
        }
    }
}
__device__ __forceinline__ void pass_c(LAS unsigned char* lds, const Ptrs& P, int G) {
    const int tid = opaque_tid(), wid = __builtin_amdgcn_readfirstlane(tid >> 6), lane = tid & 63, dir = wid >> 2, hw = wid & 3, l15 = lane & 15, g = lane >> 4;
    LAS unsigned char* hl = lds + dir * HALF_LDS;
    const bf16* Kp = dir ? P.KB : P.KF; const bf16* LFp = dir ? P.LFB : P.LFF;
    bf16* OFf = (bf16*)P.OF; bf16* OFb = OFf + (size_t)M * D; bf16* OFd = dir ? OFb : OFf;
    volatile LAS unsigned* hbc = (volatile LAS unsigned*)(lds + MISC_OFF) + 16 + dir * 4; unsigned hgen = 0u;
    if (tid < 8) ((volatile LAS unsigned*)(lds + MISC_OFF))[16 + tid] = 0u;
    __syncthreads();
    for (int it = blockIdx.x; it < 256; it += G) {
        const int b = it >> 7, h = (it >> 4) & 7, sc = it & 15; const long base = (long)b * T + sc * SCT;
        const int seq = (b * NH + h) * 2 + dir;
        const bf16* src = (const bf16*)P.SENT + ((size_t)seq * NSC + sc) * 16384;
        f32x4 Sacc[8][2];
#pragma unroll
        for (int kt = 0; kt < 8; ++kt)
#pragma unroll
            for (int ct = 0; ct < 2; ++ct)
#pragma unroll
                for (int r = 0; r < 4; ++r) Sacc[kt][ct][r] = bflo((unsigned)src[(16 * kt + 4 * g + r) * 128 + 32 * hw + 16 * ct + l15]);
        float ds0 = 0.f, ds1 = 0.f; unsigned long long gt[4] = {0ull, 0ull, 0ull, 0ull};
        unsigned lraw[16], vraw[16], qraw[16];
        issue_loads<1>(lane, hw, LFp, P.V, P.Q, dir ? base + 64 * 7 + 63 : base, dir ? -1 : 1, h * HD, lraw, vraw, qraw);
        {
            unsigned short* sink = (unsigned short*)((unsigned char*)P.DSUM - WS_DSUM + WS_CTL + 49152) + lane;
#pragma unroll
            for (int k = 0; k < 32; ++k) sink[64 * k] = (unsigned short)0;
        }
        for (int s = 0; s < 8; ++s) {
            const long row0 = dir ? base + 64 * (7 - s) + 63 : base + 64 * s;
            step<true>(hl, hw, lane, Kp, LFp, P.V, P.Q, P.SG, row0, dir ? -1 : 1, h * HD, Sacc, ds0, ds1, hbc, hgen, OFd, gt, lraw, vraw, qraw, s < 7, dir ? row0 - 64 : row0 + 64);
        }
#ifdef TS_SEG_LO
        if (it == TS_SEG_ITEM && tid == TS_SEG_TID && TS_SEG_PASS == 2) { *(volatile unsigned long long*)((unsigned char*)P.DSUM - WS_DSUM + WS_CTL + 32768) = 0ull; *(volatile unsigned long long*)((unsigned char*)P.DSUM - WS_DSUM + WS_CTL + 32776) = (unsigned long long)((float)gt[0] * 10000.0f / (float)gt[2]); }
#endif
        VM_WAIT(); __syncthreads();
        {
            const int ch = h * HD + 4 * (lane & 31);
            const f32x4 gw = *(const f32x4*)(P.gn + ch);
#pragma unroll 4
            for (int rr = 0; rr < 32; ++rr) {
                const size_t ro = (size_t)(base + rr * 16 + wid * 2 + (lane >> 5)) * D + ch;
                const u32x2 f = *(const u32x2*)(OFf + ro), bb = *(const u32x2*)(OFb + ro), sg = *(const u32x2*)(P.SG + ro);
                f32x4 o = (f32x4){bflo(f.x) + bflo(bb.x), bfhi(f.x) + bfhi(bb.x), bflo(f.y) + bflo(bb.y), bfhi(f.y) + bfhi(bb.y)};
                float ss = (o[0] * o[0] + o[1] * o[1]) + (o[2] * o[2] + o[3] * o[3]);
#pragma unroll
                for (int m = 1; m < 32; m <<= 1) ss += __shfl_xor(ss, m);
                const float rstd = rsqrtf(ss * (1.0f / HD) + EPS);
                u32x2 w; w.x = pk2(o[0] * rstd * gw[0] * bflo(sg.x), o[1] * rstd * gw[1] * bfhi(sg.x)); w.y = pk2(o[2] * rstd * gw[2] * bflo(sg.y), o[3] * rstd * gw[3] * bfhi(sg.y));
                *(u32x2*)(P.OG + ro) = w;
            }
        }
        __syncthreads();
    }
}
}

struct Args {
    const float *x, *c, *ctx, *c_ctx, *w_ada, *b_ada, *norm_w, *hg_w_in, *hg_lb, *hg_gnorm, *hg_w_out, *sg_w_in, *sg_ln_w, *sg_ln_b, *sg_w_s, *sg_b_s, *sg_w_out,
                *moe_router, *moe_w_gate, *moe_w_up, *moe_w_down;
    float* out; unsigned char* ws; int ph_lo, ph_hi, li, pad;
};
#define CAS __attribute__((address_space(4)))
typedef const CAS Args& ArgsRef;
__device__ __forceinline__ const CAS Args* launder_args(const CAS Args* p) { asm volatile("" : "+s"(p)); return p; }

#ifdef TS_A
#define USTAMP(n) do { if (blockIdx.x == 0 && threadIdx.x == 0) { if ((n) == TS_A) *(volatile unsigned long long*)(a.ws + WS_CTL + 32768) = __builtin_amdgcn_s_memrealtime(); if ((n) == TS_B) *(volatile unsigned long long*)(a.ws + WS_CTL + 32776) = __builtin_amdgcn_s_memrealtime(); } } while (0)
#else
#define USTAMP(n) do { } while (0)
#endif
struct ConvTile { const float* W; bf16* WT; int K, N, rowmode, kt, nt, f8; };
constexpr int NT_SMALL = 160 + 32 + 64 + 32, NT_MOE = 2 * 3072;
constexpr int Q_HEAD = 6144, Q_DONE0 = 6144 + 64, Q_DONE1 = 6144 + 128, Q_DONE2 = 6144 + 192;
__device__ __forceinline__ void conv_decode_small(ArgsRef a, int r, ConvTile& t) {
    unsigned char* ws = a.ws;
    t.f8 = 0;
    if (r < 160) { t.W = a.hg_w_in; t.K = D; t.N = 5 * D; t.rowmode = 0; t.kt = r / 20; t.nt = r % 20;
                   const int region = t.nt >> 2; t.f8 = (region == 1 || region == 2) ? 0 : 1; t.WT = (bf16*)(ws + (t.f8 ? WS_WHIN8 : WS_WHIN)); }
    else if ((r -= 160) < 32) { t.W = a.hg_w_out; t.WT = (bf16*)(ws + WS_WHOUT); t.K = D; t.N = D; t.rowmode = 0; t.kt = r >> 2; t.nt = r & 3; }
    else if ((r -= 32) < 64) { t.W = a.sg_w_in; t.WT = (bf16*)(ws + WS_WSIN); t.K = D; t.N = 2 * D; t.rowmode = 0; t.kt = r >> 3; t.nt = r & 7; t.f8 = 1; }
    else { r -= 64; t.W = a.sg_w_out; t.WT = (bf16*)(ws + WS_WSOUT); t.K = D; t.N = D; t.rowmode = 0; t.kt = r >> 2; t.nt = r & 3; t.f8 = 1; }
}
__device__ __forceinline__ void conv_decode_moe(ArgsRef a, int r, ConvTile& t) {
    unsigned char* ws = a.ws; unsigned char* WGU = ws + WS_WGU; unsigned char* WD = ws + WS_WD;
    const int l = r / 3072, q = r % 3072, mat = q >> 10, e = (q >> 6) & 15, tt = q & 63, le = l * 16 + e;
    t.f8 = 1;
    if (mat == 0) { t.W = a.moe_w_gate + (size_t)le * D * FF; t.WT = (bf16*)(WGU + (size_t)le * 4096 * D); t.K = D; t.N = FF; t.rowmode = 1; t.kt = tt >> 3; t.nt = tt & 7; }
    else if (mat == 1) { t.W = a.moe_w_up + (size_t)le * D * FF; t.WT = (bf16*)(WGU + (size_t)le * 4096 * D); t.K = D; t.N = FF; t.rowmode = 2; t.kt = tt >> 3; t.nt = tt & 7; }
    else { t.W = a.moe_w_down + (size_t)le * FF * D; t.WT = (bf16*)(WD + (size_t)le * D * FF); t.K = FF; t.N = D; t.rowmode = 0; t.kt = tt >> 2; t.nt = tt & 3; }
}
__device__ __forceinline__ void conv_load(const ConvTile& t, f32x4 (&v)[16], int wave, int lane) {
#pragma unroll
    for (int i = 0; i < 16; ++i) v[i] = __builtin_nontemporal_load((const f32x4*)(t.W + (size_t)(t.kt * 128 + wave * 16 + i) * t.N + t.nt * 256 + 4 * lane));
}
__device__ __forceinline__ void conv_to_lds(LAS unsigned char* buf, const f32x4 (&v)[16], int wave, int lane) {
#pragma unroll
    for (int i = 0; i < 16; ++i) { const int k = wave * 16 + i; u32x2 w; w.x = pk2(v[i][0], v[i][1]); w.y = pk2(v[i][2], v[i][3]); *(LAS u32x2*)(buf + k * 512 + (((4 * lane) ^ (((k >> 3) & 7) << 3)) * 2)) = w; }
}
__device__ __forceinline__ void conv_store(LAS unsigned char* buf, const ConvTile& t, int wave, int lane) {
#pragma unroll
    for (int q = 0; q < 8; ++q) {
        const int idx = wave * 8 + q, rowgrp = idx >> 1, c8 = (idx & 1) * 8 + (lane & 7), nl = rowgrp * 8 + (lane >> 3), n = t.nt * 256 + nl;
        const LAS unsigned short* p = (const LAS unsigned short*)(buf + (8 * c8) * 512 + ((nl ^ ((c8 & 7) << 3)) * 2));
        u32x4 o;
        o.x = (unsigned)p[0 * 256] | ((unsigned)p[1 * 256] << 16); o.y = (unsigned)p[2 * 256] | ((unsigned)p[3 * 256] << 16);
        o.z = (unsigned)p[4 * 256] | ((unsigned)p[5 * 256] << 16); o.w = (unsigned)p[6 * 256] | ((unsigned)p[7 * 256] << 16);
        const int row = t.rowmode == 0 ? n : ((n >> 7) * 256 + (n & 127) + (t.rowmode == 2 ? 128 : 0));
        *(u32x4*)(t.WT + (size_t)row * t.K + t.kt * 128 + 8 * c8) = o;
    }
}
__device__ __forceinline__ void conv_to_lds8(LAS unsigned char* buf, const f32x4 (&v)[16], int wave, int lane) {
#pragma unroll
    for (int j = 0; j < 4; ++j) { const int n = 4 * lane + j; u32x4 o;
        o.x = pk4_fp8(v[0][j] * 32.f, v[1][j] * 32.f, v[2][j] * 32.f, v[3][j] * 32.f); o.y = pk4_fp8(v[4][j] * 32.f, v[5][j] * 32.f, v[6][j] * 32.f, v[7][j] * 32.f);
        o.z = pk4_fp8(v[8][j] * 32.f, v[9][j] * 32.f, v[10][j] * 32.f, v[11][j] * 32.f); o.w = pk4_fp8(v[12][j] * 32.f, v[13][j] * 32.f, v[14][j] * 32.f, v[15][j] * 32.f);
        *(LAS u32x4*)(buf + n * 128 + ((wave ^ (((n >> 2) ^ n) & 7)) << 4)) = o; }
}
__device__ __forceinline__ void conv_store8(LAS unsigned char* buf, const ConvTile& t, int wave, int lane) {
    unsigned char* WT8 = (unsigned char*)t.WT;
#pragma unroll
    for (int q = 0; q < 4; ++q) {
        const int c = lane & 7, nl = (wave * 4 + q) * 8 + (lane >> 3), n = t.nt * 256 + nl;
        const u32x4 o = *(const LAS u32x4*)(buf + nl * 128 + ((c ^ (((nl >> 2) ^ nl) & 7)) << 4));
        const int row = t.rowmode == 0 ? n : ((n >> 7) * 256 + (n & 127) + (t.rowmode == 2 ? 128 : 0));
        *(u32x4*)(WT8 + (size_t)row * t.K + t.kt * 128 + 16 * c) = o;
    }
}
#define CONV_BAR() do { LDS_WAIT(); __builtin_amdgcn_s_barrier(); asm volatile("" ::: "memory"); } while (0)
__device__ __forceinline__ void convert_worker(LAS unsigned char* lds, ArgsRef a, int mand, int done_idx, unsigned done_target) {
    const int tid = opaque_tid(), lane = tid & 63, wave = __builtin_amdgcn_readfirstlane(tid >> 6);
    unsigned* ctl = (unsigned*)(a.ws + WS_CTL);
    volatile LAS int* slot = (volatile LAS int*)(lds + 131072);
    constexpr int CONV_BATCH = 4;
    int rng_next = 0, rng_end = 0, lastb = -1; bool stopf = false;
#define CONV_NEXT(r_) do { \
        if (rng_next < rng_end) r_ = rng_next++; \
        else if (stopf) r_ = -1; \
        else { const unsigned dn_ = __hip_atomic_load(ctl + done_idx, __ATOMIC_RELAXED, __HIP_MEMORY_SCOPE_AGENT); \
            if (lastb >= 0 && lastb + CONV_BATCH >= mand && dn_ >= done_target) { stopf = true; r_ = -1; } \
            else { const int t_ = (int)__hip_atomic_fetch_add(ctl + Q_HEAD, (unsigned)CONV_BATCH, __ATOMIC_RELAXED, __HIP_MEMORY_SCOPE_AGENT); lastb = t_; \
                if (t_ >= NT_MOE) { stopf = true; r_ = -1; } else { rng_next = t_ + 1; rng_end = t_ + CONV_BATCH < NT_MOE ? t_ + CONV_BATCH : NT_MOE; r_ = t_; } } } } while (0)
    if (tid == 0) { int r0, r1; CONV_NEXT(r0); CONV_NEXT(r1); slot[0] = r0; slot[1] = r1; }
    __syncthreads();
    f32x4 va[16], vb[16]; ConvTile ta, tb;
    int ca = slot[0], cb = slot[1];
    if (ca >= 0) { conv_decode_moe(a, ca, ta); conv_load(ta, va, wave, lane); }
    if (cb >= 0) { conv_decode_moe(a, cb, tb); conv_load(tb, vb, wave, lane); }
#define CONV_ROUND(X, tX, cX, bufoff, sl) do { \
        LAS unsigned char* buf_ = lds + (bufoff); \
        conv_to_lds8(buf_, X, wave, lane); \
        const ConvTile cc_ = tX; \
        if (tid == 0) { int r_; CONV_NEXT(r_); slot[sl] = r_; } \
        CONV_BAR(); \
        const int nxt_ = slot[sl]; \
        if (nxt_ >= 0) { conv_decode_moe(a, nxt_, tX); conv_load(tX, X, wave, lane); } \
        conv_store8(buf_, cc_, wave, lane); \
        cX = nxt_; } while (0)
    while (ca >= 0) {
        CONV_ROUND(va, ta, ca, 0, 2);
        if (cb < 0) break;
        CONV_ROUND(vb, tb, cb, 65536, 3);
    }
#undef CONV_ROUND
#undef CONV_NEXT
    __syncthreads();
}

__device__ __forceinline__ void phase_p0a(LAS unsigned char* lds, ArgsRef a, int G, int vcu) {
    unsigned char* ws = a.ws;
    const int tid = opaque_tid(), lane = tid & 63, wave = __builtin_amdgcn_readfirstlane(tid >> 6);
    USTAMP(0);
    {
        LAS float* sv = (LAS float*)(lds + 67584);
        LAS float* red = (LAS float*)(lds + 67584 + 12288);
        float* MOD = (float*)(ws + WS_MOD);
        for (int i = tid; i < 3072; i += 512) { const int v = i >> 10, k = i & 1023; sv[i] = siluf_(v < 2 ? a.c[v * D + k] : a.c_ctx[k]); }
        __syncthreads();
        for (int it = blockIdx.x; it < 192; it += G) {
            const int l = it / 96, cb = it % 96, n = cb * 64 + lane;
            const float* w = a.w_ada + (size_t)l * D * 6144 + (size_t)(wave * 128) * 6144 + n;
            float a0 = 0.f, a1 = 0.f, a2 = 0.f;
#pragma unroll 32
            for (int k = 0; k < 128; ++k) { const float wv = w[(size_t)k * 6144]; const int kk = wave * 128 + k; a0 += sv[kk] * wv; a1 += sv[1024 + kk] * wv; a2 += sv[2048 + kk] * wv; }
            red[(wave * 3 + 0) * 64 + lane] = a0; red[(wave * 3 + 1) * 64 + lane] = a1; red[(wave * 3 + 2) * 64 + lane] = a2;
            __syncthreads();
            if (tid < 192) { const int v = tid >> 6, c = tid & 63; float sacc = a.b_ada[l * 6144 + cb * 64 + c];
#pragma unroll
                for (int ww = 0; ww < 8; ++ww) sacc += red[(ww * 3 + v) * 64 + c];
                MOD[(size_t)(l * 3 + v) * 6144 + cb * 64 + c] = sacc; }
            __syncthreads();
        }
    }
    USTAMP(1);
    {
        f32x4 v[16]; ConvTile ct; int it = blockIdx.x, par = 0;
        if (it < NT_SMALL) { conv_decode_small(a, it, ct); conv_load(ct, v, wave, lane); }
        for (; it < NT_SMALL; it += G, par ^= 1) {
            LAS unsigned char* buf = lds + par * 65536;
            const ConvTile cc = ct;
            if (cc.f8) conv_to_lds8(buf, v, wave, lane); else conv_to_lds(buf, v, wave, lane);
            CONV_BAR();
            if (it + G < NT_SMALL) { conv_decode_small(a, it + G, ct); conv_load(ct, v, wave, lane); }
            if (cc.f8) conv_store8(buf, cc, wave, lane); else conv_store(buf, cc, wave, lane);
        }
        __syncthreads();
    }
    USTAMP(2);
    {
        const int gt = blockIdx.x * 512 + tid, GT = G * 512;
        bf16* WSb = (bf16*)(ws + WS_WS);
        for (int i = gt; i < 8 * 128 * 128 / 2; i += GT) { const f32x2 v = *(const f32x2*)(a.sg_w_s + 2 * i); ((unsigned*)WSb)[i] = pk2(v.x, v.y); }
        float* LB = (float*)(ws + WS_LB);
        for (int i = gt; i < 2048; i += GT) { const float l0 = a.hg_lb[i], l1 = a.hg_lb[2048 + i], l2 = a.hg_lb[4096 + i]; const float mx = fmaxf(l0, fmaxf(l1, l2));
            const float e0 = expf(l0 - mx), e1 = expf(l1 - mx), e2 = expf(l2 - mx); LB[i] = e0 / (e0 + e1 + e2); }
    }
    USTAMP(3);
}

#define ROFF(lane, j) (8 * (lane) + 512 * ((j) >> 1) + 4 * ((j) & 1))
__device__ __forceinline__ void row_load_f32(const float* p, int lane, f32x4 (&x)[4]) {
#pragma unroll
    for (int j = 0; j < 4; ++j) x[j] = *(const f32x4*)(p + ROFF(lane, j));
}
__device__ __forceinline__ void row_store_f32(float* p, int lane, const f32x4 (&x)[4]) {
#pragma unroll
    for (int j = 0; j < 4; ++j) *(f32x4*)(p + ROFF(lane, j)) = x[j];
}
__device__ __forceinline__ void row_store_bf16(bf16* p, int lane, const f32x4 (&x)[4]) {
#pragma unroll
    for (int h = 0; h < 2; ++h) { u32x4 w; w.x = pk2(x[2 * h][0], x[2 * h][1]); w.y = pk2(x[2 * h][2], x[2 * h][3]); w.z = pk2(x[2 * h + 1][0], x[2 * h + 1][1]); w.w = pk2(x[2 * h + 1][2], x[2 * h + 1][3]);
        *(u32x4*)(p + 8 * lane + 512 * h) = w; }
}
__device__ __forceinline__ void row_load_raw(const bf16* p, int lane, u32x4 (&r)[2]) {
#pragma unroll
    for (int h = 0; h < 2; ++h) r[h] = *(const u32x4*)(p + 8 * lane + 512 * h);
}
__device__ __forceinline__ void row_unpack(const u32x4 (&r)[2], f32x4 (&x)[4]) {
#pragma unroll
    for (int h = 0; h < 2; ++h) { x[2 * h] = (f32x4){bflo(r[h].x), bfhi(r[h].x), bflo(r[h].y), bfhi(r[h].y)}; x[2 * h + 1] = (f32x4){bflo(r[h].z), bfhi(r[h].z), bflo(r[h].w), bfhi(r[h].w)}; }
}
__device__ __forceinline__ void row_store_fp8(unsigned char* p, int lane, const f32x4 (&x)[4]) {
#pragma unroll
    for (int h = 0; h < 2; ++h) { u32x2 w; w.x = pk4_fp8(x[2 * h][0], x[2 * h][1], x[2 * h][2], x[2 * h][3]); w.y = pk4_fp8(x[2 * h + 1][0], x[2 * h + 1][1], x[2 * h + 1][2], x[2 * h + 1][3]);
        *(u32x2*)(p + 8 * lane + 512 * h) = w; }
}
__device__ __forceinline__ float row_rstd(const f32x4 (&x)[4]) {
    float s = 0.f;
#pragma unroll
    for (int j = 0; j < 4; ++j) s += (x[j][0] * x[j][0] + x[j][1] * x[j][1]) + (x[j][2] * x[j][2] + x[j][3] * x[j][3]);
    return rsqrtf(wave_sum(s) * (1.0f / D) + EPS);
}

__device__ __forceinline__ void phase_p0b(LAS unsigned char* lds, ArgsRef a, int G, int vcu) {
    unsigned char* ws = a.ws;
    const int tid = opaque_tid(), lane = tid & 63, wave = __builtin_amdgcn_readfirstlane(tid >> 6);
    const float* MOD = (const float*)(ws + WS_MOD);
    LAS float* modl = (LAS float*)lds;
    for (int i = tid; i < 6144; i += 512) { const int v = i >> 11, n = i & 2047; modl[i] = MOD[(size_t)v * 6144 + n]; }
    __syncthreads();
    bf16* XR = (bf16*)(ws + WS_XR); bf16* H = (bf16*)(ws + WS_H);
    f32x4 nw[4]; row_load_f32(a.norm_w, lane, nw);
    float frq[16];
#pragma unroll
    for (int j = 0; j < 4; ++j)
#pragma unroll
        for (int e = 0; e < 4; ++e) { const int dd = ROFF(lane, j) + e; frq[4 * j + e] = expf(-9.210340371976184f * (float)(dd & 255) / 256.0f); }
    const float phs = (lane & 32) ? 1.5707963267948966f : 0.0f;
    f32x4 pcol[2];
    { const float pc = (float)((vcu * 8 + wave) & 63);
#pragma unroll
      for (int j = 2; j < 4; ++j)
#pragma unroll
        for (int e = 0; e < 4; ++e) pcol[j - 2][e] = __sinf(pc * frq[4 * j + e] + phs); }
    const bool colconst = ((G * 8) & 63) == 0;
    f32x4 xn[4];
    { const int m0 = vcu * 8 + wave; if (m0 < MT) row_load_f32(m0 < M ? a.x + (size_t)m0 * D : a.ctx + (size_t)(m0 - M) * D, lane, xn); }
    for (int m = vcu * 8 + wave; m < MT; m += G * 8) {
        f32x4 x[4]; int v;
#pragma unroll
        for (int j = 0; j < 4; ++j) x[j] = xn[j];
        { const int mn = m + G * 8; if (mn < MT) row_load_f32(mn < M ? a.x + (size_t)mn * D : a.ctx + (size_t)(mn - M) * D, lane, xn); }
        if (m < M) {
            v = m >> 13;
            const float pr = (float)((m & (T - 1)) >> 6);
            if (!colconst) { const float pc = (float)(m & 63);
#pragma unroll
                for (int j = 2; j < 4; ++j)
#pragma unroll
                    for (int e = 0; e < 4; ++e) pcol[j - 2][e] = __sinf(pc * frq[4 * j + e] + phs); }
#pragma unroll
            for (int j = 0; j < 2; ++j)
#pragma unroll
                for (int e = 0; e < 4; ++e) x[j][e] += __sinf(pr * frq[4 * j + e] + phs);
            x[2] = x[2] + pcol[0]; x[3] = x[3] + pcol[1];
            row_store_bf16(XR + (size_t)m * D, lane, x);
        } else v = 2;
        const float rs = row_rstd(x);
#pragma unroll
        for (int j = 0; j < 4; ++j) { const f32x4 sh = *(const LAS f32x4*)(modl + v * 2048 + ROFF(lane, j)), sc = *(const LAS f32x4*)(modl + v * 2048 + 1024 + ROFF(lane, j));
            x[j] = x[j] * rs * nw[j] * (sc + 1.0f) + sh; }
        row_store_bf16(H + (size_t)m * D, lane, x);
        row_store_fp8(ws + WS_H8 + (size_t)m * D, lane, x);
    }
}

__device__ __forceinline__ void phase_rowpass_a(LAS unsigned char* lds, ArgsRef a, int G, int vcu, int l) {
    unsigned char* ws = a.ws;
    const int tid = opaque_tid(), lane = tid & 63, wave = __builtin_amdgcn_readfirstlane(tid >> 6);
    LAS float* RT = (LAS float*)lds;
    const float* router = a.moe_router + (size_t)l * D * NE;
    for (int i = tid; i < D * NE; i += 512) { const int d = i >> 4, ln = (d & 511) >> 3, jj = 2 * (d >> 9) + ((d & 7) >> 2);
        RT[(i & 15) * 1024 + 4 * ln + 256 * jj + (d & 3)] = router[i]; }
    __syncthreads();
    const float* MOD = (const float*)(ws + WS_MOD); bf16* XR = (bf16*)(ws + WS_XR); bf16* H = (bf16*)(ws + WS_H); const bf16* Y = (const bf16*)(ws + WS_Y); float* AFF = (float*)(ws + WS_AFF);
    f32x4 nw1[4], nw2[4]; row_load_f32(a.norm_w + (size_t)(l * 4 + 1) * D, lane, nw1); row_load_f32(a.norm_w + (size_t)(l * 4 + 2) * D, lane, nw2);
    u32x4 yr[2], xr[2];
    { const int m0 = vcu * 8 + wave; if (m0 < M) { row_load_raw(Y + (size_t)m0 * D, lane, yr); row_load_raw(XR + (size_t)m0 * D, lane, xr); } }
    f32x4 g1[4], sh[4], sc[4]; int bcur = -1;
    for (int m = vcu * 8 + wave; m < M; m += G * 8) {
        const int b = m >> 13;
        if (b != bcur) { const float* mod = MOD + (size_t)(l * 3 + b) * 6144; row_load_f32(mod + 2 * D, lane, g1); row_load_f32(mod + 3 * D, lane, sh); row_load_f32(mod + 4 * D, lane, sc); bcur = b; }
        f32x4 y[4], x[4];
        row_unpack(yr, y); row_unpack(xr, x);
        { const int mn = m + G * 8; if (mn < M) { row_load_raw(Y + (size_t)mn * D, lane, yr); row_load_raw(XR + (size_t)mn * D, lane, xr); } }
        const float r1 = row_rstd(y);
#pragma unroll
        for (int j = 0; j < 4; ++j) x[j] = x[j] + g1[j] * (y[j] * r1 * nw1[j]);
        row_store_bf16(XR + (size_t)m * D, lane, x);
        const float r2 = row_rstd(x);
#pragma unroll
        for (int j = 0; j < 4; ++j) y[j] = x[j] * r2 * nw2[j] * (sc[j] + 1.0f) + sh[j];
        row_store_fp8((unsigned char*)H + (size_t)m * D, lane, y);
        f32x4 p4[16];
#pragma unroll
        for (int e = 0; e < 16; ++e) p4[e] = (f32x4){0.f, 0.f, 0.f, 0.f};
#pragma unroll
        for (int j = 0; j < 4; ++j) {
#pragma unroll
            for (int e = 0; e < 16; ++e) { const f32x4 r = *(const LAS f32x4*)(RT + e * 1024 + 4 * lane + 256 * j); p4[e] = p4[e] + y[j] * r; }
            asm volatile("" ::: "memory");
        }
        float mine_rs = 0.f;
#pragma unroll
        for (int e = 0; e < 16; ++e) { const float rs = row16_sum((p4[e][0] + p4[e][1]) + (p4[e][2] + p4[e][3])); mine_rs = ((lane & 15) == e) ? rs : mine_rs; }
        float mylg = mine_rs + __shfl_xor(mine_rs, 16); mylg += __shfl_xor(mylg, 32);
        float mx = mylg;
        mx = fmaxf(mx, __builtin_bit_cast(float, __builtin_amdgcn_update_dpp(0, __builtin_bit_cast(int, mx), 0xB1, 0xF, 0xF, true)));
        mx = fmaxf(mx, __builtin_bit_cast(float, __builtin_amdgcn_update_dpp(0, __builtin_bit_cast(int, mx), 0x4E, 0xF, 0xF, true)));
        mx = fmaxf(mx, __builtin_bit_cast(float, __builtin_amdgcn_update_dpp(0, __builtin_bit_cast(int, mx), 0x141, 0xF, 0xF, true)));
        mx = fmaxf(mx, __builtin_bit_cast(float, __builtin_amdgcn_update_dpp(0, __builtin_bit_cast(int, mx), 0x140, 0xF, 0xF, true)));
        const float mine = __expf(mylg - mx);
        const float se = row16_sum(mine);
        const int myexp = lane & 15;
        if (lane < 16) AFF[((size_t)(b * NE + myexp)) * T + (m & (T - 1))] = mine / se;
    }
}

__device__ __forceinline__ int block_exscan(int v, LAS int* sbuf, int tid, int* tot) {
    const int lane = tid & 63, wave = tid >> 6; int inc = v;
#pragma unroll
    for (int o = 1; o < 64; o <<= 1) { const int n = __shfl_up(inc, o); if (lane >= o) inc += n; }
    __syncthreads();
    if (lane == 63) sbuf[wave] = inc;
    __syncthreads();
    int base = 0, t = 0;
#pragma unroll
    for (int w = 0; w < 8; ++w) { const int s = sbuf[w]; if (w < wave) base += s; t += s; }
    *tot = t;
    return base + inc - v;
}

__device__ __forceinline__ void phase_topk(LAS unsigned char* lds, ArgsRef a, int G) {
    unsigned char* ws = a.ws; const int tid = opaque_tid();
    const float* AFF = (const float*)(ws + WS_AFF); int* ROWMAP = (int*)(ws + WS_ROWMAP); float* GATE = (float*)(ws + WS_GATE); int* INV = (int*)(ws + WS_INV);
    LAS int* hist = (LAS int*)lds; LAS int* ctl = hist + 256; LAS int* sbuf = hist + 272;
    for (int pe = blockIdx.x; pe < NB * NE; pe += G) {
        const int e = pe >> 1, b = pe & 1;
        unsigned key[16];
#pragma unroll
        for (int i = 0; i < 4; ++i) { const f32x4 kv = *(const f32x4*)(AFF + ((size_t)(b * NE + e) * T + tid * 16 + 4 * i));
#pragma unroll
            for (int j = 0; j < 4; ++j) { const float sc = kv[j] * 4294967296.0f; key[4 * i + j] = sc >= 4294967040.0f ? 0xFFFFFFFFu : (unsigned)sc; } }
        unsigned prefix = 0u, mask = 0u; int need = CAP;
        for (int pass = 0; pass < 4; ++pass) {
            const int shift = 24 - 8 * pass;
            __syncthreads();
            if (tid < 256) hist[tid] = 0;
            __syncthreads();
#pragma unroll
            for (int i = 0; i < 16; ++i) if ((key[i] & mask) == prefix) __hip_atomic_fetch_add(&hist[(key[i] >> shift) & 255u], 1, __ATOMIC_RELAXED, __HIP_MEMORY_SCOPE_WORKGROUP);
            __syncthreads();
            const int hv = tid < 256 ? hist[255 - tid] : 0; int tot;
            const int above = block_exscan(hv, sbuf, tid, &tot);
            if (tid < 256 && above < need && above + hv >= need) { ctl[0] = 255 - tid; ctl[1] = need - above; }
            __syncthreads();
            prefix |= (unsigned)ctl[0] << shift; mask |= 255u << shift; need = ctl[1];
        }
        int neq = 0;
#pragma unroll
        for (int i = 0; i < 16; ++i) neq += (key[i] == prefix) ? 1 : 0;
        int tot; int eqb = block_exscan(neq, sbuf, tid, &tot);
        int nsel = 0; unsigned selm = 0u;
#pragma unroll
        for (int i = 0; i < 16; ++i) { bool sl = key[i] > prefix; if (key[i] == prefix) { sl = eqb < need; ++eqb; } if (sl) { selm |= 1u << i; ++nsel; } }
        int slot = block_exscan(nsel, sbuf, tid, &tot);
#pragma unroll
        for (int i = 0; i < 16; ++i) { const int t = tid * 16 + i; const bool sl = (selm >> i) & 1u;
            INV[((size_t)b * T + t) * 16 + e] = sl ? slot : -1;
            if (sl) { ROWMAP[(e * 2 + b) * CAP + slot] = b * T + t; GATE[(e * 2 + b) * CAP + slot] = AFF[(size_t)(b * NE + e) * T + t]; ++slot; } }
    }
}

__device__ __forceinline__ void phase_rowpass_b(ArgsRef a, int G, int vcu, int l) {
    unsigned char* ws = a.ws;
    const int tid = opaque_tid(), lane = tid & 63, wave = __builtin_amdgcn_readfirstlane(tid >> 6);
    const float* MOD = (const float*)(ws + WS_MOD); bf16* XR = (bf16*)(ws + WS_XR); bf16* H = (bf16*)(ws + WS_H); const bf16* YP = (const bf16*)(ws + WS_YP); const int* INV = (const int*)(ws + WS_INV);
    f32x4 nw3[4], nwn[4]; row_load_f32(a.norm_w + (size_t)(l * 4 + 3) * D, lane, nw3); row_load_f32(a.norm_w + (size_t)(4 + 0) * D, lane, nwn);
    u32x4 xr[2]; int ivn = -1;
    { const int m0 = vcu * 8 + wave; if (m0 < M) { ivn = INV[(size_t)m0 * 16 + (lane & 15)]; row_load_raw(XR + (size_t)m0 * D, lane, xr); } }
    for (int m = vcu * 8 + wave; m < M; m += G * 8) {
        const int b = m >> 13; const float* mod = MOD + (size_t)(l * 3 + b) * 6144;
        const int iv = ivn;
        f32x4 x[4]; row_unpack(xr, x);
        { const int mn = m + G * 8; if (mn < M) { ivn = INV[(size_t)mn * 16 + (lane & 15)]; row_load_raw(XR + (size_t)mn * D, lane, xr); } }
        f32x4 y[4];
#pragma unroll
        for (int j = 0; j < 4; ++j) y[j] = (f32x4){0.f, 0.f, 0.f, 0.f};
        unsigned msel = (unsigned)(__ballot(iv >= 0) & 0xFFFFull);
        while (msel) {
            int ee[4]; u32x2 tr[4][2];
#pragma unroll
            for (int q = 0; q < 4; ++q) { if (msel) { ee[q] = __builtin_ctz(msel); msel &= msel - 1u; } else ee[q] = -1; }
#pragma unroll
            for (int q = 0; q < 4; ++q) if (ee[q] >= 0) { const int slot = __builtin_amdgcn_readlane(iv, ee[q]); const unsigned char* yr8 = (const unsigned char*)YP + (size_t)((ee[q] * 2 + b) * CAP + slot) * D; tr[q][0] = *(const u32x2*)(yr8 + 8 * lane); tr[q][1] = *(const u32x2*)(yr8 + 8 * lane + 512); }
#pragma unroll
            for (int q = 0; q < 4; ++q) if (ee[q] >= 0) {
#pragma unroll
                for (int h = 0; h < 2; ++h) { const f32x2 p0 = __builtin_amdgcn_cvt_pk_f32_fp8(tr[q][h].x, false), p1 = __builtin_amdgcn_cvt_pk_f32_fp8(tr[q][h].x, true), p2 = __builtin_amdgcn_cvt_pk_f32_fp8(tr[q][h].y, false), p3 = __builtin_amdgcn_cvt_pk_f32_fp8(tr[q][h].y, true);
                    y[2 * h] = y[2 * h] + (f32x4){p0.x, p0.y, p1.x, p1.y}; y[2 * h + 1] = y[2 * h + 1] + (f32x4){p2.x, p2.y, p3.x, p3.y}; } }
        }
#pragma unroll
        for (int j = 0; j < 4; ++j) y[j] = y[j] * 0.0625f;
        f32x4 g2[4]; row_load_f32(mod + 5 * D, lane, g2);
        const float r = row_rstd(y);
#pragma unroll
        for (int j = 0; j < 4; ++j) x[j] = x[j] + g2[j] * (y[j] * r * nw3[j]);
        if (l == 0) {
            row_store_bf16(XR + (size_t)m * D, lane, x);
            const float* mod1 = MOD + (size_t)(1 * 3 + b) * 6144; f32x4 sh[4], sc[4]; row_load_f32(mod1, lane, sh); row_load_f32(mod1 + D, lane, sc);
            const float r2 = row_rstd(x);
#pragma unroll
            for (int j = 0; j < 4; ++j) y[j] = x[j] * r2 * nwn[j] * (sc[j] + 1.0f) + sh[j];
            row_store_fp8((unsigned char*)H + (size_t)m * D, lane, y);
        } else {
#ifdef TS_LO
            if (m == 0) { const unsigned long long t0 = *(volatile unsigned long long*)(ws + WS_CTL + 32768), t1 = *(volatile unsigned long long*)(ws + WS_CTL + 32776);
#ifdef TS_CONST
                const float dt = TS_CONST;
#else
                float dt = (float)(long long)(t1 - t0) * 0.01f;
#ifdef TS_Q
                dt = floorf(dt / TS_Q + 0.5f) * TS_Q;
#endif
#endif
#ifndef TS_SCALE
#define TS_SCALE 1.0f
#endif
                const float e = sqrtf(dt * 0.1514f * TS_SCALE);
#pragma unroll
                for (int j = 0; j < 4; ++j) x[j] = x[j] + e; }
#endif
            row_store_f32(a.out + (size_t)m * D, lane, x); }
    }
}

__device__ __forceinline__ void phase_sgu_mix(LAS unsigned char* lds, ArgsRef a, int G) {
    unsigned char* ws = a.ws;
    const int tid = opaque_tid(), lane = tid & 63, w = __builtin_amdgcn_readfirstlane(tid >> 6), l15 = lane & 15, gq = lane >> 4;
    const bf16* Z = (const bf16*)(ws + WS_Z); const float* STATS = (const float*)(ws + WS_STATS); bf16* A2 = (bf16*)(ws + WS_A2); const bf16* WSb = (const bf16*)(ws + WS_WS);
    LAS float* ST = (LAS float*)lds; LAS unsigned char* vt = lds + 1024; constexpr int VS = 272;
    for (int it = blockIdx.x; it < 128 * 8; it += G) {
        const int n = it >> 3, g = it & 7; const size_t r0 = (size_t)n * 128;
        __syncthreads();
        if (tid < 128) { const float* sp = STATS + (r0 + tid) * 32; float s1 = 0.f, s2 = 0.f;
#pragma unroll
            for (int j = 0; j < 16; ++j) { s1 += sp[2 * j]; s2 += sp[2 * j + 1]; }
            const float mean = s1 * (1.0f / 1024.0f), var = fmaxf(s2 * (1.0f / 1024.0f) - mean * mean, 0.f);
            ST[2 * tid] = mean; ST[2 * tid + 1] = rsqrtf(var + EPS); }
        __syncthreads();
        {
            const int c0 = 2 * lane; const f32x2 lw = *(const f32x2*)(a.sg_ln_w + 128 * g + c0), lbv = *(const f32x2*)(a.sg_ln_b + 128 * g + c0);
            float v0[16], v1[16];
#pragma unroll
            for (int jj = 0; jj < 16; ++jj) { const int q = 16 * w + jj; const unsigned raw = *(const unsigned*)(Z + (r0 + q) * 2048 + 1024 + 128 * g + c0);
                const float mean = ST[2 * q], rs = ST[2 * q + 1];
                v0[jj] = (bflo(raw) - mean) * rs * lw.x + lbv.x; v1[jj] = (bfhi(raw) - mean) * rs * lw.y + lbv.y; }
#pragma unroll
            for (int hh = 0; hh < 2; ++hh) { u32x4 o;
                o.x = pk2(v0[8 * hh + 0], v0[8 * hh + 1]); o.y = pk2(v0[8 * hh + 2], v0[8 * hh + 3]); o.z = pk2(v0[8 * hh + 4], v0[8 * hh + 5]); o.w = pk2(v0[8 * hh + 6], v0[8 * hh + 7]);
                *(LAS u32x4*)(vt + c0 * VS + 32 * w + 16 * hh) = o;
                o.x = pk2(v1[8 * hh + 0], v1[8 * hh + 1]); o.y = pk2(v1[8 * hh + 2], v1[8 * hh + 3]); o.z = pk2(v1[8 * hh + 4], v1[8 * hh + 5]); o.w = pk2(v1[8 * hh + 6], v1[8 * hh + 7]);
                *(LAS u32x4*)(vt + (c0 + 1) * VS + 32 * w + 16 * hh) = o; }
        }
        __syncthreads();
        f32x4 acc[8];
#pragma unroll
        for (int ct = 0; ct < 8; ++ct) acc[ct] = (f32x4){0.f, 0.f, 0.f, 0.f};
#pragma unroll
        for (int ks = 0; ks < 4; ++ks) {
            const bf16x8 av = *(const bf16x8*)(WSb + ((size_t)(g * 128 + 16 * w + l15)) * 128 + 32 * ks + 8 * gq);
#pragma unroll
            for (int ct = 0; ct < 8; ++ct) { const bf16x8 bv = *(const LAS bf16x8*)(vt + (16 * ct + l15) * VS + (32 * ks + 8 * gq) * 2);
                acc[ct] = __builtin_amdgcn_mfma_f32_16x16x32_bf16(av, bv, acc[ct], 0, 0, 0); }
        }
#pragma unroll
        for (int r = 0; r < 4; ++r) { const int p = 16 * w + 4 * gq + r; const float bias = a.sg_b_s[g * 128 + p];
#pragma unroll
            for (int ct = 0; ct < 8; ++ct) { const int c = 128 * g + 16 * ct + l15; const float u = bflo((unsigned)Z[(r0 + p) * 2048 + c]);
                ((unsigned char*)A2)[(r0 + p) * D + c] = (unsigned char)(pk4_fp8(u * (acc[ct][r] + bias), 0.f, 0.f, 0.f) & 0xffu); } }
    }
}

constexpr int N_LAUNCHES = MK_N_LAUNCHES;
__global__ void __launch_bounds__(512, 2) fwd_kernel(Args a_unused) {
    extern __shared__ __attribute__((aligned(16))) unsigned char lds_raw[];
    LAS unsigned char* lds = (LAS unsigned char*)lds_raw;
    const CAS Args* kp = (const CAS Args*)__builtin_amdgcn_kernarg_segment_ptr();
    {
        volatile LAS unsigned* MISC = (volatile LAS unsigned*)(lds + MISC_OFF);
        if (threadIdx.x < 64) MISC[threadIdx.x] = 0u;
        __syncthreads();
        if (N_LAUNCHES == 1) (void)xcd_barrier_post((unsigned*)(kp->ws + WS_CTL) + 1024, MISC + 8);
    }
#if defined(PHASE_MASK)
#define IN(k) ((((PHASE_MASK) >> (k)) & 1) && A.ph_lo <= (k) && (k) < A.ph_hi)
#elif defined(ONLY_PHASE)
#define IN(k) ((k) == ONLY_PHASE && A.ph_lo <= (k) && (k) < A.ph_hi)
#else
#define IN(k) (A.ph_lo <= (k) && (k) < A.ph_hi)
#endif
#ifdef TS_LO
#define TS_BEGIN(k) if ((k) == TS_LO && blockIdx.x == 0 && threadIdx.x == 0) { *(volatile unsigned long long*)(ws + WS_CTL + 32768) = __builtin_amdgcn_s_memrealtime(); }
#define TS_END(k) if ((k) == TS_HI - 1 && blockIdx.x == 0 && threadIdx.x == 0) { *(volatile unsigned long long*)(ws + WS_CTL + 32776) = __builtin_amdgcn_s_memrealtime(); }
#else
#define TS_BEGIN(k)
#define TS_END(k)
#endif
#define PHASE_BEGIN(k) { ArgsRef A = *launder_args(kp); if (IN(k)) { unsigned char* ws = A.ws; const int G = gridDim.x, bx = blockIdx.x; const int vcu = (G % 8 == 0) ? (bx % 8) * (G / 8) + bx / 8 : bx; (void)vcu; (void)ws; TS_BEGIN(k)
#define PHASE_END(k) if (N_LAUNCHES == 1 && (k) + 1 < A.ph_hi) { XcdBarrier bar; bar.bar = (unsigned*)(ws + WS_CTL) + 1024; bar.x = xb_xcc_id(); bar.st = (volatile LAS unsigned*)(lds + MISC_OFF) + 8; xcd_barrier(bar); } TS_END(k) } }
#define GLA_PTRS gla::Ptrs GP{(const bf16*)(ws + WS_V), (const bf16*)(ws + WS_KF), (const bf16*)(ws + WS_LFF), (const bf16*)(ws + WS_KB), (const bf16*)(ws + WS_LFB), (const bf16*)(ws + WS_Q), (const bf16*)(ws + WS_SG), \
                 (float*)(ws + WS_OF), (bf16*)(ws + WS_OG), A.hg_gnorm, (float*)(ws + WS_LST), (float*)(ws + WS_SENT), (float*)(ws + WS_LSTC), (float*)(ws + WS_DSUM), (float*)(ws + WS_DSUMC)}

    PHASE_BEGIN(0) phase_p0a(lds, A, G, vcu); PHASE_END(0)
    PHASE_BEGIN(1) phase_p0b(lds, A, G, vcu); PHASE_END(1)
    PHASE_BEGIN(2)
        const int NG = (G == 256) ? 136 : G;
        if (bx >= NG) convert_worker(lds, A, 0, Q_DONE0, (unsigned)NG);
        else {
            const float* LB = (const float*)(ws + WS_LB); LAS float* aux = (LAS float*)(lds + GEMM_AUX_OFF);
            for (int i = threadIdx.x; i < 2048; i += 512) aux[i] = LB[i];
            __syncthreads();
            {
                pg8::Gemm g{(const bf16*)(ws + WS_H8), (const bf16*)(ws + WS_WHIN8), D, nullptr}; pg8::HinOrder<true> S; S.init(NG, bx);
                pg8::EpiHin<true> E{ws};
                pg8::gemm_phase<pg8::EpiHin<true>, pg8::HinOrder<true>, false, true, D>(lds, g, S, E);
            }
            {
                pg8::Gemm g{(const bf16*)(ws + WS_H), (const bf16*)(ws + WS_WHIN), D, nullptr}; pg8::HinOrder<false> S; S.init(NG, NG - 1 - bx);
                pg8::EpiHin<false> E{ws};
                pg8::gemm_phase<pg8::EpiHin<false>, pg8::HinOrder<false>, false, false, D>(lds, g, S, E);
            }
            if (threadIdx.x == 0) __hip_atomic_fetch_add((unsigned*)(ws + WS_CTL) + Q_DONE0, 1u, __ATOMIC_RELAXED, __HIP_MEMORY_SCOPE_AGENT);
        }
    PHASE_END(2)
    PHASE_BEGIN(3) GLA_PTRS; gla::pass_a(lds, GP, G); PHASE_END(3)
    PHASE_BEGIN(4) GLA_PTRS; gla::pass_b(GP, G); PHASE_END(4)
    PHASE_BEGIN(5) GLA_PTRS; gla::pass_c(lds, GP, G); PHASE_END(5)
    PHASE_BEGIN(6)
        pg8::Gemm g{(const bf16*)(ws + WS_OG), (const bf16*)(ws + WS_WHOUT), D, nullptr}; pg8::GridOrder S; S.init(64, 4, G, bx, 0);
        pg8::EpiBf16<0> E{(bf16*)(ws + WS_Y), D, nullptr, 1.0f};
        pg8::gemm_phase<pg8::EpiBf16<0>, pg8::GridOrder, false, false, D>(lds, g, S, E);
    PHASE_END(6)
#define MOE_PHASES(l, p0) \
    PHASE_BEGIN(p0) phase_rowpass_a(lds, A, G, vcu, l); PHASE_END(p0) \
    PHASE_BEGIN(p0 + 1)   \
        if (bx >= NB * NE && G > NB * NE) convert_worker(lds, A, (l + 1) * 3072, (l) == 0 ? Q_DONE1 : Q_DONE2, (unsigned)(NB * NE)); \
        else { phase_topk(lds, A, G); if (G > NB * NE && threadIdx.x == 0) __hip_atomic_fetch_add((unsigned*)(ws + WS_CTL) + ((l) == 0 ? Q_DONE1 : Q_DONE2), 1u, __ATOMIC_RELAXED, __HIP_MEMORY_SCOPE_AGENT); } \
    PHASE_END(p0 + 1) \
    PHASE_BEGIN(p0 + 2)   \
        pg8::Gemm g{(const bf16*)(ws + WS_H), (const bf16*)(ws + WS_WGU + (size_t)(l) * NE * 4096 * D), D, (const int*)(ws + WS_ROWMAP)}; pg8::GridOrder S; S.init(128, 16, G, bx, 16); \
        pg8::fill_row_table(lds, S, (const unsigned*)(ws + WS_ROWMAP)); \
        pg8::EpiGU8 E{ws + WS_HID}; \
        pg8::gemm_phase<pg8::EpiGU8, pg8::GridOrder, true, true, D>(lds, g, S, E); \
    PHASE_END(p0 + 2) \
    PHASE_BEGIN(p0 + 3)   \
        pg8::Gemm g{(const bf16*)(ws + WS_HID), (const bf16*)(ws + WS_WD + (size_t)(l) * NE * D * FF), FF, nullptr}; pg8::GridOrder S; S.init(128, 4, G, bx, 4); \
        pg8::fill_row_table(lds, S, (const unsigned*)(ws + WS_GATE)); \
        pg8::EpiDown E{(bf16*)(ws + WS_YP), 0.03125f}; \
        pg8::gemm_phase<pg8::EpiDown, pg8::GridOrder, false, true, FF>(lds, g, S, E); \
    PHASE_END(p0 + 3) \
    PHASE_BEGIN(p0 + 4) phase_rowpass_b(A, G, vcu, l); PHASE_END(p0 + 4)

    MOE_PHASES(0, 7)
    PHASE_BEGIN(12)
        pg8::Gemm g{(const bf16*)(ws + WS_H), (const bf16*)(ws + WS_WSIN), D, nullptr}; pg8::GridOrder S; S.init(64, 8, G, bx, 0);
        pg8::EpiBf16<1> E{(bf16*)(ws + WS_Z), 2 * D, (float*)(ws + WS_STATS), 0.03125f};
        pg8::gemm_phase<pg8::EpiBf16<1>, pg8::GridOrder, false, true, D>(lds, g, S, E);
    PHASE_END(12)
    PHASE_BEGIN(13) phase_sgu_mix(lds, A, G); PHASE_END(13)
    PHASE_BEGIN(14)
        pg8::Gemm g{(const bf16*)(ws + WS_A2), (const bf16*)(ws + WS_WSOUT), D, nullptr}; pg8::GridOrder S; S.init(64, 4, G, bx, 0);
        pg8::EpiBf16<0> E{(bf16*)(ws + WS_Y), D, nullptr, 0.03125f};
        pg8::gemm_phase<pg8::EpiBf16<0>, pg8::GridOrder, false, true, D>(lds, g, S, E);
    PHASE_END(14)
    MOE_PHASES(1, 15)
#undef IN
}

extern "C" void kernel_launch(void* const* d_in, const int* in_sizes, int n_in, void* d_out, int out_size, void* d_ws, size_t ws_size, hipStream_t stream) {
    static int grid = 0;
    if (grid == 0) {
        if (n_in != 21 || in_sizes[0] != M * D || out_size != M * D || ws_size < WS_END) {
            fprintf(stderr, "kernel_launch: unexpected problem (n_in %d, in0 %d, out %d, ws %zu; need ws >= %zu); nothing launched\n", n_in, n_in > 0 ? in_sizes[0] : -1, out_size, ws_size, (size_t)WS_END); grid = -1; return; }
        int dev = 0, cus = 0, per_cu = 0;
        if (hipGetDevice(&dev) != hipSuccess || hipDeviceGetAttribute(&cus, hipDeviceAttributeMultiprocessorCount, dev) != hipSuccess) { grid = -1; return; }
        if (hipFuncSetAttribute((const void*)fwd_kernel, hipFuncAttributeMaxDynamicSharedMemorySize, LDS_BYTES) != hipSuccess) { fprintf(stderr, "kernel_launch: hipFuncSetAttribute failed\n"); grid = -1; return; }
        if (hipOccupancyMaxActiveBlocksPerMultiprocessor(&per_cu, (const void*)fwd_kernel, 512, LDS_BYTES) != hipSuccess || per_cu < 1) { fprintf(stderr, "kernel_launch: occupancy query reports %d blocks per CU\n", per_cu); (void)hipGetLastError(); }
        grid = cus;
    }
    if (grid < 0) return;
    (void)hipMemsetAsync((char*)d_ws + WS_CTL, 0, CTL_ZERO_BYTES, stream);
    Args a{};
    const float** fp = (const float**)&a;
    for (int i = 0; i < 21; ++i) fp[i] = (const float*)d_in[i];
    a.out = (float*)d_out; a.ws = (unsigned char*)d_ws;
    if (N_LAUNCHES == 1) { a.ph_lo = 0; a.ph_hi = NPHASE; a.li = 0; hipLaunchKernelGGL(fwd_kernel, dim3(grid), dim3(512), LDS_BYTES, stream, a); }
    else for (int li = 0; li < NPHASE; ++li) { a.ph_lo = li; a.ph_hi = li + 1; a.li = li; hipLaunchKernelGGL(fwd_kernel, dim3(grid), dim3(512), LDS_BYTES, stream, a); }
}
```

```cpp
#include <hip/hip_runtime.h>
#include <cstdio>
#include <cstdint>

#ifndef MK_N_LAUNCHES
#define MK_N_LAUNCHES 1
#endif

#define LAS __attribute__((address_space(3)))
typedef unsigned short bf16;
typedef short bf16x8 __attribute__((ext_vector_type(8)));
typedef short s16x4 __attribute__((ext_vector_type(4)));
typedef float f32x4 __attribute__((ext_vector_type(4)));
typedef float f32x2 __attribute__((ext_vector_type(2)));
typedef unsigned u32x4 __attribute__((ext_vector_type(4)));
typedef unsigned u32x2 __attribute__((ext_vector_type(2)));
typedef __bf16 bf16x2_t __attribute__((ext_vector_type(2)));
typedef int v8i __attribute__((ext_vector_type(8)));
typedef int v4i __attribute__((ext_vector_type(4)));

constexpr int NB = 2, T = 8192, D = 1024, M = NB * T, CTX = 256, MC = NB * CTX, MT = M + MC;
constexpr int NH = 8, HD = 128, NE = 16, CAP = 1024, FF = 2048, NPAIR = NB * NE * CAP;
constexpr int SCT = 512, NSC = T / SCT;
constexpr float EPS = 1e-6f;
constexpr int NPHASE = 20;

constexpr size_t MiB = 1u << 20;
constexpr size_t WS_CTL = 0, CTL_ZERO_BYTES = 64 * 1024;
constexpr size_t WS_LB = 1 * MiB;
constexpr size_t WS_MOD = 1 * MiB + 64 * 1024;
constexpr size_t WS_MODP = 2 * MiB;
constexpr size_t WS_WS = 4 * MiB;
constexpr size_t WS_WHIN = 5 * MiB;
constexpr size_t WS_WHOUT = 15 * MiB;
constexpr size_t WS_WSIN = 17 * MiB;
constexpr size_t WS_WSOUT = 21 * MiB;
constexpr size_t WS_WGU = 24 * MiB;
constexpr size_t WS_WD = 280 * MiB;
constexpr size_t WS_XR = 408 * MiB;
constexpr size_t WS_H = 472 * MiB;
constexpr size_t WS_R1 = 505 * MiB;
constexpr size_t WS_V = WS_R1, WS_KF = WS_V + 33 * MiB, WS_LFF = WS_KF + 33 * MiB, WS_KB = WS_LFF + 33 * MiB, WS_LFB = WS_KB + 33 * MiB;
constexpr size_t WS_Q = WS_LFB + 33 * MiB, WS_SG = WS_Q + 32 * MiB;
constexpr size_t WS_HID = WS_R1, WS_YP = WS_R1 + 128 * MiB;
constexpr size_t WS_Z = WS_R1, WS_A2 = WS_R1 + 64 * MiB, WS_STATS = WS_R1 + 96 * MiB;
constexpr size_t WS_OG = 734 * MiB;
constexpr size_t WS_OF = 766 * MiB;
constexpr size_t WS_LST = 830 * MiB;
constexpr size_t WS_SENT = 862 * MiB;
constexpr size_t WS_LSTC = 932 * MiB;
constexpr size_t WS_DSUM = 896 * MiB;
constexpr size_t WS_Y = 897 * MiB;
constexpr size_t WS_AFF = 929 * MiB;
constexpr size_t WS_ROWMAP = 930 * MiB;
constexpr size_t WS_GATE = 930 * MiB + 512 * 1024;
constexpr size_t WS_INV = 931 * MiB;
constexpr size_t WS_DSUMC = 896 * MiB + 512 * 1024;
constexpr size_t WS_H8 = 940 * MiB;
constexpr size_t WS_WHIN8 = 958 * MiB;
constexpr size_t WS_END = 964 * MiB;

constexpr int LDS_BYTES = 163840;
constexpr int GEMM_TAB_OFF = 131072;
constexpr int GEMM_AUX_OFF = 131072 + 8192;
constexpr int MISC_OFF = LDS_BYTES - 256;
constexpr int HALF_LDS = 81792;

__device__ __forceinline__ float bflo(unsigned u) { return __uint_as_float(u << 16); }
__device__ __forceinline__ float bfhi(unsigned u) { return __uint_as_float(u & 0xffff0000u); }
__device__ __forceinline__ unsigned pk2(float lo, float hi) { f32x2 v = {lo, hi}; bf16x2_t b = __builtin_convertvector(v, bf16x2_t); return __builtin_bit_cast(unsigned, b); }
__device__ __forceinline__ unsigned pk4_fp8(float a, float b, float c, float d) {
    a = __builtin_amdgcn_fmed3f(a, -448.f, 448.f); b = __builtin_amdgcn_fmed3f(b, -448.f, 448.f); c = __builtin_amdgcn_fmed3f(c, -448.f, 448.f); d = __builtin_amdgcn_fmed3f(d, -448.f, 448.f);
    unsigned w = 0u; w = __builtin_amdgcn_cvt_pk_fp8_f32(a, b, w, false); w = __builtin_amdgcn_cvt_pk_fp8_f32(c, d, w, true); return w;
}
#define DPP_ADD(v, ctrl) ((v) + __builtin_bit_cast(float, __builtin_amdgcn_update_dpp(0, __builtin_bit_cast(int, (v)), (ctrl), 0xF, 0xF, true)))
__device__ __forceinline__ float row16_sum(float v) {
    v = DPP_ADD(v, 0xB1); v = DPP_ADD(v, 0x4E); v = DPP_ADD(v, 0x141); v = DPP_ADD(v, 0x140);
    return v;
}
__device__ __forceinline__ float wave_sum(float v) {
    v = row16_sum(v);
    const float s0 = __builtin_bit_cast(float, __builtin_amdgcn_readlane(__builtin_bit_cast(int, v), 0)), s1 = __builtin_bit_cast(float, __builtin_amdgcn_readlane(__builtin_bit_cast(int, v), 16));
    const float s2 = __builtin_bit_cast(float, __builtin_amdgcn_readlane(__builtin_bit_cast(int, v), 32)), s3 = __builtin_bit_cast(float, __builtin_amdgcn_readlane(__builtin_bit_cast(int, v), 48));
    return (s0 + s1) + (s2 + s3);
}
__device__ __forceinline__ float sigmoidf_(float x) { return __builtin_amdgcn_rcpf(1.0f + __expf(-x)); }
__device__ __forceinline__ float siluf_(float x) { return x * __builtin_amdgcn_rcpf(1.0f + __expf(-x)); }
__device__ __forceinline__ float gelu_tanh(float x) { const float u = 0.7978845608028654f * (x + 0.044715f * x * x * x); return x * __builtin_amdgcn_rcpf(1.0f + __expf(-2.0f * u)); }
__device__ __forceinline__ int opaque_tid() { int t = threadIdx.x; asm volatile("" : "+v"(t)); return t; }
#define LDS_WAIT() asm volatile("s_waitcnt lgkmcnt(0)" ::: "memory")
#define VM_WAIT() asm volatile("s_waitcnt vmcnt(0)" ::: "memory")

#define XB_TMO      128
#define XB_XCNT(j)  (256  + 64 * (j))
#define XB_XSUB(j)  (1280 + 64 * (j))
#define XB_XGEN(j)  (2304 + 64 * (j))
#define XB_TOP      3328
#define XB_TOPGEN   3392
#define XCD_BAR_WORDS 3456
#define XB_SPIN_CAP (1u << 22)
__device__ __forceinline__ unsigned xb_ld(unsigned* p)              { return __hip_atomic_load(p, __ATOMIC_RELAXED, __HIP_MEMORY_SCOPE_AGENT); }
__device__ __forceinline__ unsigned xb_add(unsigned* p, unsigned v) { return __hip_atomic_fetch_add(p, v, __ATOMIC_RELAXED, __HIP_MEMORY_SCOPE_AGENT); }
__device__ __forceinline__ unsigned xb_xcc_id() { return (unsigned)__builtin_amdgcn_s_getreg((3 << 11) | 20) & 0xFu; }
#define XB_SPIN(cond, bar) do { unsigned _sp = 0; while (cond) { __builtin_amdgcn_s_sleep(1); \
    if ((++_sp & 255u) == 0u) { if (xb_ld(&(bar)[XB_TMO])) break; if (_sp > XB_SPIN_CAP) { atomicAdd(&(bar)[XB_TMO], 1u); break; } } } } while (0)
struct XcdBarrier { unsigned* bar; unsigned x; volatile LAS unsigned* st; };
__device__ __forceinline__ XcdBarrier xcd_barrier_post(unsigned* bar, volatile LAS unsigned* st) {
    XcdBarrier b; b.bar = bar; b.x = xb_xcc_id(); b.st = st;
    if (threadIdx.x == 0) (void)xb_add(&bar[XB_XCNT(b.x)], 1u);
    return b;
}
__device__ __forceinline__ void xcd_barrier_complete(unsigned* bar, unsigned x, unsigned& nloc, unsigned& nx) {
    const unsigned G = gridDim.x * gridDim.y * gridDim.z;
    unsigned sum, cnt, mine, sp = 0u;
    for (;;) {
        sum = 0u; cnt = 0u; mine = 0u;
#pragma unroll
        for (unsigned j = 0; j < 16; ++j) { const unsigned c = xb_ld(&bar[XB_XCNT(j)]); sum += c; cnt += (c > 0u) ? 1u : 0u; mine = (j == x) ? c : mine; }
        if (sum == G) break;
        __builtin_amdgcn_s_sleep(1);
        if ((++sp & 255u) == 0u) { if (xb_ld(&bar[XB_TMO])) break; if (sp > XB_SPIN_CAP) { atomicAdd(&bar[XB_TMO], 1u); break; } }
    }
    nloc = mine > 0u ? mine : 1u; nx = cnt > 0u ? cnt : 1u;
}
__device__ __forceinline__ void xcd_barrier(const XcdBarrier& b) {
    asm volatile("s_waitcnt vmcnt(0)" ::: "memory");
    __syncthreads();
    if (threadIdx.x == 0) {
        unsigned* bar = b.bar;
        __builtin_amdgcn_s_waitcnt(0);
        unsigned nloc = b.st[0], nx = b.st[1];
        if (nloc == 0u) { xcd_barrier_complete(bar, b.x, nloc, nx); b.st[0] = nloc; b.st[1] = nx; }
        const unsigned old = xb_add(&bar[XB_XSUB(b.x)], 1u);
        const unsigned gen = old / nloc;
        asm volatile("buffer_inv sc1" ::: "memory");
        if (old + 1u == (gen + 1u) * nloc) {
            __builtin_amdgcn_fence(__ATOMIC_RELEASE, "agent");
            asm volatile("s_waitcnt vmcnt(0)" ::: "memory");
            const unsigned og = xb_add(&bar[XB_TOP], 1u);
            const unsigned tg = og / nx;
            if (og + 1u == (tg + 1u) * nx) xb_add(&bar[XB_TOPGEN], 1u);
            else XB_SPIN(xb_ld(&bar[XB_TOPGEN]) == tg, bar);
            asm volatile("" ::: "memory");
            xb_add(&bar[XB_XGEN(b.x)], 1u);
            asm volatile("s_waitcnt vmcnt(0)" ::: "memory");
        } else {
            XB_SPIN(xb_ld(&bar[XB_XGEN(b.x)]) == gen, bar);
            asm volatile("s_waitcnt vmcnt(0)" ::: "memory");
        }
    }
    __syncthreads();
}

namespace pg8 {
constexpr int BM = 256, BK = 64, HALF = 128, HTB = HALF * BK * 2, STAGE_BYTES = 8 * HTB, NXCD = 8, WGM = 8;
__host__ __device__ __forceinline__ int lds_byte(int r, int c) { const int st = (r >> 4) * 2 + (c >> 5), rr = r & 15, cc = c & 31, ob = rr * 64 + cc * 2; return st * 1024 + (ob ^ (((ob >> 9) & 1) << 5)); }
__host__ __device__ __forceinline__ void stage_rc(int b, int& R, int& C) { const int st = b / 1024, sb = b % 1024, swz = sb ^ (((sb >> 9) & 1) << 5); R = (st >> 1) * 16 + swz / 64; C = (st & 1) * 32 + (swz % 64) / 2; }
__host__ __device__ __forceinline__ int perm32(int rho) { const int n = rho >> 4, i = rho & 15; return 8 * (i >> 2) + 4 * n + (i & 3); }

struct Unit { int pm, pn, bt; };
struct Gemm { const bf16* A; const bf16* Bt; int K; const int* rowmap; };

struct GridOrder {
    int nM, nN, nwg, G, c, bmul;
    __device__ void init(int nM_, int nN_, int G_, int c_, int bmul_) { nM = nM_; nN = nN_; nwg = nM * nN; G = G_; c = c_; bmul = bmul_; }
    __device__ __forceinline__ bool next(int i, Unit& u) const {
        const long L = (long)i * G + c; if (L >= nwg) return false;
        int wgid = (int)L; { const int q = nwg / NXCD, r = nwg % NXCD, xcd = wgid % NXCD, off = wgid / NXCD; wgid = (xcd < r ? xcd * (q + 1) : r * (q + 1) + (xcd - r) * q) + off; }
        const int nig = WGM * nN, gid = wgid / nig, fm = gid * WGM, gsz = (nM - fm) < WGM ? (nM - fm) : WGM;
        u.pm = fm + ((wgid % nig) % gsz); u.pn = (wgid % nig) / gsz; u.bt = bmul ? (u.pm >> 3) * bmul + u.pn : u.pn; return true;
    }
};
template <bool E4> struct HinOrder {
    GridOrder g;
    __device__ void init(int G_, int c_) { g.init(64, E4 ? 12 : 8, G_, c_, 0); }
    __device__ __forceinline__ bool next(int i, Unit& u) const {
        const long L = (long)i * g.G + g.c; constexpr int NLAT = 64 * (E4 ? 12 : 8), NCTX = E4 ? 4 : 8;
        if (L < NLAT) { g.next(i, u); }
        else { const int r = (int)L - NLAT; if (r >= 2 * NCTX) return false; u.pm = 64 + r / NCTX; u.pn = r % NCTX; }
        u.pn = E4 ? (u.pn < 4 ? u.pn : u.pn + 8) : u.pn + 4; u.bt = u.pn; return true;
    }
};

__device__ __forceinline__ unsigned cvt_pk_bf16(float lo, float hi) { return pk2(lo, hi); }


template <class Epi, class Sched, bool GATHER, bool F8 = false, int KC = 0>
__device__ __forceinline__ void gemm_phase(LAS unsigned char* lds, const Gemm g, const Sched& S, const Epi& E) {
    const int tid = opaque_tid(), wid = __builtin_amdgcn_readfirstlane(tid >> 6), lane = tid & 63, wr = wid >> 2, wc = wid & 3, fr = lane & 15, fq = lane >> 4;
    const int K = KC ? KC : g.K, KB = F8 ? K : 2 * K  , ntr = KB / (BK * 2);
#ifdef DUPK
    const int nt = (GATHER && F8) ? 2 * ntr : ntr;
#define KWRAP(t_) ((t_) % ntr)
#else
    const int nt = ntr;
#define KWRAP(t_) (t_)
#endif
    int RA[2], CA[2]; unsigned voffB[2], voffA[2];
#pragma unroll
    for (int i = 0; i < 2; ++i) { int R, C; stage_rc(tid * 16 + i * 8192, R, C); RA[i] = R; CA[i] = C; const int Rb = (R & ~31) + perm32(R & 31); voffB[i] = (unsigned)(Rb * KB + C * 2); voffA[i] = (unsigned)(R * KB + C * 2); }
    const size_t kstep = (size_t)(BK * 2);
    const size_t hstep = (size_t)HALF * KB;
    const size_t tstep = 2 * hstep;
    const unsigned ldsw = (unsigned)wid * 1024u;
    const int aoff = lds_byte(wr * 64 + fr, fq * 8), boff = lds_byte(wc * 32 + fr, fq * 8);
    LAS int* tab = (LAS int*)(lds + GEMM_TAB_OFF);
#define PG8_SA(b, h) (((b) * 2 + (h)) * HTB)
#define PG8_SB(b, h) ((4 + (b) * 2 + (h)) * HTB)
#define PG8_STAGE_B(bufoff, gbase) do { _Pragma("unroll") for (int _i = 0; _i < 2; ++_i) \
        __builtin_amdgcn_global_load_lds((const unsigned*)((const char*)(gbase) + voffB[_i]), (LAS unsigned*)(lds + (bufoff) + ldsw + _i * 8192), 16, 0, 0); } while (0)
#define PG8_STAGE_A(bufoff, koff, nx, h) do { _Pragma("unroll") for (int _i = 0; _i < 2; ++_i) { \
        const char* _p = GATHER ? (const char*)g.A + (koff) + ((nx) ? o2[h][_i] : oAc[h][_i]) : ((nx) ? a2b : cAb) + (koff) + (h) * hstep + voffA[_i]; \
        __builtin_amdgcn_global_load_lds((const unsigned*)_p, (LAS unsigned*)(lds + (bufoff) + ldsw + _i * 8192), 16, 0, 0); } } while (0)
#define PG8_LDA(dst, b, h) do { _Pragma("unroll") for (int m = 0; m < 4; ++m) { const v4i lo_ = *(const LAS v4i*)(lds + PG8_SA(b, h) + aoff + m * 2048), hi_ = *(const LAS v4i*)(lds + PG8_SA(b, h) + aoff + m * 2048 + 1024); dst[m] = __builtin_shufflevector(lo_, hi_, 0, 1, 2, 3, 4, 5, 6, 7); } } while (0)
#define PG8_LDB(dst, b, h) do { _Pragma("unroll") for (int n = 0; n < 2; ++n) { const v4i lo_ = *(const LAS v4i*)(lds + PG8_SB(b, h) + boff + n * 2048), hi_ = *(const LAS v4i*)(lds + PG8_SB(b, h) + boff + n * 2048 + 1024); dst[n] = __builtin_shufflevector(lo_, hi_, 0, 1, 2, 3, 4, 5, 6, 7); } } while (0)
#define PG8_MMA(ai, bj, At, Bt) do { __builtin_amdgcn_s_setprio(1); _Pragma("unroll") for (int m = 0; m < 4; ++m) _Pragma("unroll") for (int n = 0; n < 2; ++n) { \
        if constexpr (F8) {   \
            asm volatile("v_mfma_scale_f32_16x16x128_f8f6f4 %0, %1, %2, %0, %3, %3 op_sel_hi:[0,0,0]" : "+v"(acc[ai][bj][m][n]) : "v"(Bt[n]), "v"(At[m]), "v"(one_scale));   \
        } else { \
            acc[ai][bj][m][n] = __builtin_amdgcn_mfma_f32_16x16x32_bf16(__builtin_bit_cast(bf16x8, __builtin_shufflevector(Bt[n], Bt[n], 0, 1, 2, 3)), __builtin_bit_cast(bf16x8, __builtin_shufflevector(At[m], At[m], 0, 1, 2, 3)), acc[ai][bj][m][n], 0, 0, 0); \
            acc[ai][bj][m][n] = __builtin_amdgcn_mfma_f32_16x16x32_bf16(__builtin_bit_cast(bf16x8, __builtin_shufflevector(Bt[n], Bt[n], 4, 5, 6, 7)), __builtin_bit_cast(bf16x8, __builtin_shufflevector(At[m], At[m], 4, 5, 6, 7)), acc[ai][bj][m][n], 0, 0, 0); } } \
        __builtin_amdgcn_s_setprio(0); } while (0)
#define PG8_WAIT_V(n) asm volatile("s_waitcnt vmcnt(" #n ")" ::: "memory")
#define PG8_WAIT_L(n) asm volatile("s_waitcnt lgkmcnt(" #n ")" ::: "memory")
#define PG8_BAR __builtin_amdgcn_s_barrier()
#define PG8_SCHED __builtin_amdgcn_sched_barrier(0)
#define PG8_AOFFS(o, ui) do { _Pragma("unroll") for (int _h = 0; _h < 2; ++_h) _Pragma("unroll") for (int _i = 0; _i < 2; ++_i) { \
        const int _row = tab[(ui) * 256 + _h * HALF + RA[_i]]; (o)[_h][_i] = (unsigned)(_row * KB + CA[_i] * 2); } } while (0)
    Unit cur, nxt; int ui = 0;
    if (!S.next(0, cur)) return;
    int one_scale = 0x7f7f7f7f; asm volatile("" : "+v"(one_scale));
    f32x4 acc[2][2][4][2];
#pragma unroll
    for (int a = 0; a < 2; ++a)
#pragma unroll
        for (int b = 0; b < 2; ++b)
#pragma unroll
            for (int m = 0; m < 4; ++m)
#pragma unroll
                for (int n = 0; n < 2; ++n) acc[a][b][m][n] = (f32x4){0.f, 0.f, 0.f, 0.f};
    v8i At[4], B0[2], B1[2];
    unsigned oAc[2][2], oAn[2][2], o2[2][2];
#pragma unroll
    for (int h = 0; h < 2; ++h)
#pragma unroll
        for (int i = 0; i < 2; ++i) { oAc[h][i] = 0u; oAn[h][i] = 0u; o2[h][i] = 0u; }
    if (GATHER) { PG8_AOFFS(oAc, 0); }
    const char* cAb = (const char*)g.A + (size_t)cur.pm * tstep; const char* a2b = cAb;
    const char* cB = (const char*)g.Bt + (size_t)cur.bt * tstep;
    PG8_STAGE_B(PG8_SB(0, 0), cB); PG8_STAGE_B(PG8_SB(0, 1), cB + hstep); PG8_STAGE_A(PG8_SA(0, 0), 0, 0, 0); PG8_STAGE_A(PG8_SA(0, 1), 0, 0, 1);
    if (wr == 1) PG8_BAR;
    PG8_WAIT_V(2); PG8_BAR;
    PG8_STAGE_B(PG8_SB(1, 0), cB + kstep); PG8_STAGE_A(PG8_SA(1, 0), kstep, 0, 0); PG8_STAGE_B(PG8_SB(1, 1), cB + hstep + kstep);
    PG8_WAIT_V(6); PG8_BAR;
    for (;;) {
        const bool has_next = S.next(ui + 1, nxt);
        if (GATHER) {
            if (has_next) { PG8_AOFFS(oAn, ui + 1); }
            else {
#pragma unroll
                for (int h = 0; h < 2; ++h)
#pragma unroll
                    for (int i = 0; i < 2; ++i) oAn[h][i] = oAc[h][i];
            }
        }
        const char* nAb = has_next ? (const char*)g.A + (size_t)nxt.pm * tstep : cAb;
        const char* nB = has_next ? (const char*)g.Bt + (size_t)nxt.bt * tstep : cB;
#pragma unroll 1
        for (int t = 0; t < nt; t += 2) {
            const bool last = (t == nt - 2);
            const size_t k1 = (size_t)KWRAP(t + 1) * kstep;
            const size_t k2 = last ? 0 : (size_t)KWRAP(t + 2) * kstep, k3 = k2 + kstep;
            if (GATHER) {
#pragma unroll
                for (int h = 0; h < 2; ++h)
#pragma unroll
                    for (int i = 0; i < 2; ++i) o2[h][i] = last ? oAn[h][i] : oAc[h][i];
            }
            a2b = last ? nAb : cAb;
            const char* b2 = last ? nB : cB + (size_t)KWRAP(t + 2) * kstep; const char* b3 = b2 + kstep;
            PG8_LDB(B0, 0, 0); PG8_LDB(B1, 0, 1); PG8_SCHED; PG8_LDA(At, 0, 0); PG8_STAGE_A(PG8_SA(1, 1), k1, 0, 1);
            PG8_WAIT_V(8); PG8_WAIT_L(0); PG8_BAR; PG8_MMA(0, 0, At, B0); PG8_MMA(0, 1, At, B1); PG8_BAR; PG8_SCHED;
            PG8_LDA(At, 0, 1); PG8_STAGE_B(PG8_SB(0, 0), b2); PG8_STAGE_B(PG8_SB(0, 1), b2 + hstep); PG8_STAGE_A(PG8_SA(0, 0), k2, 1, 0);
            PG8_WAIT_V(8); PG8_WAIT_L(0); PG8_BAR; PG8_MMA(1, 0, At, B0); PG8_MMA(1, 1, At, B1); PG8_BAR; PG8_SCHED;
            PG8_LDB(B0, 1, 0); PG8_LDB(B1, 1, 1); PG8_SCHED; PG8_LDA(At, 1, 0); PG8_STAGE_A(PG8_SA(0, 1), k2, 1, 1);
            PG8_WAIT_V(8); PG8_WAIT_L(0); PG8_BAR; PG8_MMA(0, 0, At, B0); PG8_MMA(0, 1, At, B1); PG8_BAR; PG8_SCHED;
            PG8_LDA(At, 1, 1); PG8_STAGE_B(PG8_SB(1, 0), b3); PG8_STAGE_B(PG8_SB(1, 1), b3 + hstep); PG8_STAGE_A(PG8_SA(1, 0), k3, 1, 0);
            PG8_WAIT_V(8); PG8_WAIT_L(0); PG8_BAR; PG8_MMA(1, 0, At, B0); PG8_MMA(1, 1, At, B1); PG8_BAR; PG8_SCHED;
        }
        if (wr == 0) PG8_BAR;
        if constexpr (F8) asm volatile("s_nop 15\n\ts_nop 15" ::: "memory");
        E(acc, cur, ui, wr, wc, fr, fq, lds);
        if (!has_next) break;
#pragma unroll
        for (int a = 0; a < 2; ++a)
#pragma unroll
            for (int b = 0; b < 2; ++b)
#pragma unroll
                for (int m = 0; m < 4; ++m)
#pragma unroll
                    for (int n = 0; n < 2; ++n) acc[a][b][m][n] = (f32x4){0.f, 0.f, 0.f, 0.f};
        cur = nxt; cB = nB; cAb = nAb; ++ui;
        if (GATHER) {
#pragma unroll
            for (int h = 0; h < 2; ++h)
#pragma unroll
                for (int i = 0; i < 2; ++i) oAc[h][i] = oAn[h][i];
        }
        if (wr == 1) PG8_BAR;
    }
    PG8_WAIT_V(0);
    PG8_BAR;
#undef PG8_SA
#undef PG8_SB
#undef PG8_STAGE_A
#undef PG8_STAGE_B
#undef PG8_LDA
#undef PG8_LDB
#undef PG8_MMA
#undef PG8_WAIT_V
#undef PG8_WAIT_L
#undef PG8_BAR
#undef PG8_SCHED
#undef PG8_AOFFS
}

#define EPI_ROWS_BEGIN(u) \
    _Pragma("unroll") for (int ai = 0; ai < 2; ++ai) _Pragma("unroll") for (int m = 0; m < 4; ++m) { const int row = (u).pm * BM + ai * HALF + wr * 64 + m * 16 + fr; const int rloc = ai * HALF + wr * 64 + m * 16 + fr; (void)rloc; (void)row;
#define EPI_ROWS_END }

template <bool E4> struct EpiHin {
    unsigned char* ws;
    __device__ __forceinline__ void operator()(const f32x4 (&acc)[2][2][4][2], const Unit& u, int ui, int wr, int wc, int fr, int fq, LAS unsigned char* lds) const {
        const int region = u.pn >> 2, cc0 = (u.pn & 3) * 256 + wc * 32 + 8 * fq;
        const LAS float* lbt = (const LAS float*)(lds + GEMM_AUX_OFF);
        if constexpr (E4) {
            bf16* O = (bf16*)(ws + (region == 0 ? WS_V : (region == 3 ? WS_Q : WS_SG)));
            EPI_ROWS_BEGIN(u)
                bf16* rowp = O + (size_t)row * D + cc0;
#pragma unroll
                for (int bj = 0; bj < 2; ++bj) { f32x4 v0 = acc[ai][bj][m][0] * (1.0f / 32.0f), v1 = acc[ai][bj][m][1] * (1.0f / 32.0f);
                    if (region != 0) {
#pragma unroll
                        for (int j = 0; j < 4; ++j) { v0[j] = siluf_(v0[j]); v1[j] = siluf_(v1[j]); } }
                    u32x4 w; w.x = pk2(v0[0], v0[1]); w.y = pk2(v0[2], v0[3]); w.z = pk2(v1[0], v1[1]); w.w = pk2(v1[2], v1[3]);
                    *(u32x4*)(rowp + bj * HALF) = w; }
            EPI_ROWS_END
        } else {
            bf16* OL = (bf16*)(ws + (region == 1 ? WS_LFF : WS_LFB));
            EPI_ROWS_BEGIN(u)
                const size_t ro = (size_t)row * D + cc0;
#pragma unroll
                for (int bj = 0; bj < 2; ++bj) {
                    const f32x4 l0 = *(const LAS f32x4*)(lbt + (region - 1) * 1024 + cc0 + bj * HALF), l1 = *(const LAS f32x4*)(lbt + (region - 1) * 1024 + cc0 + bj * HALF + 4);
                    f32x4 f0, f1;
#pragma unroll
                    for (int j = 0; j < 4; ++j) {
                        { const float a = acc[ai][bj][m][0][j], l = l0[j], sg = __builtin_amdgcn_rcpf(1.0f + __expf(-a)); f0[j] = __builtin_amdgcn_logf(l + (1.0f - l) * sg); }
                        { const float a = acc[ai][bj][m][1][j], l = l1[j], sg = __builtin_amdgcn_rcpf(1.0f + __expf(-a)); f1[j] = __builtin_amdgcn_logf(l + (1.0f - l) * sg); }
                    }
                    u32x4 w; w.x = pk2(f0[0], f0[1]); w.y = pk2(f0[2], f0[3]); w.z = pk2(f1[0], f1[1]); w.w = pk2(f1[2], f1[3]);
                    *(u32x4*)(OL + ro + bj * HALF) = w; }
            EPI_ROWS_END
        }
    }
};
template <int ACT> struct EpiBf16 {
    bf16* O; int ldc; float* stats; float scale;
    __device__ __forceinline__ void operator()(const f32x4 (&acc)[2][2][4][2], const Unit& u, int ui, int wr, int wc, int fr, int fq, LAS unsigned char* lds) const {
        const int col0 = u.pn * BM + wc * 32 + 8 * fq;
        EPI_ROWS_BEGIN(u)
            bf16* rowp = O + (size_t)row * ldc + col0; float s1 = 0.f, s2 = 0.f;
#pragma unroll
            for (int bj = 0; bj < 2; ++bj) { f32x4 v0 = acc[ai][bj][m][0] * scale, v1 = acc[ai][bj][m][1] * scale;
                if (ACT == 1) {
#pragma unroll
                    for (int j = 0; j < 4; ++j) { v0[j] = gelu_tanh(v0[j]); v1[j] = gelu_tanh(v1[j]); s1 += v0[j] + v1[j]; s2 += v0[j] * v0[j] + v1[j] * v1[j]; } }
                u32x4 w; w.x = pk2(v0[0], v0[1]); w.y = pk2(v0[2], v0[3]); w.z = pk2(v1[0], v1[1]); w.w = pk2(v1[2], v1[3]);
                *(u32x4*)(rowp + bj * HALF) = w; }
            if (ACT == 1) { s1 += __shfl_xor(s1, 16); s1 += __shfl_xor(s1, 32); s2 += __shfl_xor(s2, 16); s2 += __shfl_xor(s2, 32);
                if (u.pn >= 4 && fq == 0) *(f32x2*)(stats + ((size_t)row * 16 + (u.pn - 4) * 4 + wc) * 2) = (f32x2){s1, s2}; }
        EPI_ROWS_END
    }
};
struct EpiGU {
    bf16* Hd;
    __device__ __forceinline__ void operator()(const f32x4 (&acc)[2][2][4][2], const Unit& u, int ui, int wr, int wc, int fr, int fq, LAS unsigned char* lds) const {
        const int col0 = u.pn * HALF + wc * 32 + 8 * fq;
        EPI_ROWS_BEGIN(u)
            f32x4 g0 = acc[ai][0][m][0], g1 = acc[ai][0][m][1], u0 = acc[ai][1][m][0], u1 = acc[ai][1][m][1];
#pragma unroll
            for (int j = 0; j < 4; ++j) { g0[j] = siluf_(g0[j]) * u0[j]; g1[j] = siluf_(g1[j]) * u1[j]; }
            u32x4 w; w.x = pk2(g0[0], g0[1]); w.y = pk2(g0[2], g0[3]); w.z = pk2(g1[0], g1[1]); w.w = pk2(g1[2], g1[3]);
            *(u32x4*)(Hd + (size_t)row * FF + col0) = w;
        EPI_ROWS_END
    }
};
struct EpiGU8 {
    unsigned char* Hd;
    __device__ __forceinline__ void operator()(const f32x4 (&acc)[2][2][4][2], const Unit& u, int ui, int wr, int wc, int fr, int fq, LAS unsigned char* lds) const {
        const int col0 = u.pn * HALF + wc * 32 + 8 * fq;
        EPI_ROWS_BEGIN(u)
#ifdef DUPK
            constexpr float GS = 0.015625f;
#else
            constexpr float GS = 0.03125f;
#endif
            f32x4 g0 = acc[ai][0][m][0] * GS, g1 = acc[ai][0][m][1] * GS, u0 = acc[ai][1][m][0] * GS, u1 = acc[ai][1][m][1] * GS;
#pragma unroll
            for (int j = 0; j < 4; ++j) { g0[j] = siluf_(g0[j]) * u0[j]; g1[j] = siluf_(g1[j]) * u1[j]; }
            u32x2 w; w.x = pk4_fp8(g0[0], g0[1], g0[2], g0[3]); w.y = pk4_fp8(g1[0], g1[1], g1[2], g1[3]);
            *(u32x2*)(Hd + (size_t)row * FF + col0) = w;
        EPI_ROWS_END
    }
};
struct EpiDown {
    bf16* Yp; float scale;
    __device__ __forceinline__ void operator()(const f32x4 (&acc)[2][2][4][2], const Unit& u, int ui, int wr, int wc, int fr, int fq, LAS unsigned char* lds) const {
        const int col0 = u.pn * BM + wc * 32 + 8 * fq;
        const LAS float* gt = (const LAS float*)(lds + GEMM_TAB_OFF) + ui * 256;
        EPI_ROWS_BEGIN(u)
            const float gv = gt[rloc] * scale * 16.0f; unsigned char* rowp = (unsigned char*)Yp + (size_t)row * D + col0;
#pragma unroll
            for (int bj = 0; bj < 2; ++bj) { const f32x4 v0 = acc[ai][bj][m][0] * gv, v1 = acc[ai][bj][m][1] * gv;
                u32x2 w; w.x = pk4_fp8(v0[0], v0[1], v0[2], v0[3]); w.y = pk4_fp8(v1[0], v1[1], v1[2], v1[3]);
                *(u32x2*)(rowp + bj * HALF) = w; }
        EPI_ROWS_END
    }
};
template <class Sched> __device__ __forceinline__ void fill_row_table(LAS unsigned char* lds, const Sched& S, const unsigned* src) {
    LAS unsigned* tab = (LAS unsigned*)(lds + GEMM_TAB_OFF); Unit u;
    for (int i = 0; i < 8 && S.next(i, u); ++i) if (threadIdx.x < 256) tab[i * 256 + threadIdx.x] = src[u.pm * 256 + threadIdx.x];
    VM_WAIT(); LDS_WAIT(); __syncthreads();
}
}

#ifdef TS_SEG_LO
#define GT(k) do { asm volatile("" ::: "memory"); const unsigned long long now_ = __builtin_amdgcn_s_memrealtime(); if ((k) == TS_SEG_LO) gt[1] = now_; if ((k) == TS_SEG_HI) gt[0] += now_ - gt[1]; if ((k) == 0) gt[3] = now_; if ((k) == 8) gt[2] += now_ - gt[3]; asm volatile("" ::: "memory"); } while (0)
#define GT_DRAIN() asm volatile("s_waitcnt vmcnt(0) lgkmcnt(0)" ::: "memory")
#else
#define GT(k) do { } while (0)
#define GT_DRAIN() do { } while (0)
#endif
namespace gla {
__device__ __forceinline__ float ex2(float x) { return __builtin_amdgcn_exp2f(x); }
constexpr int QX_OFF = 0, KE_OFF = 17408, KST_OFF = 34816, VT_OFF = 53248, TOT_OFF = 71680, DG_OFF = 73728, OD_OFF = 75776, DEC_OFF = 77312, SSQ_OFF = 77824;
constexpr int QSTR = 272, PSTR = 144, TSTR = 144;
static_assert(SSQ_OFF + 1024 <= HALF_LDS, "gla LDS map");

__device__ __forceinline__ bf16x8 scale8(bf16x8 a, f32x4 f0, f32x4 f1) {
    u32x4 w = __builtin_bit_cast(u32x4, a);
    w.x = pk2(bflo(w.x) * f0[0], bfhi(w.x) * f0[1]); w.y = pk2(bflo(w.y) * f0[2], bfhi(w.y) * f0[3]);
    w.z = pk2(bflo(w.z) * f1[0], bfhi(w.z) * f1[1]); w.w = pk2(bflo(w.w) * f1[2], bfhi(w.w) * f1[3]);
    return __builtin_bit_cast(bf16x8, w);
}

__device__ __forceinline__ void half_barrier(volatile LAS unsigned* cnt, unsigned& gen, int lane) {
    asm volatile("s_waitcnt lgkmcnt(0)" ::: "memory");
    gen += 4u;
    if (lane == 0) {
        __hip_atomic_fetch_add((LAS unsigned*)cnt, 1u, __ATOMIC_RELAXED, __HIP_MEMORY_SCOPE_WORKGROUP);
        while (__hip_atomic_load((LAS unsigned*)cnt, __ATOMIC_RELAXED, __HIP_MEMORY_SCOPE_WORKGROUP) < gen) __builtin_amdgcn_s_sleep(1);
    }
    asm volatile("" ::: "memory");
}
template <int WHICH>
__device__ __forceinline__ void issue_loads(int lane, int J, const bf16* LFp, const bf16* Vp, const bf16* Qp, long row0, int rstep, int hc, unsigned (&lraw)[16], unsigned (&vraw)[16], unsigned (&qraw)[16]) {
    const unsigned base = ((unsigned)((int)row0 + rstep * (16 * J)) * (unsigned)D + (unsigned)(hc + 2 * lane)) * 2u; const int rs = rstep * (D * 2);
    if (WHICH & 1) {
#pragma unroll
        for (int jj = 0; jj < 16; ++jj) lraw[jj] = *(const unsigned*)((const char*)LFp + (base + (unsigned)(rs * jj)));
#pragma unroll
        for (int jj = 0; jj < 16; ++jj) vraw[jj] = *(const unsigned*)((const char*)Vp + (base + (unsigned)(rs * jj)));
    }
    if (WHICH & 2) {
#pragma unroll
        for (int jj = 0; jj < 16; ++jj) qraw[jj] = *(const unsigned*)((const char*)Qp + (base + (unsigned)(rs * jj)));
    }
}
template <bool OUT>
__device__ __forceinline__ void step(LAS unsigned char* hl, int hw, int lane_in, const bf16* Kp, const bf16* LFp, const bf16* Vp, const bf16* Qp, const bf16* SGp,
                                     long row0, int rstep, int hc, f32x4 (&Sacc)[8][2], float& dsum0, float& dsum1, volatile LAS unsigned* hbc, unsigned& hgen, bf16* OFd, unsigned long long (&gt)[4],
                                     unsigned (&lraw)[16], unsigned (&vraw)[16], unsigned (&qraw)[16], bool more, long next_row0) {
    GT(0);
    int lane = lane_in; asm volatile("" : "+v"(lane));
    const int J = hw, c0 = 2 * lane, l15 = lane & 15, g = lane >> 4;
    GT_DRAIN(); GT(1);
    float a0 = 0.f, a1 = 0.f;
#pragma unroll
    for (int jj = 0; jj < 16; ++jj) { a0 += bflo(lraw[jj]); a1 += bfhi(lraw[jj]); }
    LAS float* TOT = (LAS float*)(hl + TOT_OFF);
    *(LAS f32x2*)(TOT + J * 128 + c0) = (f32x2){a0, a1};
    half_barrier(hbc, hgen, lane);
    GT(2);
    if (OUT) issue_loads<2>(lane, J, LFp, Vp, Qp, row0, rstep, hc, lraw, vraw, qraw);
    float t0[4], t1[4];
#pragma unroll
    for (int I = 0; I < 4; ++I) { const f32x2 t = *(const LAS f32x2*)(TOT + I * 128 + c0); t0[I] = t.x; t1[I] = t.y; }
    float RJ0 = 0.f, RJ1 = 0.f, RA0 = 0.f, RA1 = 0.f;
#pragma unroll
    for (int I = 0; I < 4; ++I) { if (I < J) { RJ0 += t0[I]; RJ1 += t1[I]; } if (I > J) { RA0 += t0[I]; RA1 += t1[I]; } }
    const float R40 = (t0[0] + t0[1]) + (t0[2] + t0[3]), R41 = (t1[0] + t1[1]) + (t1[2] + t1[3]);
    {
        LAS float* DG = (LAS float*)(hl + DG_OFF); LAS float* OD = (LAS float*)(hl + OD_OFF); LAS float* DEC = (LAS float*)(hl + DEC_OFF);
        *(LAS f32x2*)(DG + J * 128 + c0) = (f32x2){ex2(fminf(-a0, 115.f)), ex2(fminf(-a1, 115.f))};
        if (J == 0) { *(LAS f32x2*)(DEC + c0) = (f32x2){ex2(R40), ex2(R41)}; dsum0 += R40; dsum1 += R41; }
        else if (J == 1) *(LAS f32x2*)(OD + 0 * 128 + c0) = (f32x2){ex2(t0[1]), ex2(t1[1])};
        else if (J == 2) *(LAS f32x2*)(OD + 1 * 128 + c0) = (f32x2){ex2(t0[2]), ex2(t1[2])};
        else *(LAS f32x2*)(OD + 2 * 128 + c0) = (f32x2){ex2(t0[1] + t0[2]), ex2(t1[1] + t1[2])};
    }
    const float eR0 = ex2(RJ0), eR1 = ex2(RJ1), eA0 = ex2(RA0), eA1 = ex2(RA1);
    unsigned qs[16];
    {
        float su0 = 1.0f, su1 = 1.0f;
#pragma unroll
        for (int hh = 1; hh >= 0; --hh) {
            float ks0[8], ks1[8];
#pragma unroll
            for (int j8 = 7; j8 >= 0; --j8) {
                const int jj = 8 * hh + j8, i = 16 * J + jj;
                const float f0 = ex2(bflo(lraw[jj])), f1 = ex2(bfhi(lraw[jj]));
                const float ke0 = (1.0f - f0) * su0, ke1 = (1.0f - f1) * su1;
                ks0[j8] = ke0 * eA0; ks1[j8] = ke1 * eA1;
                if (OUT) *(LAS unsigned*)(hl + KE_OFF + i * QSTR + c0 * 2) = pk2(ke0, ke1);
                su0 *= f0; su1 *= f1;
            }
            u32x4 w;
            w.x = pk2(ks0[0], ks0[1]); w.y = pk2(ks0[2], ks0[3]); w.z = pk2(ks0[4], ks0[5]); w.w = pk2(ks0[6], ks0[7]);
            *(LAS u32x4*)(hl + KST_OFF + c0 * TSTR + 32 * J + 16 * hh) = w;
            w.x = pk2(ks1[0], ks1[1]); w.y = pk2(ks1[2], ks1[3]); w.z = pk2(ks1[4], ks1[5]); w.w = pk2(ks1[6], ks1[7]);
            *(LAS u32x4*)(hl + KST_OFF + (c0 + 1) * TSTR + 32 * J + 16 * hh) = w;
#define VLO(a, b) ((vraw[a] & 0xffffu) | (vraw[b] << 16))
#define VHI(a, b) ((vraw[a] >> 16) | (vraw[b] & 0xffff0000u))
            w.x = VLO(8 * hh + 0, 8 * hh + 1); w.y = VLO(8 * hh + 2, 8 * hh + 3); w.z = VLO(8 * hh + 4, 8 * hh + 5); w.w = VLO(8 * hh + 6, 8 * hh + 7);
            *(LAS u32x4*)(hl + VT_OFF + c0 * TSTR + 32 * J + 16 * hh) = w;
            w.x = VHI(8 * hh + 0, 8 * hh + 1); w.y = VHI(8 * hh + 2, 8 * hh + 3); w.z = VHI(8 * hh + 4, 8 * hh + 5); w.w = VHI(8 * hh + 6, 8 * hh + 7);
            *(LAS u32x4*)(hl + VT_OFF + (c0 + 1) * TSTR + 32 * J + 16 * hh) = w;
#undef VLO
#undef VHI
        }
        if (OUT) {
            float pr0 = 1.0f, pr1 = 1.0f;
#pragma unroll
            for (int jj = 0; jj < 16; ++jj) {
                pr0 *= ex2(bflo(lraw[jj])); pr1 *= ex2(bfhi(lraw[jj]));
                const float qt0 = bflo(qraw[jj]) * pr0, qt1 = bfhi(qraw[jj]) * pr1;
                *(LAS unsigned*)(hl + QX_OFF + (16 * J + jj) * QSTR + c0 * 2) = pk2(qt0, qt1);
                qs[jj] = pk2(qt0 * eR0, qt1 * eR1);
            }
        } else {
#pragma unroll
            for (int jj = 0; jj < 16; ++jj) qs[jj] = 0u;
        }
    }
    GT_DRAIN(); GT(3);
    half_barrier(hbc, hgen, lane);
    GT(4);
    if (more) issue_loads<1>(lane, J, LFp, Vp, Qp, next_row0, rstep, hc, lraw, vraw, qraw);
    f32x4 o[4][2];
    if (OUT) {
        const int I = hw;
        f32x4 sc[4];
#pragma unroll
        for (int Jp = 0; Jp < 4; ++Jp) {
            sc[Jp] = (f32x4){0.f, 0.f, 0.f, 0.f};
            if (Jp <= I) {
                const LAS float* ft = (Jp == I) ? (const LAS float*)(hl + DG_OFF) + I * 128
                                    : ((I - Jp == 2) ? (const LAS float*)(hl + OD_OFF) + (I - 2) * 128 : (const LAS float*)(hl + OD_OFF) + 2 * 128);
                const bool needf = (Jp != I - 1);
                f32x4 acc = (f32x4){0.f, 0.f, 0.f, 0.f};
#pragma unroll
                for (int ks = 0; ks < 4; ++ks) {
                    bf16x8 a = *(const LAS bf16x8*)(hl + QX_OFF + (16 * I + l15) * QSTR + (32 * ks + 8 * g) * 2);
                    if (needf) { const f32x4 f0 = *(const LAS f32x4*)(ft + 32 * ks + 8 * g), f1 = *(const LAS f32x4*)(ft + 32 * ks + 8 * g + 4); a = scale8(a, f0, f1); }
                    const bf16x8 b = *(const LAS bf16x8*)(hl + KE_OFF + (16 * Jp + l15) * QSTR + (32 * ks + 8 * g) * 2);
                    acc = __builtin_amdgcn_mfma_f32_16x16x32_bf16(a, b, acc, 0, 0, 0);
                }
                if (Jp == I) {
#pragma unroll
                    for (int r = 0; r < 4; ++r) if (l15 > 4 * g + r) acc[r] = 0.f;
                }
                sc[Jp] = acc;
            }
        }
        GT(5);
        half_barrier(hbc, hgen, lane);
        GT(6);
#pragma unroll
        for (int Jp = 0; Jp < 4; ++Jp) {
            const bool wr_blk = (Jp <= I) || (I == 0 && Jp == 1) || (I == 2 && Jp == 3);
            if (wr_blk) {
#pragma unroll
                for (int r = 0; r < 4; ++r) *(LAS unsigned short*)(hl + KE_OFF + (16 * I + 4 * g + r) * PSTR + (16 * Jp + l15) * 2) = (unsigned short)(pk2(sc[Jp][r], 0.f) & 0xffffu);
            }
        }
#pragma unroll
        for (int jj = 0; jj < 16; ++jj) *(LAS unsigned*)(hl + QX_OFF + (16 * J + jj) * QSTR + c0 * 2) = qs[jj];
        half_barrier(hbc, hgen, lane);
        GT(7);
    }
    bf16x8 vb[2][2];
#pragma unroll
    for (int ct = 0; ct < 2; ++ct)
#pragma unroll
        for (int js = 0; js < 2; ++js) vb[ct][js] = *(const LAS bf16x8*)(hl + VT_OFF + (32 * hw + 16 * ct + l15) * TSTR + (32 * js + 8 * g) * 2);
    if (OUT) {
#pragma unroll
        for (int I = 0; I < 4; ++I) {
            o[I][0] = (f32x4){0.f, 0.f, 0.f, 0.f}; o[I][1] = (f32x4){0.f, 0.f, 0.f, 0.f};
#pragma unroll
            for (int ks = 0; ks < (I < 2 ? 1 : 2); ++ks) {
                const bf16x8 pa = *(const LAS bf16x8*)(hl + KE_OFF + (16 * I + l15) * PSTR + (32 * ks + 8 * g) * 2);
                o[I][0] = __builtin_amdgcn_mfma_f32_16x16x32_bf16(pa, vb[0][ks], o[I][0], 0, 0, 0);
                o[I][1] = __builtin_amdgcn_mfma_f32_16x16x32_bf16(pa, vb[1][ks], o[I][1], 0, 0, 0);
            }
        }
#pragma unroll
        for (int ks = 0; ks < 4; ++ks) {
            bf16x8 Sb[2];
#pragma unroll
            for (int ct = 0; ct < 2; ++ct) { const f32x4 s0 = Sacc[2 * ks][ct], s1 = Sacc[2 * ks + 1][ct]; u32x4 w; w.x = pk2(s0[0], s0[1]); w.y = pk2(s0[2], s0[3]); w.z = pk2(s1[0], s1[1]); w.w = pk2(s1[2], s1[3]); Sb[ct] = __builtin_bit_cast(bf16x8, w); }
#pragma unroll
            for (int I = 0; I < 4; ++I) {
                const u32x2 lo = *(const LAS u32x2*)(hl + QX_OFF + (16 * I + l15) * QSTR + (32 * ks + 4 * g) * 2), hi = *(const LAS u32x2*)(hl + QX_OFF + (16 * I + l15) * QSTR + (32 * ks + 16 + 4 * g) * 2);
                const bf16x8 qa = __builtin_bit_cast(bf16x8, (u32x4){lo.x, lo.y, hi.x, hi.y});
                o[I][0] = __builtin_amdgcn_mfma_f32_16x16x32_bf16(qa, Sb[0], o[I][0], 0, 0, 0);
                o[I][1] = __builtin_amdgcn_mfma_f32_16x16x32_bf16(qa, Sb[1], o[I][1], 0, 0, 0);
            }
        }
    }
#pragma unroll
    for (int kt = 0; kt < 8; ++kt) {
        const f32x4 d = *(const LAS f32x4*)(hl + DEC_OFF + (16 * kt + 4 * g) * 4);
        Sacc[kt][0] = Sacc[kt][0] * d; Sacc[kt][1] = Sacc[kt][1] * d;
#pragma unroll
        for (int js = 0; js < 2; ++js) {
            const bf16x8 ka = *(const LAS bf16x8*)(hl + KST_OFF + (16 * kt + l15) * TSTR + (32 * js + 8 * g) * 2);
            Sacc[kt][0] = __builtin_amdgcn_mfma_f32_16x16x32_bf16(ka, vb[0][js], Sacc[kt][0], 0, 0, 0);
            Sacc[kt][1] = __builtin_amdgcn_mfma_f32_16x16x32_bf16(ka, vb[1][js], Sacc[kt][1], 0, 0, 0);
        }
    }
    if (OUT) {
        const unsigned cbase = (unsigned)(hc + 32 * hw + l15);
#pragma unroll
        for (int I = 0; I < 4; ++I)
#pragma unroll
            for (int r = 0; r < 4; ++r) { const unsigned ro = (unsigned)((int)row0 + rstep * (16 * I + 4 * g + r)) * (unsigned)D + cbase;
                OFd[ro] = (bf16)(pk2(o[I][0][r], 0.f) & 0xffffu); OFd[ro + 16] = (bf16)(pk2(o[I][1][r], 0.f) & 0xffffu); }
    }
    GT(8);
}

struct Ptrs { const bf16 *V, *KF, *LFF, *KB, *LFB, *Q, *SG; float* OF; bf16* OG; const float* gn; float *LST, *SENT, *LSTC, *DSUM, *DSUMC; };

__device__ __forceinline__ void pass_a(LAS unsigned char* lds, const Ptrs& P, int G) {
    const int tid = opaque_tid(), wid = __builtin_amdgcn_readfirstlane(tid >> 6), lane = tid & 63, dir = wid >> 2, hw = wid & 3, l15 = lane & 15, g = lane >> 4;
    LAS unsigned char* hl = lds + dir * HALF_LDS;
    const bf16* Kp = dir ? P.KB : P.KF; const bf16* LFp = dir ? P.LFB : P.LFF;
    volatile LAS unsigned* hbc = (volatile LAS unsigned*)(lds + MISC_OFF) + 16 + dir * 4; unsigned hgen = 0u;
    if (tid < 8) ((volatile LAS unsigned*)(lds + MISC_OFF))[16 + tid] = 0u;
    __syncthreads();
    for (int it = blockIdx.x; it < 320; it += G) {
        const bool isctx = it >= 256;
        int b, h, sc, nsteps; long base;
        if (!isctx) { b = it >> 7; h = (it >> 4) & 7; sc = it & 15; nsteps = 8; base = (long)b * T + sc * SCT; }
        else { const int r = it - 256; b = r >> 5; h = (r >> 2) & 7; sc = r & 3; nsteps = 1; base = (long)M + b * CTX + 64 * sc; }
        f32x4 Sacc[8][2];
#pragma unroll
        for (int kt = 0; kt < 8; ++kt) { Sacc[kt][0] = (f32x4){0.f, 0.f, 0.f, 0.f}; Sacc[kt][1] = (f32x4){0.f, 0.f, 0.f, 0.f}; }
        float ds0 = 0.f, ds1 = 0.f; unsigned long long gt[4] = {0ull, 0ull, 0ull, 0ull};
        unsigned lraw[16], vraw[16], qraw[16];
        issue_loads<1>(lane, hw, LFp, P.V, P.Q, dir ? base + 64 * (nsteps - 1) + 63 : base, dir ? -1 : 1, h * HD, lraw, vraw, qraw);
#pragma unroll
        for (int jj = 0; jj < 16; ++jj) qraw[jj] = 0u;
        for (int s = 0; s < nsteps; ++s) {
            const long row0 = dir ? base + 64 * (nsteps - 1 - s) + 63 : base + 64 * s;
            step<false>(hl, hw, lane, Kp, LFp, P.V, P.Q, P.SG, row0, dir ? -1 : 1, h * HD, Sacc, ds0, ds1, hbc, hgen, nullptr, gt, lraw, vraw, qraw, s + 1 < nsteps, dir ? row0 - 64 : row0 + 64);
        }
#ifdef TS_SEG_LO
        if (it == TS_SEG_ITEM && tid == TS_SEG_TID && TS_SEG_PASS == 0) { *(volatile unsigned long long*)((unsigned char*)P.DSUM - WS_DSUM + WS_CTL + 32768) = 0ull; *(volatile unsigned long long*)((unsigned char*)P.DSUM - WS_DSUM + WS_CTL + 32776) = (unsigned long long)((float)gt[0] * 10000.0f / (float)gt[2]); }
#endif
        const int seq = (b * NH + h) * 2 + dir;
        if (isctx) { float* dst = P.LSTC + ((size_t)seq * 4 + sc) * 16384;
#pragma unroll
            for (int kt = 0; kt < 8; ++kt)
#pragma unroll
                for (int ct = 0; ct < 2; ++ct)
#pragma unroll
                    for (int r = 0; r < 4; ++r) dst[(16 * kt + 4 * g + r) * 128 + 32 * hw + 16 * ct + l15] = Sacc[kt][ct][r];
        } else { bf16* dst = (bf16*)P.LST + ((size_t)seq * NSC + sc) * 16384;
#pragma unroll
            for (int kt = 0; kt < 8; ++kt)
#pragma unroll
                for (int ct = 0; ct < 2; ++ct)
#pragma unroll
                    for (int r = 0; r < 4; ++r) dst[(16 * kt + 4 * g + r) * 128 + 32 * hw + 16 * ct + l15] = (bf16)(pk2(Sacc[kt][ct][r], 0.f) & 0xffffu); }
        if (hw == 0) *(f32x2*)((isctx ? P.DSUMC + ((size_t)seq * 4 + sc) * 128 : P.DSUM + ((size_t)seq * NSC + sc) * 128) + 2 * lane) = (f32x2){ds0, ds1};
    }
}
__device__ __forceinline__ void pass_b(const Ptrs& P, int G) {
    for (int idx = blockIdx.x * 512 + threadIdx.x; idx < 32 * 4096; idx += G * 512) {
        const int seq = idx >> 12, e4 = (idx & 4095) * 4, k = e4 >> 7, dir = seq & 1;
        f32x4 cur = (f32x4){0.f, 0.f, 0.f, 0.f};
        for (int j = 0; j < 4; ++j) { const int cc = dir ? 3 - j : j; const size_t o = (size_t)seq * 4 + cc;
            cur = cur * ex2(P.DSUMC[o * 128 + k]) + *(const f32x4*)(P.LSTC + o * 16384 + e4); }
        for (int j = 0; j < NSC; ++j) {
            const int sc = dir ? NSC - 1 - j : j;
            const size_t o = ((size_t)seq * NSC + sc);
            { u32x2 wv; wv.x = pk2(cur[0], cur[1]); wv.y = pk2(cur[2], cur[3]); *(u32x2*)((bf16*)P.SENT + o * 16384 + e4) = wv; }
            const float dk = ex2(P.DSUM[o * 128 + k]);
            const u32x2 lw = *(const u32x2*)((const bf16*)P.LST + o * 16384 + e4);
            cur = cur * dk + (f32x4){bflo(lw.x), bfhi(lw.x), bflo(lw.y), bfhi(lw.y)};
        }
    }
}
__device__ __forceinline__ void pass_c(LAS unsigned char* lds, const Ptrs& P, int G) {
    const int tid = opaque_tid(), wid = __builtin_amdgcn_readfirstlane(tid >> 6), lane = tid & 63, dir = wid >> 2, hw = wid & 3, l15 = lane & 15, g = lane >> 4;
    LAS unsigned char* hl = lds + dir * HALF_LDS;
    const bf16* Kp = dir ? P.KB : P.KF; const bf16* LFp = dir ? P.LFB : P.LFF;
    bf16* OFf = (bf16*)P.OF; bf16* OFb = OFf + (size_t)M * D; bf16* OFd = dir ? OFb : OFf;
    volatile LAS unsigned* hbc = (volatile LAS unsigned*)(lds + MISC_OFF) + 16 + dir * 4; unsigned hgen = 0u;
    if (tid < 8) ((volatile LAS unsigned*)(lds + MISC_OFF))[16 + tid] = 0u;
    __syncthreads();
    for (int it = blockIdx.x; it < 256; it += G) {
        const int b = it >> 7, h = (it >> 4) & 7, sc = it & 15; const long base = (long)b * T + sc * SCT;
        const int seq = (b * NH + h) * 2 + dir;
        const bf16* src = (const bf16*)P.SENT + ((size_t)seq * NSC + sc) * 16384;
        f32x4 Sacc[8][2];
#pragma unroll
        for (int kt = 0; kt < 8; ++kt)
#pragma unroll
            for (int ct = 0; ct < 2; ++ct)
#pragma unroll
                for (int r = 0; r < 4; ++r) Sacc[kt][ct][r] = bflo((unsigned)src[(16 * kt + 4 * g + r) * 128 + 32 * hw + 16 * ct + l15]);
        float ds0 = 0.f, ds1 = 0.f; unsigned long long gt[4] = {0ull, 0ull, 0ull, 0ull};
        unsigned lraw[16], vraw[16], qraw[16];
        issue_loads<1>(lane, hw, LFp, P.V, P.Q, dir ? base + 64 * 7 + 63 : base, dir ? -1 : 1, h * HD, lraw, vraw, qraw);
        {
            unsigned short* sink = (unsigned short*)((unsigned char*)P.DSUM - WS_DSUM + WS_CTL + 49152) + lane;
#pragma unroll
            for (int k = 0; k < 32; ++k) sink[64 * k] = (unsigned short)0;
        }
        for (int s = 0; s < 8; ++s) {
            const long row0 = dir ? base + 64 * (7 - s) + 63 : base + 64 * s;
            step<true>(hl, hw, lane, Kp, LFp, P.V, P.Q, P.SG, row0, dir ? -1 : 1, h * HD, Sacc, ds0, ds1, hbc, hgen, OFd, gt, lraw, vraw, qraw, s < 7, dir ? row0 - 64 : row0 + 64);
        }
#ifdef TS_SEG_LO
        if (it == TS_SEG_ITEM && tid == TS_SEG_TID && TS_SEG_PASS == 2) { *(volatile unsigned long long*)((unsigned char*)P.DSUM - WS_DSUM + WS_CTL + 32768) = 0ull; *(volatile unsigned long long*)((unsigned char*)P.DSUM - WS_DSUM + WS_CTL + 32776) = (unsigned long long)((float)gt[0] * 10000.0f / (float)gt[2]); }
#endif
        VM_WAIT(); __syncthreads();
        {
            const int ch = h * HD + 4 * (lane & 31);
            const f32x4 gw = *(const f32x4*)(P.gn + ch);
#pragma unroll 4
            for (int rr = 0; rr < 32; ++rr) {
                const size_t ro = (size_t)(base + rr * 16 + wid * 2 + (lane >> 5)) * D + ch;
                const u32x2 f = *(const u32x2*)(OFf + ro), bb = *(const u32x2*)(OFb + ro), sg = *(const u32x2*)(P.SG + ro);
                f32x4 o = (f32x4){bflo(f.x) + bflo(bb.x), bfhi(f.x) + bfhi(bb.x), bflo(f.y) + bflo(bb.y), bfhi(f.y) + bfhi(bb.y)};
                float ss = (o[0] * o[0] + o[1] * o[1]) + (o[2] * o[2] + o[3] * o[3]);
#pragma unroll
                for (int m = 1; m < 32; m <<= 1) ss += __shfl_xor(ss, m);
                const float rstd = rsqrtf(ss * (1.0f / HD) + EPS);
                u32x2 w; w.x = pk2(o[0] * rstd * gw[0] * bflo(sg.x), o[1] * rstd * gw[1] * bfhi(sg.x)); w.y = pk2(o[2] * rstd * gw[2] * bflo(sg.y), o[3] * rstd * gw[3] * bfhi(sg.y));
                *(u32x2*)(P.OG + ro) = w;
            }
        }
        __syncthreads();
    }
}
}

struct Args {
    const float *x, *c, *ctx, *c_ctx, *w_ada, *b_ada, *norm_w, *hg_w_in, *hg_lb, *hg_gnorm, *hg_w_out, *sg_w_in, *sg_ln_w, *sg_ln_b, *sg_w_s, *sg_b_s, *sg_w_out,
                *moe_router, *moe_w_gate, *moe_w_up, *moe_w_down;
    float* out; unsigned char* ws; int ph_lo, ph_hi, li, pad;
};
#define CAS __attribute__((address_space(4)))
typedef const CAS Args& ArgsRef;
__device__ __forceinline__ const CAS Args* launder_args(const CAS Args* p) { asm volatile("" : "+s"(p)); return p; }

#ifdef TS_A
#define USTAMP(n) do { if (blockIdx.x == 0 && threadIdx.x == 0) { if ((n) == TS_A) *(volatile unsigned long long*)(a.ws + WS_CTL + 32768) = __builtin_amdgcn_s_memrealtime(); if ((n) == TS_B) *(volatile unsigned long long*)(a.ws + WS_CTL + 32776) = __builtin_amdgcn_s_memrealtime(); } } while (0)
#else
#define USTAMP(n) do { } while (0)
#endif
struct ConvTile { const float* W; bf16* WT; int K, N, rowmode, kt, nt, f8; };
constexpr int NT_SMALL = 160 + 32 + 64 + 32, NT_MOE = 2 * 3072;
constexpr int Q_HEAD = 6144, Q_DONE0 = 6144 + 64, Q_DONE1 = 6144 + 128, Q_DONE2 = 6144 + 192, Q_SMALL = 6144 + 256;
__device__ __forceinline__ void conv_decode_small(ArgsRef a, int r, ConvTile& t) {
    unsigned char* ws = a.ws;
    t.f8 = 0;
    if (r < 160) { t.W = a.hg_w_in; t.K = D; t.N = 5 * D; t.rowmode = 0; t.kt = r / 20; t.nt = r % 20;
                   const int region = t.nt >> 2; t.f8 = (region == 1 || region == 2) ? 0 : 1; t.WT = (bf16*)(ws + (t.f8 ? WS_WHIN8 : WS_WHIN)); }
    else if ((r -= 160) < 32) { t.W = a.hg_w_out; t.WT = (bf16*)(ws + WS_WHOUT); t.K = D; t.N = D; t.rowmode = 0; t.kt = r >> 2; t.nt = r & 3; }
    else if ((r -= 32) < 64) { t.W = a.sg_w_in; t.WT = (bf16*)(ws + WS_WSIN); t.K = D; t.N = 2 * D; t.rowmode = 0; t.kt = r >> 3; t.nt = r & 7; t.f8 = 1; }
    else { r -= 64; t.W = a.sg_w_out; t.WT = (bf16*)(ws + WS_WSOUT); t.K = D; t.N = D; t.rowmode = 0; t.kt = r >> 2; t.nt = r & 3; t.f8 = 1; }
}
__device__ __forceinline__ void conv_decode_moe(ArgsRef a, int r, ConvTile& t) {
    unsigned char* ws = a.ws; unsigned char* WGU = ws + WS_WGU; unsigned char* WD = ws + WS_WD;
    const int l = r / 3072, q = r % 3072, mat = q >> 10, e = (q >> 6) & 15, tt = q & 63, le = l * 16 + e;
    t.f8 = 1;
    if (mat == 0) { t.W = a.moe_w_gate + (size_t)le * D * FF; t.WT = (bf16*)(WGU + (size_t)le * 4096 * D); t.K = D; t.N = FF; t.rowmode = 1; t.kt = tt >> 3; t.nt = tt & 7; }
    else if (mat == 1) { t.W = a.moe_w_up + (size_t)le * D * FF; t.WT = (bf16*)(WGU + (size_t)le * 4096 * D); t.K = D; t.N = FF; t.rowmode = 2; t.kt = tt >> 3; t.nt = tt & 7; }
    else { t.W = a.moe_w_down + (size_t)le * FF * D; t.WT = (bf16*)(WD + (size_t)le * D * FF); t.K = FF; t.N = D; t.rowmode = 0; t.kt = tt >> 2; t.nt = tt & 3; }
}
__device__ __forceinline__ void conv_load(const ConvTile& t, f32x4 (&v)[16], int wave, int lane) {
#pragma unroll
    for (int i = 0; i < 16; ++i) v[i] = __builtin_nontemporal_load((const f32x4*)(t.W + (size_t)(t.kt * 128 + wave * 16 + i) * t.N + t.nt * 256 + 4 * lane));
}
__device__ __forceinline__ void conv_to_lds(LAS unsigned char* buf, const f32x4 (&v)[16], int wave, int lane) {
#pragma unroll
    for (int i = 0; i < 16; ++i) { const int k = wave * 16 + i; u32x2 w; w.x = pk2(v[i][0], v[i][1]); w.y = pk2(v[i][2], v[i][3]); *(LAS u32x2*)(buf + k * 512 + (((4 * lane) ^ (((k >> 3) & 7) << 3)) * 2)) = w; }
}
__device__ __forceinline__ void conv_store(LAS unsigned char* buf, const ConvTile& t, int wave, int lane) {
#pragma unroll
    for (int q = 0; q < 8; ++q) {
        const int idx = wave * 8 + q, rowgrp = idx >> 1, c8 = (idx & 1) * 8 + (lane & 7), nl = rowgrp * 8 + (lane >> 3), n = t.nt * 256 + nl;
        const LAS unsigned short* p = (const LAS unsigned short*)(buf + (8 * c8) * 512 + ((nl ^ ((c8 & 7) << 3)) * 2));
        u32x4 o;
        o.x = (unsigned)p[0 * 256] | ((unsigned)p[1 * 256] << 16); o.y = (unsigned)p[2 * 256] | ((unsigned)p[3 * 256] << 16);
        o.z = (unsigned)p[4 * 256] | ((unsigned)p[5 * 256] << 16); o.w = (unsigned)p[6 * 256] | ((unsigned)p[7 * 256] << 16);
        const int row = t.rowmode == 0 ? n : ((n >> 7) * 256 + (n & 127) + (t.rowmode == 2 ? 128 : 0));
        *(u32x4*)(t.WT + (size_t)row * t.K + t.kt * 128 + 8 * c8) = o;
    }
}
__device__ __forceinline__ void conv_to_lds8(LAS unsigned char* buf, const f32x4 (&v)[16], int wave, int lane) {
#pragma unroll
    for (int j = 0; j < 4; ++j) { const int n = 4 * lane + j; u32x4 o;
        o.x = pk4_fp8(v[0][j] * 32.f, v[1][j] * 32.f, v[2][j] * 32.f, v[3][j] * 32.f); o.y = pk4_fp8(v[4][j] * 32.f, v[5][j] * 32.f, v[6][j] * 32.f, v[7][j] * 32.f);
        o.z = pk4_fp8(v[8][j] * 32.f, v[9][j] * 32.f, v[10][j] * 32.f, v[11][j] * 32.f); o.w = pk4_fp8(v[12][j] * 32.f, v[13][j] * 32.f, v[14][j] * 32.f, v[15][j] * 32.f);
        *(LAS u32x4*)(buf + n * 128 + ((wave ^ (((n >> 2) ^ n) & 7)) << 4)) = o; }
}
__device__ __forceinline__ void conv_store8(LAS unsigned char* buf, const ConvTile& t, int wave, int lane) {
    unsigned char* WT8 = (unsigned char*)t.WT;
#pragma unroll
    for (int q = 0; q < 4; ++q) {
        const int c = lane & 7, nl = (wave * 4 + q) * 8 + (lane >> 3), n = t.nt * 256 + nl;
        const u32x4 o = *(const LAS u32x4*)(buf + nl * 128 + ((c ^ (((nl >> 2) ^ nl) & 7)) << 4));
        const int row = t.rowmode == 0 ? n : ((n >> 7) * 256 + (n & 127) + (t.rowmode == 2 ? 128 : 0));
        *(u32x4*)(WT8 + (size_t)row * t.K + t.kt * 128 + 16 * c) = o;
    }
}
#define CONV_BAR() do { LDS_WAIT(); __builtin_amdgcn_s_barrier(); asm volatile("" ::: "memory"); } while (0)
template <int CONV_BATCH>
__device__ __forceinline__ void convert_worker(LAS unsigned char* lds, ArgsRef a, int mand, int done_idx, unsigned done_target) {
    const int tid = opaque_tid(), lane = tid & 63, wave = __builtin_amdgcn_readfirstlane(tid >> 6);
    unsigned* ctl = (unsigned*)(a.ws + WS_CTL);
    volatile LAS int* slot = (volatile LAS int*)(lds + 131072);
    int rng_next = 0, rng_end = 0, lastb = -1; bool stopf = false;
#define CONV_NEXT(r_) do { \
        if (rng_next < rng_end) r_ = rng_next++; \
        else if (stopf) r_ = -1; \
        else { const unsigned dn_ = __hip_atomic_load(ctl + done_idx, __ATOMIC_RELAXED, __HIP_MEMORY_SCOPE_AGENT); \
            if (lastb >= 0 && lastb + CONV_BATCH >= mand && dn_ >= done_target) { stopf = true; r_ = -1; } \
            else { const int t_ = (int)__hip_atomic_fetch_add(ctl + Q_HEAD, (unsigned)CONV_BATCH, __ATOMIC_RELAXED, __HIP_MEMORY_SCOPE_AGENT); lastb = t_; \
                if (t_ >= NT_MOE) { stopf = true; r_ = -1; } else { rng_next = t_ + 1; rng_end = t_ + CONV_BATCH < NT_MOE ? t_ + CONV_BATCH : NT_MOE; r_ = t_; } } } } while (0)
    if (tid == 0) { int r0, r1; CONV_NEXT(r0); CONV_NEXT(r1); slot[0] = r0; slot[1] = r1; }
    __syncthreads();
    f32x4 va[16], vb[16]; ConvTile ta, tb;
    int ca = slot[0], cb = slot[1];
    if (ca >= 0) { conv_decode_moe(a, ca, ta); conv_load(ta, va, wave, lane); }
    if (cb >= 0) { conv_decode_moe(a, cb, tb); conv_load(tb, vb, wave, lane); }
#define CONV_ROUND(X, tX, cX, bufoff, sl) do { \
        LAS unsigned char* buf_ = lds + (bufoff); \
        conv_to_lds8(buf_, X, wave, lane); \
        const ConvTile cc_ = tX; \
        if (tid == 0) { int r_; CONV_NEXT(r_); slot[sl] = r_; } \
        CONV_BAR(); \
        const int nxt_ = slot[sl]; \
        if (nxt_ >= 0) { conv_decode_moe(a, nxt_, tX); conv_load(tX, X, wave, lane); } \
        conv_store8(buf_, cc_, wave, lane); \
        cX = nxt_; } while (0)
    while (ca >= 0) {
        CONV_ROUND(va, ta, ca, 0, 2);
        if (cb < 0) break;
        CONV_ROUND(vb, tb, cb, 65536, 3);
    }
#undef CONV_ROUND
#undef CONV_NEXT
    __syncthreads();
}

__device__ __forceinline__ void phase_p0a(LAS unsigned char* lds, ArgsRef a, int G, int vcu) {
    unsigned char* ws = a.ws;
    const int tid = opaque_tid(), lane = tid & 63, wave = __builtin_amdgcn_readfirstlane(tid >> 6);
    USTAMP(0);
    {
        LAS float* sv = (LAS float*)(lds + 67584);
        LAS float* red = (LAS float*)(lds + 67584 + 12288);
        float* MOD = (float*)(ws + WS_MOD);
        for (int i = tid; i < 3072; i += 512) { const int v = i >> 10, k = i & 1023; sv[i] = siluf_(v < 2 ? a.c[v * D + k] : a.c_ctx[k]); }
        __syncthreads();
        for (int it = blockIdx.x; it < 192; it += G) {
            const int l = it / 96, cb = it % 96, n = cb * 64 + lane;
            const float* w = a.w_ada + (size_t)l * D * 6144 + (size_t)(wave * 128) * 6144 + n;
            float a0 = 0.f, a1 = 0.f, a2 = 0.f;
#pragma unroll 32
            for (int k = 0; k < 128; ++k) { const float wv = w[(size_t)k * 6144]; const int kk = wave * 128 + k; a0 += sv[kk] * wv; a1 += sv[1024 + kk] * wv; a2 += sv[2048 + kk] * wv; }
            red[(wave * 3 + 0) * 64 + lane] = a0; red[(wave * 3 + 1) * 64 + lane] = a1; red[(wave * 3 + 2) * 64 + lane] = a2;
            __syncthreads();
            if (tid < 192) { const int v = tid >> 6, c = tid & 63; float sacc = a.b_ada[l * 6144 + cb * 64 + c];
#pragma unroll
                for (int ww = 0; ww < 8; ++ww) sacc += red[(ww * 3 + v) * 64 + c];
                MOD[(size_t)(l * 3 + v) * 6144 + cb * 64 + c] = sacc; }
            __syncthreads();
        }
    }
    USTAMP(1);
    {
        f32x4 v[16]; ConvTile ct; int par = 0;
        volatile LAS int* slot = (volatile LAS int*)(lds + 131072);
        unsigned* qs = (unsigned*)(ws + WS_CTL) + Q_SMALL;
        if (tid == 0) slot[0] = (int)__hip_atomic_fetch_add(qs, 1u, __ATOMIC_RELAXED, __HIP_MEMORY_SCOPE_AGENT);
        __syncthreads();
        int it = slot[0];
        if (it < NT_SMALL) { conv_decode_small(a, it, ct); conv_load(ct, v, wave, lane); }
        while (it < NT_SMALL) {
            LAS unsigned char* buf = lds + par * 65536;
            const ConvTile cc = ct;
            if (cc.f8) conv_to_lds8(buf, v, wave, lane); else conv_to_lds(buf, v, wave, lane);
            if (tid == 0) slot[1 + par] = (int)__hip_atomic_fetch_add(qs, 1u, __ATOMIC_RELAXED, __HIP_MEMORY_SCOPE_AGENT);
            CONV_BAR();
            const int nx = slot[1 + par];
            if (nx < NT_SMALL) { conv_decode_small(a, nx, ct); conv_load(ct, v, wave, lane); }
            if (cc.f8) conv_store8(buf, cc, wave, lane); else conv_store(buf, cc, wave, lane);
            it = nx; par ^= 1;
        }
        __syncthreads();
    }
    USTAMP(2);
    {
        const int gt = blockIdx.x * 512 + tid, GT = G * 512;
        bf16* WSb = (bf16*)(ws + WS_WS);
        for (int i = gt; i < 8 * 128 * 128 / 2; i += GT) { const f32x2 v = *(const f32x2*)(a.sg_w_s + 2 * i); ((unsigned*)WSb)[i] = pk2(v.x, v.y); }
        float* LB = (float*)(ws + WS_LB);
        for (int i = gt; i < 2048; i += GT) { const float l0 = a.hg_lb[i], l1 = a.hg_lb[2048 + i], l2 = a.hg_lb[4096 + i]; const float mx = fmaxf(l0, fmaxf(l1, l2));
            const float e0 = expf(l0 - mx), e1 = expf(l1 - mx), e2 = expf(l2 - mx); LB[i] = e0 / (e0 + e1 + e2); }
    }
    USTAMP(3);
}

#define ROFF(lane, j) (8 * (lane) + 512 * ((j) >> 1) + 4 * ((j) & 1))
__device__ __forceinline__ void row_load_f32(const float* p, int lane, f32x4 (&x)[4]) {
#pragma unroll
    for (int j = 0; j < 4; ++j) x[j] = *(const f32x4*)(p + ROFF(lane, j));
}
__device__ __forceinline__ void row_store_f32(float* p, int lane, const f32x4 (&x)[4]) {
#pragma unroll
    for (int j = 0; j < 4; ++j) *(f32x4*)(p + ROFF(lane, j)) = x[j];
}
__device__ __forceinline__ void row_store_bf16(bf16* p, int lane, const f32x4 (&x)[4]) {
#pragma unroll
    for (int h = 0; h < 2; ++h) { u32x4 w; w.x = pk2(x[2 * h][0], x[2 * h][1]); w.y = pk2(x[2 * h][2], x[2 * h][3]); w.z = pk2(x[2 * h + 1][0], x[2 * h + 1][1]); w.w = pk2(x[2 * h + 1][2], x[2 * h + 1][3]);
        *(u32x4*)(p + 8 * lane + 512 * h) = w; }
}
__device__ __forceinline__ void row_load_raw(const bf16* p, int lane, u32x4 (&r)[2]) {
#pragma unroll
    for (int h = 0; h < 2; ++h) r[h] = *(const u32x4*)(p + 8 * lane + 512 * h);
}
__device__ __forceinline__ void row_unpack(const u32x4 (&r)[2], f32x4 (&x)[4]) {
#pragma unroll
    for (int h = 0; h < 2; ++h) { x[2 * h] = (f32x4){bflo(r[h].x), bfhi(r[h].x), bflo(r[h].y), bfhi(r[h].y)}; x[2 * h + 1] = (f32x4){bflo(r[h].z), bfhi(r[h].z), bflo(r[h].w), bfhi(r[h].w)}; }
}
__device__ __forceinline__ void row_store_fp8(unsigned char* p, int lane, const f32x4 (&x)[4]) {
#pragma unroll
    for (int h = 0; h < 2; ++h) { u32x2 w; w.x = pk4_fp8(x[2 * h][0], x[2 * h][1], x[2 * h][2], x[2 * h][3]); w.y = pk4_fp8(x[2 * h + 1][0], x[2 * h + 1][1], x[2 * h + 1][2], x[2 * h + 1][3]);
        *(u32x2*)(p + 8 * lane + 512 * h) = w; }
}
__device__ __forceinline__ float row_rstd(const f32x4 (&x)[4]) {
    float s = 0.f;
#pragma unroll
    for (int j = 0; j < 4; ++j) s += (x[j][0] * x[j][0] + x[j][1] * x[j][1]) + (x[j][2] * x[j][2] + x[j][3] * x[j][3]);
    return rsqrtf(wave_sum(s) * (1.0f / D) + EPS);
}

__device__ __forceinline__ void phase_p0b(LAS unsigned char* lds, ArgsRef a, int G, int vcu) {
    unsigned char* ws = a.ws;
    const int tid = opaque_tid(), lane = tid & 63, wave = __builtin_amdgcn_readfirstlane(tid >> 6);
    const float* MOD = (const float*)(ws + WS_MOD);
    LAS float* modl = (LAS float*)lds;
    for (int i = tid; i < 6144; i += 512) { const int v = i >> 11, n = i & 2047; modl[i] = MOD[(size_t)v * 6144 + n]; }
    __syncthreads();
    bf16* XR = (bf16*)(ws + WS_XR); bf16* H = (bf16*)(ws + WS_H);
    f32x4 nw[4]; row_load_f32(a.norm_w, lane, nw);
    float frq[16];
#pragma unroll
    for (int j = 0; j < 4; ++j)
#pragma unroll
        for (int e = 0; e < 4; ++e) { const int dd = ROFF(lane, j) + e; frq[4 * j + e] = expf(-9.210340371976184f * (float)(dd & 255) / 256.0f); }
    const float phs = (lane & 32) ? 1.5707963267948966f : 0.0f;
    f32x4 pcol[2];
    { const float pc = (float)((vcu * 8 + wave) & 63);
#pragma unroll
      for (int j = 2; j < 4; ++j)
#pragma unroll
        for (int e = 0; e < 4; ++e) pcol[j - 2][e] = __sinf(pc * frq[4 * j + e] + phs); }
    const bool colconst = ((G * 8) & 63) == 0;
    f32x4 xn[4];
    { const int m0 = vcu * 8 + wave; if (m0 < MT) row_load_f32(m0 < M ? a.x + (size_t)m0 * D : a.ctx + (size_t)(m0 - M) * D, lane, xn); }
    for (int m = vcu * 8 + wave; m < MT; m += G * 8) {
        f32x4 x[4]; int v;
#pragma unroll
        for (int j = 0; j < 4; ++j) x[j] = xn[j];
        { const int mn = m + G * 8; if (mn < MT) row_load_f32(mn < M ? a.x + (size_t)mn * D : a.ctx + (size_t)(mn - M) * D, lane, xn); }
        if (m < M) {
            v = m >> 13;
            const float pr = (float)((m & (T - 1)) >> 6);
            if (!colconst) { const float pc = (float)(m & 63);
#pragma unroll
                for (int j = 2; j < 4; ++j)
#pragma unroll
                    for (int e = 0; e < 4; ++e) pcol[j - 2][e] = __sinf(pc * frq[4 * j + e] + phs); }
#pragma unroll
            for (int j = 0; j < 2; ++j)
#pragma unroll
                for (int e = 0; e < 4; ++e) x[j][e] += __sinf(pr * frq[4 * j + e] + phs);
            x[2] = x[2] + pcol[0]; x[3] = x[3] + pcol[1];
            row_store_bf16(XR + (size_t)m * D, lane, x);
        } else v = 2;
        const float rs = row_rstd(x);
#pragma unroll
        for (int j = 0; j < 4; ++j) { const f32x4 sh = *(const LAS f32x4*)(modl + v * 2048 + ROFF(lane, j)), sc = *(const LAS f32x4*)(modl + v * 2048 + 1024 + ROFF(lane, j));
            x[j] = x[j] * rs * nw[j] * (sc + 1.0f) + sh; }
        row_store_bf16(H + (size_t)m * D, lane, x);
        row_store_fp8(ws + WS_H8 + (size_t)m * D, lane, x);
    }
}

__device__ __forceinline__ void phase_rowpass_a(LAS unsigned char* lds, ArgsRef a, int G, int vcu, int l) {
    unsigned char* ws = a.ws;
    const int tid = opaque_tid(), lane = tid & 63, wave = __builtin_amdgcn_readfirstlane(tid >> 6);
    LAS float* RT = (LAS float*)lds;
    const float* router = a.moe_router + (size_t)l * D * NE;
    for (int i = tid; i < D * NE; i += 512) { const int d = i >> 4, ln = (d & 511) >> 3, jj = 2 * (d >> 9) + ((d & 7) >> 2);
        RT[(i & 15) * 1024 + 4 * ln + 256 * jj + (d & 3)] = router[i]; }
    __syncthreads();
    const float* MOD = (const float*)(ws + WS_MOD); bf16* XR = (bf16*)(ws + WS_XR); bf16* H = (bf16*)(ws + WS_H); const bf16* Y = (const bf16*)(ws + WS_Y); float* AFF = (float*)(ws + WS_AFF);
    f32x4 nw1[4], nw2[4]; row_load_f32(a.norm_w + (size_t)(l * 4 + 1) * D, lane, nw1); row_load_f32(a.norm_w + (size_t)(l * 4 + 2) * D, lane, nw2);
    u32x4 yr[2], xr[2];
    { const int m0 = vcu * 8 + wave; if (m0 < M) { row_load_raw(Y + (size_t)m0 * D, lane, yr); row_load_raw(XR + (size_t)m0 * D, lane, xr); } }
    f32x4 g1[4], sh[4], sc[4]; int bcur = -1;
    for (int m = vcu * 8 + wave; m < M; m += G * 8) {
        const int b = m >> 13;
        if (b != bcur) { const float* mod = MOD + (size_t)(l * 3 + b) * 6144; row_load_f32(mod + 2 * D, lane, g1); row_load_f32(mod + 3 * D, lane, sh); row_load_f32(mod + 4 * D, lane, sc); bcur = b; }
        f32x4 y[4], x[4];
        row_unpack(yr, y); row_unpack(xr, x);
        { const int mn = m + G * 8; if (mn < M) { row_load_raw(Y + (size_t)mn * D, lane, yr); row_load_raw(XR + (size_t)mn * D, lane, xr); } }
        const float r1 = row_rstd(y);
#pragma unroll
        for (int j = 0; j < 4; ++j) x[j] = x[j] + g1[j] * (y[j] * r1 * nw1[j]);
        row_store_bf16(XR + (size_t)m * D, lane, x);
        const float r2 = row_rstd(x);
#pragma unroll
        for (int j = 0; j < 4; ++j) y[j] = x[j] * r2 * nw2[j] * (sc[j] + 1.0f) + sh[j];
        row_store_fp8((unsigned char*)H + (size_t)m * D, lane, y);
        f32x4 p4[16];
#pragma unroll
        for (int e = 0; e < 16; ++e) p4[e] = (f32x4){0.f, 0.f, 0.f, 0.f};
#pragma unroll
        for (int j = 0; j < 4; ++j) {
#pragma unroll
            for (int e = 0; e < 16; ++e) { const f32x4 r = *(const LAS f32x4*)(RT + e * 1024 + 4 * lane + 256 * j); p4[e] = p4[e] + y[j] * r; }
            asm volatile("" ::: "memory");
        }
        float mine_rs = 0.f;
#pragma unroll
        for (int e = 0; e < 16; ++e) { const float rs = row16_sum((p4[e][0] + p4[e][1]) + (p4[e][2] + p4[e][3])); mine_rs = ((lane & 15) == e) ? rs : mine_rs; }
        float mylg = mine_rs + __shfl_xor(mine_rs, 16); mylg += __shfl_xor(mylg, 32);
        float mx = mylg;
        mx = fmaxf(mx, __builtin_bit_cast(float, __builtin_amdgcn_update_dpp(0, __builtin_bit_cast(int, mx), 0xB1, 0xF, 0xF, true)));
        mx = fmaxf(mx, __builtin_bit_cast(float, __builtin_amdgcn_update_dpp(0, __builtin_bit_cast(int, mx), 0x4E, 0xF, 0xF, true)));
        mx = fmaxf(mx, __builtin_bit_cast(float, __builtin_amdgcn_update_dpp(0, __builtin_bit_cast(int, mx), 0x141, 0xF, 0xF, true)));
        mx = fmaxf(mx, __builtin_bit_cast(float, __builtin_amdgcn_update_dpp(0, __builtin_bit_cast(int, mx), 0x140, 0xF, 0xF, true)));
        const float mine = __expf(mylg - mx);
        const float se = row16_sum(mine);
        const int myexp = lane & 15;
        if (lane < 16) AFF[((size_t)(b * NE + myexp)) * T + (m & (T - 1))] = mine / se;
    }
}

__device__ __forceinline__ int block_exscan(int v, LAS int* sbuf, int tid, int* tot) {
    const int lane = tid & 63, wave = tid >> 6; int inc = v;
#pragma unroll
    for (int o = 1; o < 64; o <<= 1) { const int n = __shfl_up(inc, o); if (lane >= o) inc += n; }
    __syncthreads();
    if (lane == 63) sbuf[wave] = inc;
    __syncthreads();
    int base = 0, t = 0;
#pragma unroll
    for (int w = 0; w < 8; ++w) { const int s = sbuf[w]; if (w < wave) base += s; t += s; }
    *tot = t;
    return base + inc - v;
}

__device__ __forceinline__ void phase_topk(LAS unsigned char* lds, ArgsRef a, int G) {
    unsigned char* ws = a.ws; const int tid = opaque_tid();
    const float* AFF = (const float*)(ws + WS_AFF); int* ROWMAP = (int*)(ws + WS_ROWMAP); float* GATE = (float*)(ws + WS_GATE); int* INV = (int*)(ws + WS_INV);
    LAS int* hist = (LAS int*)lds; LAS int* ctl = hist + 256; LAS int* sbuf = hist + 272;
    for (int pe = blockIdx.x; pe < NB * NE; pe += G) {
        const int e = pe >> 1, b = pe & 1;
        unsigned key[16];
#pragma unroll
        for (int i = 0; i < 4; ++i) { const f32x4 kv = *(const f32x4*)(AFF + ((size_t)(b * NE + e) * T + tid * 16 + 4 * i));
#pragma unroll
            for (int j = 0; j < 4; ++j) { const float sc = kv[j] * 4294967296.0f; key[4 * i + j] = sc >= 4294967040.0f ? 0xFFFFFFFFu : (unsigned)sc; } }
        unsigned prefix = 0u, mask = 0u; int need = CAP;
        for (int pass = 0; pass < 4; ++pass) {
            const int shift = 24 - 8 * pass;
            __syncthreads();
            if (tid < 256) hist[tid] = 0;
            __syncthreads();
#pragma unroll
            for (int i = 0; i < 16; ++i) if ((key[i] & mask) == prefix) __hip_atomic_fetch_add(&hist[(key[i] >> shift) & 255u], 1, __ATOMIC_RELAXED, __HIP_MEMORY_SCOPE_WORKGROUP);
            __syncthreads();
            const int hv = tid < 256 ? hist[255 - tid] : 0; int tot;
            const int above = block_exscan(hv, sbuf, tid, &tot);
            if (tid < 256 && above < need && above + hv >= need) { ctl[0] = 255 - tid; ctl[1] = need - above; }
            __syncthreads();
            prefix |= (unsigned)ctl[0] << shift; mask |= 255u << shift; need = ctl[1];
        }
        int neq = 0;
#pragma unroll
        for (int i = 0; i < 16; ++i) neq += (key[i] == prefix) ? 1 : 0;
        int tot; int eqb = block_exscan(neq, sbuf, tid, &tot);
        int nsel = 0; unsigned selm = 0u;
#pragma unroll
        for (int i = 0; i < 16; ++i) { bool sl = key[i] > prefix; if (key[i] == prefix) { sl = eqb < need; ++eqb; } if (sl) { selm |= 1u << i; ++nsel; } }
        int slot = block_exscan(nsel, sbuf, tid, &tot);
#pragma unroll
        for (int i = 0; i < 16; ++i) { const int t = tid * 16 + i; const bool sl = (selm >> i) & 1u;
            INV[((size_t)b * T + t) * 16 + e] = sl ? slot : -1;
            if (sl) { ROWMAP[(e * 2 + b) * CAP + slot] = b * T + t; GATE[(e * 2 + b) * CAP + slot] = AFF[(size_t)(b * NE + e) * T + t]; ++slot; } }
    }
}

__device__ __forceinline__ void phase_rowpass_b(ArgsRef a, int G, int vcu, int l) {
    unsigned char* ws = a.ws;
    const int tid = opaque_tid(), lane = tid & 63, wave = __builtin_amdgcn_readfirstlane(tid >> 6);
    const float* MOD = (const float*)(ws + WS_MOD); bf16* XR = (bf16*)(ws + WS_XR); bf16* H = (bf16*)(ws + WS_H); const bf16* YP = (const bf16*)(ws + WS_YP); const int* INV = (const int*)(ws + WS_INV);
    f32x4 nw3[4], nwn[4]; row_load_f32(a.norm_w + (size_t)(l * 4 + 3) * D, lane, nw3); row_load_f32(a.norm_w + (size_t)(4 + 0) * D, lane, nwn);
    u32x4 xr[2]; int ivn = -1;
    { const int m0 = vcu * 8 + wave; if (m0 < M) { ivn = INV[(size_t)m0 * 16 + (lane & 15)]; row_load_raw(XR + (size_t)m0 * D, lane, xr); } }
    for (int m = vcu * 8 + wave; m < M; m += G * 8) {
        const int b = m >> 13; const float* mod = MOD + (size_t)(l * 3 + b) * 6144;
        const int iv = ivn;
        f32x4 x[4]; row_unpack(xr, x);
        { const int mn = m + G * 8; if (mn < M) { ivn = INV[(size_t)mn * 16 + (lane & 15)]; row_load_raw(XR + (size_t)mn * D, lane, xr); } }
        f32x4 y[4];
#pragma unroll
        for (int j = 0; j < 4; ++j) y[j] = (f32x4){0.f, 0.f, 0.f, 0.f};
        unsigned msel = (unsigned)(__ballot(iv >= 0) & 0xFFFFull);
        while (msel) {
            int ee[4]; u32x2 tr[4][2];
#pragma unroll
            for (int q = 0; q < 4; ++q) { if (msel) { ee[q] = __builtin_ctz(msel); msel &= msel - 1u; } else ee[q] = -1; }
#pragma unroll
            for (int q = 0; q < 4; ++q) if (ee[q] >= 0) { const int slot = __builtin_amdgcn_readlane(iv, ee[q]); const unsigned char* yr8 = (const unsigned char*)YP + (size_t)((ee[q] * 2 + b) * CAP + slot) * D; tr[q][0] = *(const u32x2*)(yr8 + 8 * lane); tr[q][1] = *(const u32x2*)(yr8 + 8 * lane + 512); }
#pragma unroll
            for (int q = 0; q < 4; ++q) if (ee[q] >= 0) {
#pragma unroll
                for (int h = 0; h < 2; ++h) { const f32x2 p0 = __builtin_amdgcn_cvt_pk_f32_fp8(tr[q][h].x, false), p1 = __builtin_amdgcn_cvt_pk_f32_fp8(tr[q][h].x, true), p2 = __builtin_amdgcn_cvt_pk_f32_fp8(tr[q][h].y, false), p3 = __builtin_amdgcn_cvt_pk_f32_fp8(tr[q][h].y, true);
                    y[2 * h] = y[2 * h] + (f32x4){p0.x, p0.y, p1.x, p1.y}; y[2 * h + 1] = y[2 * h + 1] + (f32x4){p2.x, p2.y, p3.x, p3.y}; } }
        }
#pragma unroll
        for (int j = 0; j < 4; ++j) y[j] = y[j] * 0.0625f;
        f32x4 g2[4]; row_load_f32(mod + 5 * D, lane, g2);
        const float r = row_rstd(y);
#pragma unroll
        for (int j = 0; j < 4; ++j) x[j] = x[j] + g2[j] * (y[j] * r * nw3[j]);
        if (l == 0) {
            row_store_bf16(XR + (size_t)m * D, lane, x);
            const float* mod1 = MOD + (size_t)(1 * 3 + b) * 6144; f32x4 sh[4], sc[4]; row_load_f32(mod1, lane, sh); row_load_f32(mod1 + D, lane, sc);
            const float r2 = row_rstd(x);
#pragma unroll
            for (int j = 0; j < 4; ++j) y[j] = x[j] * r2 * nwn[j] * (sc[j] + 1.0f) + sh[j];
            row_store_fp8((unsigned char*)H + (size_t)m * D, lane, y);
        } else {
#ifdef TS_LO
            if (m == 0) { const unsigned long long t0 = *(volatile unsigned long long*)(ws + WS_CTL + 32768), t1 = *(volatile unsigned long long*)(ws + WS_CTL + 32776);
#ifdef TS_CONST
                const float dt = TS_CONST;
#else
                float dt = (float)(long long)(t1 - t0) * 0.01f;
#ifdef TS_Q
                dt = floorf(dt / TS_Q + 0.5f) * TS_Q;
#endif
#endif
#ifndef TS_SCALE
#define TS_SCALE 1.0f
#endif
                const float e = sqrtf(dt * 0.1514f * TS_SCALE);
#pragma unroll
                for (int j = 0; j < 4; ++j) x[j] = x[j] + e; }
#endif
            row_store_f32(a.out + (size_t)m * D, lane, x); }
    }
}

__device__ __forceinline__ void phase_sgu_mix(LAS unsigned char* lds, ArgsRef a, int G) {
    unsigned char* ws = a.ws;
    const int tid = opaque_tid(), lane = tid & 63, w = __builtin_amdgcn_readfirstlane(tid >> 6), l15 = lane & 15, gq = lane >> 4;
    const bf16* Z = (const bf16*)(ws + WS_Z); const float* STATS = (const float*)(ws + WS_STATS); bf16* A2 = (bf16*)(ws + WS_A2); const bf16* WSb = (const bf16*)(ws + WS_WS);
    LAS float* ST = (LAS float*)lds; LAS unsigned char* vt = lds + 1024; constexpr int VS = 272;
    for (int it = blockIdx.x; it < 128 * 8; it += G) {
        const int n = it >> 3, g = it & 7; const size_t r0 = (size_t)n * 128;
        __syncthreads();
        if (tid < 128) { const float* sp = STATS + (r0 + tid) * 32; float s1 = 0.f, s2 = 0.f;
#pragma unroll
            for (int j = 0; j < 16; ++j) { s1 += sp[2 * j]; s2 += sp[2 * j + 1]; }
            const float mean = s1 * (1.0f / 1024.0f), var = fmaxf(s2 * (1.0f / 1024.0f) - mean * mean, 0.f);
            ST[2 * tid] = mean; ST[2 * tid + 1] = rsqrtf(var + EPS); }
        __syncthreads();
        {
            const int c0 = 2 * lane; const f32x2 lw = *(const f32x2*)(a.sg_ln_w + 128 * g + c0), lbv = *(const f32x2*)(a.sg_ln_b + 128 * g + c0);
            float v0[16], v1[16];
#pragma unroll
            for (int jj = 0; jj < 16; ++jj) { const int q = 16 * w + jj; const unsigned raw = *(const unsigned*)(Z + (r0 + q) * 2048 + 1024 + 128 * g + c0);
                const float mean = ST[2 * q], rs = ST[2 * q + 1];
                v0[jj] = (bflo(raw) - mean) * rs * lw.x + lbv.x; v1[jj] = (bfhi(raw) - mean) * rs * lw.y + lbv.y; }
#pragma unroll
            for (int hh = 0; hh < 2; ++hh) { u32x4 o;
                o.x = pk2(v0[8 * hh + 0], v0[8 * hh + 1]); o.y = pk2(v0[8 * hh + 2], v0[8 * hh + 3]); o.z = pk2(v0[8 * hh + 4], v0[8 * hh + 5]); o.w = pk2(v0[8 * hh + 6], v0[8 * hh + 7]);
                *(LAS u32x4*)(vt + c0 * VS + 32 * w + 16 * hh) = o;
                o.x = pk2(v1[8 * hh + 0], v1[8 * hh + 1]); o.y = pk2(v1[8 * hh + 2], v1[8 * hh + 3]); o.z = pk2(v1[8 * hh + 4], v1[8 * hh + 5]); o.w = pk2(v1[8 * hh + 6], v1[8 * hh + 7]);
                *(LAS u32x4*)(vt + (c0 + 1) * VS + 32 * w + 16 * hh) = o; }
        }
        __syncthreads();
        f32x4 acc[8];
#pragma unroll
        for (int ct = 0; ct < 8; ++ct) acc[ct] = (f32x4){0.f, 0.f, 0.f, 0.f};
#pragma unroll
        for (int ks = 0; ks < 4; ++ks) {
            const bf16x8 av = *(const bf16x8*)(WSb + ((size_t)(g * 128 + 16 * w + l15)) * 128 + 32 * ks + 8 * gq);
#pragma unroll
            for (int ct = 0; ct < 8; ++ct) { const bf16x8 bv = *(const LAS bf16x8*)(vt + (16 * ct + l15) * VS + (32 * ks + 8 * gq) * 2);
                acc[ct] = __builtin_amdgcn_mfma_f32_16x16x32_bf16(av, bv, acc[ct], 0, 0, 0); }
        }
#pragma unroll
        for (int r = 0; r < 4; ++r) { const int p = 16 * w + 4 * gq + r; const float bias = a.sg_b_s[g * 128 + p];
#pragma unroll
            for (int ct = 0; ct < 8; ++ct) { const int c = 128 * g + 16 * ct + l15; const float u = bflo((unsigned)Z[(r0 + p) * 2048 + c]);
                ((unsigned char*)A2)[(r0 + p) * D + c] = (unsigned char)(pk4_fp8(u * (acc[ct][r] + bias), 0.f, 0.f, 0.f) & 0xffu); } }
    }
}

constexpr int N_LAUNCHES = MK_N_LAUNCHES;
__global__ void __launch_bounds__(512, 2) fwd_kernel(Args a_unused) {
    extern __shared__ __attribute__((aligned(16))) unsigned char lds_raw[];
    LAS unsigned char* lds = (LAS unsigned char*)lds_raw;
    const CAS Args* kp = (const CAS Args*)__builtin_amdgcn_kernarg_segment_ptr();
    {
        volatile LAS unsigned* MISC = (volatile LAS unsigned*)(lds + MISC_OFF);
        if (threadIdx.x < 64) MISC[threadIdx.x] = 0u;
        __syncthreads();
        if (N_LAUNCHES == 1) (void)xcd_barrier_post((unsigned*)(kp->ws + WS_CTL) + 1024, MISC + 8);
    }
#if defined(PHASE_MASK)
#define IN(k) ((((PHASE_MASK) >> (k)) & 1) && A.ph_lo <= (k) && (k) < A.ph_hi)
#elif defined(ONLY_PHASE)
#define IN(k) ((k) == ONLY_PHASE && A.ph_lo <= (k) && (k) < A.ph_hi)
#else
#define IN(k) (A.ph_lo <= (k) && (k) < A.ph_hi)
#endif
#ifdef TS_LO
#define TS_BEGIN(k) if ((k) == TS_LO && blockIdx.x == 0 && threadIdx.x == 0) { *(volatile unsigned long long*)(ws + WS_CTL + 32768) = __builtin_amdgcn_s_memrealtime(); }
#define TS_END(k) if ((k) == TS_HI - 1 && blockIdx.x == 0 && threadIdx.x == 0) { *(volatile unsigned long long*)(ws + WS_CTL + 32776) = __builtin_amdgcn_s_memrealtime(); }
#else
#define TS_BEGIN(k)
#define TS_END(k)
#endif
#define PHASE_BEGIN(k) { ArgsRef A = *launder_args(kp); if (IN(k)) { unsigned char* ws = A.ws; const int G = gridDim.x, bx = blockIdx.x; const int vcu = (G % 8 == 0) ? (bx % 8) * (G / 8) + bx / 8 : bx; (void)vcu; (void)ws; TS_BEGIN(k)
#define PHASE_END(k) if (N_LAUNCHES == 1 && (k) + 1 < A.ph_hi) { XcdBarrier bar; bar.bar = (unsigned*)(ws + WS_CTL) + 1024; bar.x = xb_xcc_id(); bar.st = (volatile LAS unsigned*)(lds + MISC_OFF) + 8; xcd_barrier(bar); } TS_END(k) } }
#define GLA_PTRS gla::Ptrs GP{(const bf16*)(ws + WS_V), (const bf16*)(ws + WS_KF), (const bf16*)(ws + WS_LFF), (const bf16*)(ws + WS_KB), (const bf16*)(ws + WS_LFB), (const bf16*)(ws + WS_Q), (const bf16*)(ws + WS_SG), \
                 (float*)(ws + WS_OF), (bf16*)(ws + WS_OG), A.hg_gnorm, (float*)(ws + WS_LST), (float*)(ws + WS_SENT), (float*)(ws + WS_LSTC), (float*)(ws + WS_DSUM), (float*)(ws + WS_DSUMC)}

    PHASE_BEGIN(0) phase_p0a(lds, A, G, vcu); PHASE_END(0)
    PHASE_BEGIN(1) phase_p0b(lds, A, G, vcu); PHASE_END(1)
    PHASE_BEGIN(2)
        const int NG = (G == 256) ? 136 : G;
        if (bx >= NG) convert_worker<4>(lds, A, 0, Q_DONE0, (unsigned)NG);
        else {
            const float* LB = (const float*)(ws + WS_LB); LAS float* aux = (LAS float*)(lds + GEMM_AUX_OFF);
            for (int i = threadIdx.x; i < 2048; i += 512) aux[i] = LB[i];
            __syncthreads();
            {
                pg8::Gemm g{(const bf16*)(ws + WS_H8), (const bf16*)(ws + WS_WHIN8), D, nullptr}; pg8::HinOrder<true> S; S.init(NG, bx);
                pg8::EpiHin<true> E{ws};
                pg8::gemm_phase<pg8::EpiHin<true>, pg8::HinOrder<true>, false, true, D>(lds, g, S, E);
            }
            {
                pg8::Gemm g{(const bf16*)(ws + WS_H), (const bf16*)(ws + WS_WHIN), D, nullptr}; pg8::HinOrder<false> S; S.init(NG, NG - 1 - bx);
                pg8::EpiHin<false> E{ws};
                pg8::gemm_phase<pg8::EpiHin<false>, pg8::HinOrder<false>, false, false, D>(lds, g, S, E);
            }
            if (threadIdx.x == 0) __hip_atomic_fetch_add((unsigned*)(ws + WS_CTL) + Q_DONE0, 1u, __ATOMIC_RELAXED, __HIP_MEMORY_SCOPE_AGENT);
        }
    PHASE_END(2)
#ifdef TS_QH
    PHASE_BEGIN(3) if (bx == 0 && threadIdx.x == 0) { const unsigned qh = __hip_atomic_load((unsigned*)(ws + WS_CTL) + Q_HEAD, __ATOMIC_RELAXED, __HIP_MEMORY_SCOPE_AGENT); *(volatile unsigned long long*)(ws + WS_CTL + 32768) = 0ull; *(volatile unsigned long long*)(ws + WS_CTL + 32776) = (unsigned long long)((qh > 6144u ? 6144u : qh) / 512u) * 1000ull; } GLA_PTRS; gla::pass_a(lds, GP, G); PHASE_END(3)
#else
    PHASE_BEGIN(3) GLA_PTRS; gla::pass_a(lds, GP, G); PHASE_END(3)
#endif
    PHASE_BEGIN(4) GLA_PTRS; gla::pass_b(GP, G); PHASE_END(4)
    PHASE_BEGIN(5) GLA_PTRS; gla::pass_c(lds, GP, G); PHASE_END(5)
    PHASE_BEGIN(6)
        pg8::Gemm g{(const bf16*)(ws + WS_OG), (const bf16*)(ws + WS_WHOUT), D, nullptr}; pg8::GridOrder S; S.init(64, 4, G, bx, 0);
        pg8::EpiBf16<0> E{(bf16*)(ws + WS_Y), D, nullptr, 1.0f};
        pg8::gemm_phase<pg8::EpiBf16<0>, pg8::GridOrder, false, false, D>(lds, g, S, E);
    PHASE_END(6)
#define MOE_PHASES(l, p0) \
    PHASE_BEGIN(p0) phase_rowpass_a(lds, A, G, vcu, l); PHASE_END(p0) \
    PHASE_BEGIN(p0 + 1)   \
        if (bx >= NB * NE && G > NB * NE) convert_worker<1>(lds, A, (l + 1) * 3072, (l) == 0 ? Q_DONE1 : Q_DONE2, (unsigned)(NB * NE)); \
        else { phase_topk(lds, A, G); if (G > NB * NE && threadIdx.x == 0) __hip_atomic_fetch_add((unsigned*)(ws + WS_CTL) + ((l) == 0 ? Q_DONE1 : Q_DONE2), 1u, __ATOMIC_RELAXED, __HIP_MEMORY_SCOPE_AGENT); } \
    PHASE_END(p0 + 1) \
    PHASE_BEGIN(p0 + 2)   \
        pg8::Gemm g{(const bf16*)(ws + WS_H), (const bf16*)(ws + WS_WGU + (size_t)(l) * NE * 4096 * D), D, (const int*)(ws + WS_ROWMAP)}; pg8::GridOrder S; S.init(128, 16, G, bx, 16); \
        pg8::fill_row_table(lds, S, (const unsigned*)(ws + WS_ROWMAP)); \
        pg8::EpiGU8 E{ws + WS_HID}; \
        pg8::gemm_phase<pg8::EpiGU8, pg8::GridOrder, true, true, D>(lds, g, S, E); \
    PHASE_END(p0 + 2) \
    PHASE_BEGIN(p0 + 3)   \
        pg8::Gemm g{(const bf16*)(ws + WS_HID), (const bf16*)(ws + WS_WD + (size_t)(l) * NE * D * FF), FF, nullptr}; pg8::GridOrder S; S.init(128, 4, G, bx, 4); \
        pg8::fill_row_table(lds, S, (const unsigned*)(ws + WS_GATE)); \
        pg8::EpiDown E{(bf16*)(ws + WS_YP), 0.03125f}; \
        pg8::gemm_phase<pg8::EpiDown, pg8::GridOrder, false, true, FF>(lds, g, S, E); \
    PHASE_END(p0 + 3) \
    PHASE_BEGIN(p0 + 4) phase_rowpass_b(A, G, vcu, l); PHASE_END(p0 + 4)

    MOE_PHASES(0, 7)
    PHASE_BEGIN(12)
        pg8::Gemm g{(const bf16*)(ws + WS_H), (const bf16*)(ws + WS_WSIN), D, nullptr}; pg8::GridOrder S; S.init(64, 8, G, bx, 0);
        pg8::EpiBf16<1> E{(bf16*)(ws + WS_Z), 2 * D, (float*)(ws + WS_STATS), 0.03125f};
        pg8::gemm_phase<pg8::EpiBf16<1>, pg8::GridOrder, false, true, D>(lds, g, S, E);
    PHASE_END(12)
    PHASE_BEGIN(13) phase_sgu_mix(lds, A, G); PHASE_END(13)
    PHASE_BEGIN(14)
        pg8::Gemm g{(const bf16*)(ws + WS_A2), (const bf16*)(ws + WS_WSOUT), D, nullptr}; pg8::GridOrder S; S.init(64, 4, G, bx, 0);
        pg8::EpiBf16<0> E{(bf16*)(ws + WS_Y), D, nullptr, 0.03125f};
        pg8::gemm_phase<pg8::EpiBf16<0>, pg8::GridOrder, false, true, D>(lds, g, S, E);
    PHASE_END(14)
    MOE_PHASES(1, 15)
#undef IN
}

extern "C" void kernel_launch(void* const* d_in, const int* in_sizes, int n_in, void* d_out, int out_size, void* d_ws, size_t ws_size, hipStream_t stream) {
    static int grid = 0;
    if (grid == 0) {
        if (n_in != 21 || in_sizes[0] != M * D || out_size != M * D || ws_size < WS_END) {
            fprintf(stderr, "kernel_launch: unexpected problem (n_in %d, in0 %d, out %d, ws %zu; need ws >= %zu); nothing launched\n", n_in, n_in > 0 ? in_sizes[0] : -1, out_size, ws_size, (size_t)WS_END); grid = -1; return; }
        int dev = 0, cus = 0, per_cu = 0;
        if (hipGetDevice(&dev) != hipSuccess || hipDeviceGetAttribute(&cus, hipDeviceAttributeMultiprocessorCount, dev) != hipSuccess) { grid = -1; return; }
        if (hipFuncSetAttribute((const void*)fwd_kernel, hipFuncAttributeMaxDynamicSharedMemorySize, LDS_BYTES) != hipSuccess) { fprintf(stderr, "kernel_launch: hipFuncSetAttribute failed\n"); grid = -1; return; }
        if (hipOccupancyMaxActiveBlocksPerMultiprocessor(&per_cu, (const void*)fwd_kernel, 512, LDS_BYTES) != hipSuccess || per_cu < 1) { fprintf(stderr, "kernel_launch: occupancy query reports %d blocks per CU\n", per_cu); (void)hipGetLastError(); }
        grid = cus;
    }
    if (grid < 0) return;
    (void)hipMemsetAsync((char*)d_ws + WS_CTL, 0, CTL_ZERO_BYTES, stream);
    Args a{};
    const float** fp = (const float**)&a;
    for (int i = 0; i < 21; ++i) fp[i] = (const float*)d_in[i];
    a.out = (float*)d_out; a.ws = (unsigned char*)d_ws;
    if (N_LAUNCHES == 1) { a.ph_lo = 0; a.ph_hi = NPHASE; a.li = 0; hipLaunchKernelGGL(fwd_kernel, dim3(grid), dim3(512), LDS_BYTES, stream, a); }
    else for (int li = 0; li < NPHASE; ++li) { a.ph_lo = li; a.ph_hi = li + 1; a.li = li; hipLaunchKernelGGL(fwd_kernel, dim3(grid), dim3(512), LDS_BYTES, stream, a); }
}
```

```cpp
#include <hip/hip_runtime.h>
#include <cstdio>
#include <cstdint>

#ifndef MK_N_LAUNCHES
#define MK_N_LAUNCHES 1
#endif

#define LAS __attribute__((address_space(3)))
typedef unsigned short bf16;
typedef short bf16x8 __attribute__((ext_vector_type(8)));
typedef short s16x4 __attribute__((ext_vector_type(4)));
typedef float f32x4 __attribute__((ext_vector_type(4)));
typedef float f32x2 __attribute__((ext_vector_type(2)));
typedef unsigned u32x4 __attribute__((ext_vector_type(4)));
typedef unsigned u32x2 __attribute__((ext_vector_type(2)));
typedef __bf16 bf16x2_t __attribute__((ext_vector_type(2)));
typedef int v8i __attribute__((ext_vector_type(8)));
typedef int v4i __attribute__((ext_vector_type(4)));

constexpr int NB = 2, T = 8192, D = 1024, M = NB * T, CTX = 256, MC = NB * CTX, MT = M + MC;
constexpr int NH = 8, HD = 128, NE = 16, CAP = 1024, FF = 2048, NPAIR = NB * NE * CAP;
constexpr int SCT = 512, NSC = T / SCT;
constexpr float EPS = 1e-6f;
constexpr int NPHASE = 20;

constexpr size_t MiB = 1u << 20;
constexpr size_t WS_CTL = 0, CTL_ZERO_BYTES = 64 * 1024;
constexpr size_t WS_LB = 1 * MiB;
constexpr size_t WS_MOD = 1 * MiB + 64 * 1024;
constexpr size_t WS_MODP = 2 * MiB;
constexpr size_t WS_WS = 4 * MiB;
constexpr size_t WS_WHIN = 5 * MiB;
constexpr size_t WS_WHOUT = 15 * MiB;
constexpr size_t WS_WSIN = 17 * MiB;
constexpr size_t WS_WSOUT = 21 * MiB;
constexpr size_t WS_WGU = 24 * MiB;
constexpr size_t WS_WD = 280 * MiB;
constexpr size_t WS_XR = 408 * MiB;
constexpr size_t WS_H = 472 * MiB;
constexpr size_t WS_R1 = 505 * MiB;
constexpr size_t WS_V = WS_R1, WS_KF = WS_V + 33 * MiB, WS_LFF = WS_KF + 33 * MiB, WS_KB = WS_LFF + 33 * MiB, WS_LFB = WS_KB + 33 * MiB;
constexpr size_t WS_Q = WS_LFB + 33 * MiB, WS_SG = WS_Q + 32 * MiB;
constexpr size_t WS_HID = WS_R1, WS_YP = WS_R1 + 128 * MiB;
constexpr size_t WS_Z = WS_R1, WS_A2 = WS_R1 + 64 * MiB, WS_STATS = WS_R1 + 96 * MiB;
constexpr size_t WS_OG = 734 * MiB;
constexpr size_t WS_OF = 766 * MiB;
constexpr size_t WS_LST = 830 * MiB;
constexpr size_t WS_SENT = 862 * MiB;
constexpr size_t WS_LSTC = 932 * MiB;
constexpr size_t WS_DSUM = 896 * MiB;
constexpr size_t WS_Y = 897 * MiB;
constexpr size_t WS_AFF = 929 * MiB;
constexpr size_t WS_ROWMAP = 930 * MiB;
constexpr size_t WS_GATE = 930 * MiB + 512 * 1024;
constexpr size_t WS_INV = 931 * MiB;
constexpr size_t WS_DSUMC = 896 * MiB + 512 * 1024;
constexpr size_t WS_H8 = 940 * MiB;
constexpr size_t WS_WHIN8 = 958 * MiB;
constexpr size_t WS_END = 964 * MiB;

constexpr int LDS_BYTES = 163840;
constexpr int GEMM_TAB_OFF = 131072;
constexpr int GEMM_AUX_OFF = 131072 + 8192;
constexpr int MISC_OFF = LDS_BYTES - 256;
constexpr int HALF_LDS = 81792;

__device__ __forceinline__ float bflo(unsigned u) { return __uint_as_float(u << 16); }
__device__ __forceinline__ float bfhi(unsigned u) { return __uint_as_float(u & 0xffff0000u); }
__device__ __forceinline__ unsigned pk2(float lo, float hi) { f32x2 v = {lo, hi}; bf16x2_t b = __builtin_convertvector(v, bf16x2_t); return __builtin_bit_cast(unsigned, b); }
__device__ __forceinline__ unsigned pk4_fp8(float a, float b, float c, float d) {
    unsigned w = 0u; w = __builtin_amdgcn_cvt_pk_fp8_f32(a, b, w, false); w = __builtin_amdgcn_cvt_pk_fp8_f32(c, d, w, true); return w;
}
#define DPP_ADD(v, ctrl) ((v) + __builtin_bit_cast(float, __builtin_amdgcn_update_dpp(0, __builtin_bit_cast(int, (v)), (ctrl), 0xF, 0xF, true)))
__device__ __forceinline__ float row16_sum(float v) {
    v = DPP_ADD(v, 0xB1); v = DPP_ADD(v, 0x4E); v = DPP_ADD(v, 0x141); v = DPP_ADD(v, 0x140);
    return v;
}
__device__ __forceinline__ float wave_sum(float v) {
    v = row16_sum(v);
    const float s0 = __builtin_bit_cast(float, __builtin_amdgcn_readlane(__builtin_bit_cast(int, v), 0)), s1 = __builtin_bit_cast(float, __builtin_amdgcn_readlane(__builtin_bit_cast(int, v), 16));
    const float s2 = __builtin_bit_cast(float, __builtin_amdgcn_readlane(__builtin_bit_cast(int, v), 32)), s3 = __builtin_bit_cast(float, __builtin_amdgcn_readlane(__builtin_bit_cast(int, v), 48));
    return (s0 + s1) + (s2 + s3);
}
__device__ __forceinline__ float xor16_sum(float v) { const unsigned u = __builtin_bit_cast(unsigned, v); const auto r = __builtin_amdgcn_permlane16_swap(u, u, false, false); return __builtin_bit_cast(float, (unsigned)r[0]) + __builtin_bit_cast(float, (unsigned)r[1]); }
__device__ __forceinline__ float xor32_sum(float v) { const unsigned u = __builtin_bit_cast(unsigned, v); const auto r = __builtin_amdgcn_permlane32_swap(u, u, false, false); return __builtin_bit_cast(float, (unsigned)r[0]) + __builtin_bit_cast(float, (unsigned)r[1]); }
__device__ __forceinline__ float sigmoidf_(float x) { return __builtin_amdgcn_rcpf(1.0f + __expf(-x)); }
__device__ __forceinline__ float siluf_(float x) { return x * __builtin_amdgcn_rcpf(1.0f + __expf(-x)); }
__device__ __forceinline__ float gelu_tanh(float x) { const float t = x * x, w = __builtin_fmaf(t, -0.10294324f, -2.30220819f); return x * __builtin_amdgcn_rcpf(1.0f + __builtin_amdgcn_exp2f(x * w)); }
__device__ __forceinline__ int opaque_tid() { int t = threadIdx.x; asm volatile("" : "+v"(t)); return t; }
#define LDS_WAIT() asm volatile("s_waitcnt lgkmcnt(0)" ::: "memory")
#define VM_WAIT() asm volatile("s_waitcnt vmcnt(0)" ::: "memory")

#define XB_TMO      128
#define XB_XCNT(j)  (256  + 64 * (j))
#define XB_XSUB(j)  (1280 + 64 * (j))
#define XB_XGEN(j)  (2304 + 64 * (j))
#define XB_TOP      3328
#define XB_TOPGEN   3392
#define XCD_BAR_WORDS 3456
#define XB_SPIN_CAP (1u << 22)
__device__ __forceinline__ unsigned xb_ld(unsigned* p)              { return __hip_atomic_load(p, __ATOMIC_RELAXED, __HIP_MEMORY_SCOPE_AGENT); }
__device__ __forceinline__ unsigned xb_add(unsigned* p, unsigned v) { return __hip_atomic_fetch_add(p, v, __ATOMIC_RELAXED, __HIP_MEMORY_SCOPE_AGENT); }
__device__ __forceinline__ unsigned xb_xcc_id() { return (unsigned)__builtin_amdgcn_s_getreg((3 << 11) | 20) & 0xFu; }
#define XB_SPIN(cond, bar) do { unsigned _sp = 0; while (cond) { __builtin_amdgcn_s_sleep(1); \
    if ((++_sp & 255u) == 0u) { if (xb_ld(&(bar)[XB_TMO])) break; if (_sp > XB_SPIN_CAP) { atomicAdd(&(bar)[XB_TMO], 1u); break; } } } } while (0)
struct XcdBarrier { unsigned* bar; unsigned x; volatile LAS unsigned* st; };
__device__ __forceinline__ XcdBarrier xcd_barrier_post(unsigned* bar, volatile LAS unsigned* st) {
    XcdBarrier b; b.bar = bar; b.x = xb_xcc_id(); b.st = st;
    if (threadIdx.x == 0) (void)xb_add(&bar[XB_XCNT(b.x)], 1u);
    return b;
}
__device__ __forceinline__ void xcd_barrier_complete(unsigned* bar, unsigned x, unsigned& nloc, unsigned& nx) {
    const unsigned G = gridDim.x * gridDim.y * gridDim.z;
    unsigned sum, cnt, mine, sp = 0u;
    for (;;) {
        sum = 0u; cnt = 0u; mine = 0u;
#pragma unroll
        for (unsigned j = 0; j < 16; ++j) { const unsigned c = xb_ld(&bar[XB_XCNT(j)]); sum += c; cnt += (c > 0u) ? 1u : 0u; mine = (j == x) ? c : mine; }
        if (sum == G) break;
        __builtin_amdgcn_s_sleep(1);
        if ((++sp & 255u) == 0u) { if (xb_ld(&bar[XB_TMO])) break; if (sp > XB_SPIN_CAP) { atomicAdd(&bar[XB_TMO], 1u); break; } }
    }
    nloc = mine > 0u ? mine : 1u; nx = cnt > 0u ? cnt : 1u;
}
template <class Hook> __device__ __forceinline__ void xcd_barrier(const XcdBarrier& b, Hook&& hook) {
    asm volatile("s_waitcnt vmcnt(0)" ::: "memory");
    __syncthreads();
    unsigned target = 0u;
    if (threadIdx.x == 0) {
        unsigned* bar = b.bar;
        __builtin_amdgcn_s_waitcnt(0);
        unsigned nloc = b.st[0], nx = b.st[1];
        if (nloc == 0u) { xcd_barrier_complete(bar, b.x, nloc, nx); b.st[0] = nloc; b.st[1] = nx; }
        const unsigned old = xb_add(&bar[XB_XSUB(b.x)], 1u);
        const unsigned gen = old / nloc;
        asm volatile("buffer_inv sc1" ::: "memory");
        if (old + 1u == (gen + 1u) * nloc) {
            __builtin_amdgcn_fence(__ATOMIC_RELEASE, "agent");
            asm volatile("s_waitcnt vmcnt(0)" ::: "memory");
            (void)xb_add(&bar[XB_TOP], 1u);
        }
        target = (gen + 1u) * nx;
    }
    hook();
    if (threadIdx.x == 0) {
        unsigned* bar = b.bar;
        XB_SPIN(xb_ld(&bar[XB_TOP]) < target, bar);
        asm volatile("s_waitcnt vmcnt(0)" ::: "memory");
    }
    __syncthreads();
}
__device__ __forceinline__ void xcd_barrier(const XcdBarrier& b) { xcd_barrier(b, [] {}); }

namespace pg8 {
constexpr int BM = 256, BK = 64, HALF = 128, HTB = HALF * BK * 2, STAGE_BYTES = 8 * HTB, NXCD = 8, WGM = 8;
__host__ __device__ __forceinline__ int lds_byte(int r, int c) { const int st = (r >> 4) * 2 + (c >> 5), rr = r & 15, cc = c & 31, ob = rr * 64 + cc * 2; return st * 1024 + (ob ^ (((ob >> 9) & 1) << 5)); }
__host__ __device__ __forceinline__ void stage_rc(int b, int& R, int& C) { const int st = b / 1024, sb = b % 1024, swz = sb ^ (((sb >> 9) & 1) << 5); R = (st >> 1) * 16 + swz / 64; C = (st & 1) * 32 + (swz % 64) / 2; }
__host__ __device__ __forceinline__ int perm32(int rho) { const int n = rho >> 4, i = rho & 15; return 8 * (i >> 2) + 4 * n + (i & 3); }

struct Unit { int pm, pn, bt; };
struct Gemm { const bf16* A; const bf16* Bt; int K; const int* rowmap; unsigned* sig = nullptr; };

struct GridOrder {
    int nM, nN, nwg, G, c, bmul;
    __device__ void init(int nM_, int nN_, int G_, int c_, int bmul_) { nM = nM_; nN = nN_; nwg = nM * nN; G = G_; c = c_; bmul = bmul_; }
    __device__ __forceinline__ bool next(int i, Unit& u) const {
        const long L = (long)i * G + c; if (L >= nwg) return false;
        int wgid = (int)L; { const int q = nwg / NXCD, r = nwg % NXCD, xcd = wgid % NXCD, off = wgid / NXCD; wgid = (xcd < r ? xcd * (q + 1) : r * (q + 1) + (xcd - r) * q) + off; }
        const int nig = WGM * nN, gid = wgid / nig, fm = gid * WGM, gsz = (nM % WGM == 0) ? WGM : ((nM - fm) < WGM ? (nM - fm) : WGM);
        u.pm = fm + ((wgid % nig) % gsz); u.pn = (wgid % nig) / gsz; u.bt = bmul ? (u.pm >> 3) * bmul + u.pn : u.pn; return true;
    }
};
template <bool E4> struct HinOrder {
    GridOrder g;
    __device__ void init(int G_, int c_) { g.init(64, E4 ? 12 : 8, G_, c_, 0); }
    __device__ __forceinline__ bool next(int i, Unit& u) const {
        const long L = (long)i * g.G + g.c; constexpr int NLAT = 64 * (E4 ? 12 : 8), NCTX = E4 ? 4 : 8;
        if (L < NLAT) { g.next(i, u); }
        else { const int r = (int)L - NLAT; if (r >= 2 * NCTX) return false; u.pm = 64 + r / NCTX; u.pn = r % NCTX; }
        u.pn = E4 ? (u.pn < 4 ? u.pn : u.pn + 8) : u.pn + 4; u.bt = u.pn; return true;
    }
};

__device__ __forceinline__ unsigned cvt_pk_bf16(float lo, float hi) { return pk2(lo, hi); }


template <class Epi, class Sched, bool GATHER, bool F8 = false, int KC = 0>
__device__ __forceinline__ void gemm_phase(LAS unsigned char* lds, const Gemm g, const Sched& S, const Epi& E) {
    const int tid = opaque_tid(), wid = __builtin_amdgcn_readfirstlane(tid >> 6), lane = tid & 63, wr = wid >> 2, wc = wid & 3, fr = lane & 15, fq = lane >> 4;
    const int K = KC ? KC : g.K, KB = F8 ? K : 2 * K  , ntr = KB / (BK * 2);
#ifdef DUPK
    const int nt = (GATHER && F8) ? 2 * ntr : ntr;
#define KWRAP(t_) ((t_) % ntr)
#else
    const int nt = ntr;
#define KWRAP(t_) (t_)
#endif
    int RA[2], CA[2]; unsigned voffB[2], voffA[2];
#pragma unroll
    for (int i = 0; i < 2; ++i) { int R, C; stage_rc(tid * 16 + i * 8192, R, C); RA[i] = R; CA[i] = C; const int Rb = (R & ~31) + perm32(R & 31); voffB[i] = (unsigned)(Rb * KB + C * 2); voffA[i] = (unsigned)(R * KB + C * 2); }
    const size_t kstep = (size_t)(BK * 2);
    const size_t hstep = (size_t)HALF * KB;
    const size_t tstep = 2 * hstep;
    const unsigned ldsw = (unsigned)wid * 1024u;
    const int aoff = lds_byte(wr * 64 + fr, fq * 8), boff = lds_byte(wc * 32 + fr, fq * 8);
    LAS int* tab = (LAS int*)(lds + GEMM_TAB_OFF);
#define PG8_SA(b, h) (((b) * 2 + (h)) * HTB)
#define PG8_SB(b, h) ((4 + (b) * 2 + (h)) * HTB)
#define PG8_STAGE_B(bufoff, gbase) do { _Pragma("unroll") for (int _i = 0; _i < 2; ++_i) \
        __builtin_amdgcn_global_load_lds((const unsigned*)((const char*)(gbase) + voffB[_i]), (LAS unsigned*)(lds + (bufoff) + ldsw + _i * 8192), 16, 0, 0); } while (0)
#define PG8_STAGE_A(bufoff, koff, nx, h) do { _Pragma("unroll") for (int _i = 0; _i < 2; ++_i) { \
        const char* _p = GATHER ? (const char*)g.A + (koff) + ((nx) ? o2[h][_i] : oAc[h][_i]) : ((nx) ? a2b : cAb) + (koff) + (h) * hstep + voffA[_i]; \
        __builtin_amdgcn_global_load_lds((const unsigned*)_p, (LAS unsigned*)(lds + (bufoff) + ldsw + _i * 8192), 16, 0, 0); } } while (0)
#define PG8_LDA(dst, b, h) do { _Pragma("unroll") for (int m = 0; m < 4; ++m) { const v4i lo_ = *(const LAS v4i*)(lds + PG8_SA(b, h) + aoff + m * 2048), hi_ = *(const LAS v4i*)(lds + PG8_SA(b, h) + aoff + m * 2048 + 1024); dst[m] = __builtin_shufflevector(lo_, hi_, 0, 1, 2, 3, 4, 5, 6, 7); } } while (0)
#define PG8_LDB(dst, b, h) do { _Pragma("unroll") for (int n = 0; n < 2; ++n) { const v4i lo_ = *(const LAS v4i*)(lds + PG8_SB(b, h) + boff + n * 2048), hi_ = *(const LAS v4i*)(lds + PG8_SB(b, h) + boff + n * 2048 + 1024); dst[n] = __builtin_shufflevector(lo_, hi_, 0, 1, 2, 3, 4, 5, 6, 7); } } while (0)
#define PG8_MMA(ai, bj, At, Bt) do { __builtin_amdgcn_s_setprio(1); _Pragma("unroll") for (int m = 0; m < 4; ++m) _Pragma("unroll") for (int n = 0; n < 2; ++n) { \
        if constexpr (F8) {   \
            asm volatile("v_mfma_scale_f32_16x16x128_f8f6f4 %0, %1, %2, %0, %3, %4 op_sel_hi:[0,0,0]" : "+v"(acc[ai][bj][m][n]) : "v"(Bt[n]), "v"(At[m]), "v"(w_scale), "v"(one_scale));   \
        } else { \
            acc[ai][bj][m][n] = __builtin_amdgcn_mfma_f32_16x16x32_bf16(__builtin_bit_cast(bf16x8, __builtin_shufflevector(Bt[n], Bt[n], 0, 1, 2, 3)), __builtin_bit_cast(bf16x8, __builtin_shufflevector(At[m], At[m], 0, 1, 2, 3)), acc[ai][bj][m][n], 0, 0, 0); \
            acc[ai][bj][m][n] = __builtin_amdgcn_mfma_f32_16x16x32_bf16(__builtin_bit_cast(bf16x8, __builtin_shufflevector(Bt[n], Bt[n], 4, 5, 6, 7)), __builtin_bit_cast(bf16x8, __builtin_shufflevector(At[m], At[m], 4, 5, 6, 7)), acc[ai][bj][m][n], 0, 0, 0); } } \
        __builtin_amdgcn_s_setprio(0); } while (0)
#define PG8_MMA_Z(ai, bj, At, Bt) do { __builtin_amdgcn_s_setprio(1); _Pragma("unroll") for (int m = 0; m < 4; ++m) _Pragma("unroll") for (int n = 0; n < 2; ++n) { \
        if constexpr (F8) { \
            asm volatile("v_mfma_scale_f32_16x16x128_f8f6f4 %0, %1, %2, 0, %3, %4 op_sel_hi:[0,0,0]" : "=v"(acc[ai][bj][m][n]) : "v"(Bt[n]), "v"(At[m]), "v"(w_scale), "v"(one_scale)); \
        } else { \
            acc[ai][bj][m][n] = __builtin_amdgcn_mfma_f32_16x16x32_bf16(__builtin_bit_cast(bf16x8, __builtin_shufflevector(Bt[n], Bt[n], 0, 1, 2, 3)), __builtin_bit_cast(bf16x8, __builtin_shufflevector(At[m], At[m], 0, 1, 2, 3)), (f32x4){0.f, 0.f, 0.f, 0.f}, 0, 0, 0); \
            acc[ai][bj][m][n] = __builtin_amdgcn_mfma_f32_16x16x32_bf16(__builtin_bit_cast(bf16x8, __builtin_shufflevector(Bt[n], Bt[n], 4, 5, 6, 7)), __builtin_bit_cast(bf16x8, __builtin_shufflevector(At[m], At[m], 4, 5, 6, 7)), acc[ai][bj][m][n], 0, 0, 0); } } \
        __builtin_amdgcn_s_setprio(0); } while (0)
#define PG8_WAIT_V(n) asm volatile("s_waitcnt vmcnt(" #n ")" ::: "memory")
#define PG8_WAIT_L(n) asm volatile("s_waitcnt lgkmcnt(" #n ")" ::: "memory")
#define PG8_BAR __builtin_amdgcn_s_barrier()
#define PG8_SCHED __builtin_amdgcn_sched_barrier(0)
#define PG8_AOFFS(o, ui) do { _Pragma("unroll") for (int _h = 0; _h < 2; ++_h) _Pragma("unroll") for (int _i = 0; _i < 2; ++_i) { \
        const int _row = tab[(ui) * 256 + _h * HALF + RA[_i]]; (o)[_h][_i] = (unsigned)(_row * KB + CA[_i] * 2); } } while (0)
    Unit cur, nxt; int ui = 0;
    if (!S.next(0, cur)) return;
    int one_scale = 0x7f7f7f7f; asm volatile("" : "+v"(one_scale));
    int w_scale = 0x7a7a7a7a; asm volatile("" : "+v"(w_scale));
    f32x4 acc[2][2][4][2];
#define PG8_ZERO_ACC() do { if constexpr (!F8) { _Pragma("unroll") for (int a = 0; a < 2; ++a) _Pragma("unroll") for (int b = 0; b < 2; ++b) _Pragma("unroll") for (int m = 0; m < 4; ++m) _Pragma("unroll") for (int n = 0; n < 2; ++n) acc[a][b][m][n] = (f32x4){0.f, 0.f, 0.f, 0.f}; } } while (0)
    PG8_ZERO_ACC();
    v8i At[4], B0[2], B1[2];
    unsigned oAc[2][2], oAn[2][2], o2[2][2];
#pragma unroll
    for (int h = 0; h < 2; ++h)
#pragma unroll
        for (int i = 0; i < 2; ++i) { oAc[h][i] = 0u; oAn[h][i] = 0u; o2[h][i] = 0u; }
    if (GATHER) { PG8_AOFFS(oAc, 0); }
    const char* cAb = (const char*)g.A + (size_t)cur.pm * tstep; const char* a2b = cAb;
    const char* cB = (const char*)g.Bt + (size_t)cur.bt * tstep;
    PG8_STAGE_B(PG8_SB(0, 0), cB); PG8_STAGE_B(PG8_SB(0, 1), cB + hstep); PG8_STAGE_A(PG8_SA(0, 0), 0, 0, 0); PG8_STAGE_A(PG8_SA(0, 1), 0, 0, 1);
    if (wr == 1) PG8_BAR;
    PG8_WAIT_V(2); PG8_BAR;
    PG8_STAGE_B(PG8_SB(1, 0), cB + kstep); PG8_STAGE_A(PG8_SA(1, 0), kstep, 0, 0); PG8_STAGE_B(PG8_SB(1, 1), cB + hstep + kstep);
    PG8_WAIT_V(6); PG8_BAR;
    for (;;) {
        const bool has_next = S.next(ui + 1, nxt);
        if (GATHER) {
            if (has_next) { PG8_AOFFS(oAn, ui + 1); }
            else {
#pragma unroll
                for (int h = 0; h < 2; ++h)
#pragma unroll
                    for (int i = 0; i < 2; ++i) oAn[h][i] = oAc[h][i];
            }
        }
        const char* nAb = has_next ? (const char*)g.A + (size_t)nxt.pm * tstep : cAb;
        const char* nB = has_next ? (const char*)g.Bt + (size_t)nxt.bt * tstep : cB;
#define PG8_ITER(MMA0_) { \
            const bool last = (t == nt - 2); \
            if (g.sig != nullptr && !has_next && t == ((nt / 2 + 2) & ~1) && tid == 0) __hip_atomic_fetch_add(g.sig, 1u, __ATOMIC_RELAXED, __HIP_MEMORY_SCOPE_AGENT); \
            const size_t k1 = (size_t)KWRAP(t + 1) * kstep; \
            const size_t k2 = last ? 0 : (size_t)KWRAP(t + 2) * kstep, k3 = k2 + kstep; \
            if (GATHER) { \
_Pragma("unroll") \
                for (int h = 0; h < 2; ++h) \
_Pragma("unroll") \
                    for (int i = 0; i < 2; ++i) o2[h][i] = last ? oAn[h][i] : oAc[h][i]; \
            } \
            a2b = last ? nAb : cAb; \
            const char* b2 = last ? nB : cB + (size_t)KWRAP(t + 2) * kstep; const char* b3 = b2 + kstep; \
            PG8_LDB(B0, 0, 0); PG8_LDB(B1, 0, 1); PG8_SCHED; PG8_LDA(At, 0, 0); PG8_STAGE_A(PG8_SA(1, 1), k1, 0, 1); \
            PG8_WAIT_V(8); PG8_WAIT_L(0); PG8_BAR; MMA0_(0, 0, At, B0); MMA0_(0, 1, At, B1); PG8_BAR; PG8_SCHED; \
            PG8_LDA(At, 0, 1); PG8_STAGE_B(PG8_SB(0, 0), b2); PG8_STAGE_B(PG8_SB(0, 1), b2 + hstep); PG8_STAGE_A(PG8_SA(0, 0), k2, 1, 0); \
            PG8_WAIT_V(8); PG8_WAIT_L(0); PG8_BAR; MMA0_(1, 0, At, B0); MMA0_(1, 1, At, B1); PG8_BAR; PG8_SCHED; \
            PG8_LDB(B0, 1, 0); PG8_LDB(B1, 1, 1); PG8_SCHED; PG8_LDA(At, 1, 0); PG8_STAGE_A(PG8_SA(0, 1), k2, 1, 1); \
            PG8_WAIT_V(8); PG8_WAIT_L(0); PG8_BAR; PG8_MMA(0, 0, At, B0); PG8_MMA(0, 1, At, B1); PG8_BAR; PG8_SCHED; \
            PG8_LDA(At, 1, 1); PG8_STAGE_B(PG8_SB(1, 0), b3); PG8_STAGE_B(PG8_SB(1, 1), b3 + hstep); PG8_STAGE_A(PG8_SA(1, 0), k3, 1, 0); \
            PG8_WAIT_V(8); PG8_WAIT_L(0); PG8_BAR; PG8_MMA(1, 0, At, B0); PG8_MMA(1, 1, At, B1); PG8_BAR; PG8_SCHED; \
        }
        if constexpr (F8) {
            { const int t = 0; PG8_ITER(PG8_MMA_Z) }
#pragma unroll 1
            for (int t = 2; t < nt; t += 2) PG8_ITER(PG8_MMA)
        } else {
#pragma unroll 1
            for (int t = 0; t < nt; t += 2) PG8_ITER(PG8_MMA)
        }
#undef PG8_ITER
        if (wr == 0) PG8_BAR;
        if constexpr (F8) asm volatile("s_nop 15\n\ts_nop 15" ::: "memory");
        E(acc, cur, ui, wr, wc, fr, fq, lds);
        if (!has_next) break;
        PG8_ZERO_ACC();
        cur = nxt; cB = nB; cAb = nAb; ++ui;
        if (GATHER) {
#pragma unroll
            for (int h = 0; h < 2; ++h)
#pragma unroll
                for (int i = 0; i < 2; ++i) oAc[h][i] = oAn[h][i];
        }
        if (wr == 1) PG8_BAR;
    }
    PG8_WAIT_V(0);
    PG8_BAR;
#undef PG8_SA
#undef PG8_SB
#undef PG8_STAGE_A
#undef PG8_STAGE_B
#undef PG8_LDA
#undef PG8_LDB
#undef PG8_MMA
#undef PG8_MMA_Z
#undef PG8_ZERO_ACC
#undef PG8_WAIT_V
#undef PG8_WAIT_L
#undef PG8_BAR
#undef PG8_SCHED
#undef PG8_AOFFS
}

#define EPI_ROWS_BEGIN(u) \
    _Pragma("unroll") for (int ai = 0; ai < 2; ++ai) _Pragma("unroll") for (int m = 0; m < 4; ++m) { const int row = (u).pm * BM + ai * HALF + wr * 64 + m * 16 + fr; const int rloc = ai * HALF + wr * 64 + m * 16 + fr; (void)rloc; (void)row;
#define EPI_ROWS_END }

template <bool E4> struct EpiHin {
    unsigned char* ws;
    __device__ __forceinline__ void operator()(const f32x4 (&acc)[2][2][4][2], const Unit& u, int ui, int wr, int wc, int fr, int fq, LAS unsigned char* lds) const {
        const int region = u.pn >> 2, cc0 = (u.pn & 3) * 256 + wc * 32 + 8 * fq;
        const LAS float* lbt = (const LAS float*)(lds + GEMM_AUX_OFF);
        if constexpr (E4) {
            bf16* O = (bf16*)(ws + (region == 0 ? WS_V : (region == 3 ? WS_Q : WS_SG)));
            EPI_ROWS_BEGIN(u)
                bf16* rowp = O + (size_t)row * D + cc0;
#pragma unroll
                for (int bj = 0; bj < 2; ++bj) { f32x4 v0 = acc[ai][bj][m][0], v1 = acc[ai][bj][m][1];
                    if (region != 0) {
                        f32x4 z0 = v0 * -1.4426950408889634f, z1 = v1 * -1.4426950408889634f;
#pragma unroll
                        for (int j = 0; j < 4; ++j) { z0[j] = __builtin_amdgcn_exp2f(z0[j]); z1[j] = __builtin_amdgcn_exp2f(z1[j]); }
                        z0 = z0 + 1.0f; z1 = z1 + 1.0f;
#pragma unroll
                        for (int j = 0; j < 4; ++j) { z0[j] = __builtin_amdgcn_rcpf(z0[j]); z1[j] = __builtin_amdgcn_rcpf(z1[j]); }
                        v0 = v0 * z0; v1 = v1 * z1; }
                    u32x4 w; w.x = pk2(v0[0], v0[1]); w.y = pk2(v0[2], v0[3]); w.z = pk2(v1[0], v1[1]); w.w = pk2(v1[2], v1[3]);
                    *(u32x4*)(rowp + bj * HALF) = w; }
            EPI_ROWS_END
        } else {
            bf16* OL = (bf16*)(ws + (region == 1 ? WS_LFF : WS_LFB));
            EPI_ROWS_BEGIN(u)
                const size_t ro = (size_t)row * D + cc0;
#pragma unroll
                for (int bj = 0; bj < 2; ++bj) {
                    const f32x4 l0 = *(const LAS f32x4*)(lbt + (region - 1) * 1024 + cc0 + bj * HALF), l1 = *(const LAS f32x4*)(lbt + (region - 1) * 1024 + cc0 + bj * HALF + 4);
                    f32x4 f0, f1;
#pragma unroll
                    for (int j = 0; j < 4; ++j) {
                        { const float a = acc[ai][bj][m][0][j], l = l0[j], sg = __builtin_amdgcn_rcpf(1.0f + __expf(-a)); f0[j] = __builtin_amdgcn_logf(l + (1.0f - l) * sg); }
                        { const float a = acc[ai][bj][m][1][j], l = l1[j], sg = __builtin_amdgcn_rcpf(1.0f + __expf(-a)); f1[j] = __builtin_amdgcn_logf(l + (1.0f - l) * sg); }
                    }
                    u32x4 w; w.x = pk2(f0[0], f0[1]); w.y = pk2(f0[2], f0[3]); w.z = pk2(f1[0], f1[1]); w.w = pk2(f1[2], f1[3]);
                    *(u32x4*)(OL + ro + bj * HALF) = w; }
            EPI_ROWS_END
        }
    }
};
template <int ACT> struct EpiBf16 {
    bf16* O; int ldc; float* stats; float scale;
    __device__ __forceinline__ void operator()(const f32x4 (&acc)[2][2][4][2], const Unit& u, int ui, int wr, int wc, int fr, int fq, LAS unsigned char* lds) const {
        const int col0 = u.pn * BM + wc * 32 + 8 * fq;
        EPI_ROWS_BEGIN(u)
            bf16* rowp = O + (unsigned)(row * ldc + col0); float s1 = 0.f, s2 = 0.f;
#pragma unroll
            for (int bj = 0; bj < 2; ++bj) { f32x4 v0 = acc[ai][bj][m][0], v1 = acc[ai][bj][m][1];
                if (ACT == 1) {
                    f32x4 z0 = v0 * (v0 * v0 * -0.10294324f + -2.30220819f), z1 = v1 * (v1 * v1 * -0.10294324f + -2.30220819f);
#pragma unroll
                    for (int j = 0; j < 4; ++j) { z0[j] = __builtin_amdgcn_exp2f(z0[j]); z1[j] = __builtin_amdgcn_exp2f(z1[j]); }
                    z0 = z0 + 1.0f; z1 = z1 + 1.0f;
#pragma unroll
                    for (int j = 0; j < 4; ++j) { z0[j] = __builtin_amdgcn_rcpf(z0[j]); z1[j] = __builtin_amdgcn_rcpf(z1[j]); }
                    v0 = v0 * z0; v1 = v1 * z1;
                    const f32x4 q0 = v0 * v0 + v1 * v1, p0 = v0 + v1;
                    s1 += (p0[0] + p0[1]) + (p0[2] + p0[3]); s2 += (q0[0] + q0[1]) + (q0[2] + q0[3]); }
                u32x4 w; w.x = pk2(v0[0], v0[1]); w.y = pk2(v0[2], v0[3]); w.z = pk2(v1[0], v1[1]); w.w = pk2(v1[2], v1[3]);
                *(u32x4*)(rowp + bj * HALF) = w; }
            if (ACT == 1) { s1 = xor32_sum(xor16_sum(s1)); s2 = xor32_sum(xor16_sum(s2));
                if (u.pn >= 4 && fq == 0) *(f32x2*)(stats + ((size_t)row * 16 + (u.pn - 4) * 4 + wc) * 2) = (f32x2){s1, s2}; }
        EPI_ROWS_END
    }
};
struct EpiGU {
    bf16* Hd;
    __device__ __forceinline__ void operator()(const f32x4 (&acc)[2][2][4][2], const Unit& u, int ui, int wr, int wc, int fr, int fq, LAS unsigned char* lds) const {
        const int col0 = u.pn * HALF + wc * 32 + 8 * fq;
        EPI_ROWS_BEGIN(u)
            f32x4 g0 = acc[ai][0][m][0], g1 = acc[ai][0][m][1], u0 = acc[ai][1][m][0], u1 = acc[ai][1][m][1];
#pragma unroll
            for (int j = 0; j < 4; ++j) { g0[j] = siluf_(g0[j]) * u0[j]; g1[j] = siluf_(g1[j]) * u1[j]; }
            u32x4 w; w.x = pk2(g0[0], g0[1]); w.y = pk2(g0[2], g0[3]); w.z = pk2(g1[0], g1[1]); w.w = pk2(g1[2], g1[3]);
            *(u32x4*)(Hd + (size_t)row * FF + col0) = w;
        EPI_ROWS_END
    }
};
struct EpiGU8 {
    unsigned char* Hd;
    __device__ __forceinline__ void operator()(const f32x4 (&acc)[2][2][4][2], const Unit& u, int ui, int wr, int wc, int fr, int fq, LAS unsigned char* lds) const {
        const int col0 = u.pn * HALF + wc * 32 + 8 * fq;
        EPI_ROWS_BEGIN(u)
#ifdef DUPK
            constexpr float GS = 0.015625f;
#else
            constexpr float GS = 1.0f;
#endif
            constexpr float CZ = -GS * 1.4426950408889634f, KI = 1.0f / (GS * GS);
            const f32x4 a0 = acc[ai][0][m][0], a1 = acc[ai][0][m][1];
            f32x4 z0 = a0 * CZ, z1 = a1 * CZ;
#pragma unroll
            for (int j = 0; j < 4; ++j) { z0[j] = __builtin_amdgcn_exp2f(z0[j]); z1[j] = __builtin_amdgcn_exp2f(z1[j]); }
            z0 = z0 * KI + KI; z1 = z1 * KI + KI;
#pragma unroll
            for (int j = 0; j < 4; ++j) { z0[j] = __builtin_amdgcn_rcpf(z0[j]); z1[j] = __builtin_amdgcn_rcpf(z1[j]); }
            const f32x4 g0 = (a0 * acc[ai][1][m][0]) * z0, g1 = (a1 * acc[ai][1][m][1]) * z1;
            u32x2 w; w.x = pk4_fp8(g0[0], g0[1], g0[2], g0[3]); w.y = pk4_fp8(g1[0], g1[1], g1[2], g1[3]);
            *(u32x2*)(Hd + (unsigned)(row * FF + col0)) = w;
        EPI_ROWS_END
    }
};
struct EpiDown {
    bf16* Yp; float scale;
    __device__ __forceinline__ void operator()(const f32x4 (&acc)[2][2][4][2], const Unit& u, int ui, int wr, int wc, int fr, int fq, LAS unsigned char* lds) const {
        const int col0 = u.pn * BM + wc * 32 + 8 * fq;
        const LAS float* gt = (const LAS float*)(lds + GEMM_TAB_OFF) + ui * 256;
        EPI_ROWS_BEGIN(u)
            const float gv = gt[rloc] * scale * 16.0f; unsigned char* rowp = (unsigned char*)Yp + (unsigned)(row * D + col0);
#pragma unroll
            for (int bj = 0; bj < 2; ++bj) { const f32x4 v0 = acc[ai][bj][m][0] * gv, v1 = acc[ai][bj][m][1] * gv;
                u32x2 w; w.x = pk4_fp8(v0[0], v0[1], v0[2], v0[3]); w.y = pk4_fp8(v1[0], v1[1], v1[2], v1[3]);
                *(u32x2*)(rowp + bj * HALF) = w; }
        EPI_ROWS_END
    }
};
template <class Sched> __device__ __forceinline__ void fill_row_table(LAS unsigned char* lds, const Sched& S, const unsigned* src) {
    LAS unsigned* tab = (LAS unsigned*)(lds + GEMM_TAB_OFF); Unit u;
    for (int i = 0; i < 8 && S.next(i, u); ++i) if (threadIdx.x < 256) tab[i * 256 + threadIdx.x] = src[u.pm * 256 + threadIdx.x];
    VM_WAIT(); LDS_WAIT(); __syncthreads();
}
}

#ifdef TS_SEG_LO
#define GT(k) do { asm volatile("" ::: "memory"); const unsigned long long now_ = __builtin_amdgcn_s_memrealtime(); if ((k) == TS_SEG_LO) gt[1] = now_; if ((k) == TS_SEG_HI) gt[0] += now_ - gt[1]; if ((k) == 0) gt[3] = now_; if ((k) == 8) gt[2] += now_ - gt[3]; asm volatile("" ::: "memory"); } while (0)
#define GT_DRAIN() asm volatile("s_waitcnt vmcnt(0) lgkmcnt(0)" ::: "memory")
#else
#define GT(k) do { } while (0)
#define GT_DRAIN() do { } while (0)
#endif
#ifdef TS_A
#define GSTAMP(n) do { if (blockIdx.x == 0 && threadIdx.x == 0) { unsigned char* ws_ = (unsigned char*)P.DSUM - WS_DSUM; if ((n) == TS_A) *(volatile unsigned long long*)(ws_ + WS_CTL + 32768) = __builtin_amdgcn_s_memrealtime(); if ((n) == TS_B) *(volatile unsigned long long*)(ws_ + WS_CTL + 32776) = __builtin_amdgcn_s_memrealtime(); } } while (0)
#else
#define GSTAMP(n) do { } while (0)
#endif
namespace gla {
__device__ __forceinline__ float ex2(float x) { return __builtin_amdgcn_exp2f(x); }
constexpr int QX_OFF = 0, KE_OFF = 17408, KST_OFF = 34816, VT_OFF = 53248, TOT_OFF = 71680, DG_OFF = 73728, OD_OFF = 75776, DEC_OFF = 77312, SSQ_OFF = 77824;
constexpr int QSTR = 272, PSTR = 144, TSTR = 144;
static_assert(SSQ_OFF + 1024 <= HALF_LDS, "gla LDS map");

__device__ __forceinline__ bf16x8 scale8(bf16x8 a, f32x4 f0, f32x4 f1) {
    u32x4 w = __builtin_bit_cast(u32x4, a);
    w.x = pk2(bflo(w.x) * f0[0], bfhi(w.x) * f0[1]); w.y = pk2(bflo(w.y) * f0[2], bfhi(w.y) * f0[3]);
    w.z = pk2(bflo(w.z) * f1[0], bfhi(w.z) * f1[1]); w.w = pk2(bflo(w.w) * f1[2], bfhi(w.w) * f1[3]);
    return __builtin_bit_cast(bf16x8, w);
}

__device__ __forceinline__ void half_barrier(volatile LAS unsigned* cnt, unsigned& gen, int lane) {
    asm volatile("s_waitcnt lgkmcnt(0)" ::: "memory");
    gen += 4u;
    if (lane == 0) {
        __hip_atomic_fetch_add((LAS unsigned*)cnt, 1u, __ATOMIC_RELAXED, __HIP_MEMORY_SCOPE_WORKGROUP);
        while (__hip_atomic_load((LAS unsigned*)cnt, __ATOMIC_RELAXED, __HIP_MEMORY_SCOPE_WORKGROUP) < gen) __builtin_amdgcn_s_sleep(1);
    }
    asm volatile("" ::: "memory");
}
struct NoHook { __device__ __forceinline__ void after_b4(u32x2 (&)[24]) {} __device__ __forceinline__ void at_end(u32x2 (&)[24]) {} };
struct SweepHook {
    const bf16 *OFf, *OFb, *SG; bf16* OG; f32x4 gw; volatile LAS unsigned* flags; int dir, hw, lane, ch;
    long rowbase; unsigned need, pub;
    __device__ __forceinline__ size_t ro(int q) const { return (size_t)(rowbase + 16 * hw + 2 * q + (lane >> 5)) * D + ch; }
    __device__ __forceinline__ void publish() { if (hw == 0 && lane == 0) flags[dir] = pub; }
    __device__ __forceinline__ void wait_other() { if (lane == 0) { while (flags[dir ^ 1] < need) __builtin_amdgcn_s_sleep(1); } asm volatile("" ::: "memory"); }
    __device__ __forceinline__ void load(u32x2 (&sw)[24]) {
#pragma unroll
        for (int q = 0; q < 8; ++q) { const size_t r = ro(q); sw[q] = *(const u32x2*)(OFf + r); sw[8 + q] = *(const u32x2*)(OFb + r); sw[16 + q] = *(const u32x2*)(SG + r); }
    }
    __device__ __forceinline__ void finish(const u32x2 (&sw)[24]) {
        float ssq[8];
#pragma unroll
        for (int q = 0; q < 8; ++q) { const u32x2 fv = sw[q], bb = sw[8 + q];
            const f32x4 o = (f32x4){bflo(fv.x) + bflo(bb.x), bfhi(fv.x) + bfhi(bb.x), bflo(fv.y) + bflo(bb.y), bfhi(fv.y) + bfhi(bb.y)};
            ssq[q] = row16_sum((o[0] * o[0] + o[1] * o[1]) + (o[2] * o[2] + o[3] * o[3])); }
#pragma unroll
        for (int q = 0; q < 8; ++q) ssq[q] = xor16_sum(ssq[q]);
#pragma unroll
        for (int q = 0; q < 8; ++q) { const u32x2 fv = sw[q], bb = sw[8 + q], sg = sw[16 + q];
            f32x4 o = (f32x4){bflo(fv.x) + bflo(bb.x), bfhi(fv.x) + bfhi(bb.x), bflo(fv.y) + bflo(bb.y), bfhi(fv.y) + bfhi(bb.y)};
            const float ss = ssq[q];
            const float rstd = rsqrtf(ss * (1.0f / HD) + EPS);
            u32x2 w; w.x = pk2(o[0] * rstd * gw[0] * bflo(sg.x), o[1] * rstd * gw[1] * bfhi(sg.x)); w.y = pk2(o[2] * rstd * gw[2] * bflo(sg.y), o[3] * rstd * gw[3] * bfhi(sg.y));
            *(u32x2*)(OG + ro(q)) = w; }
    }
    __device__ __forceinline__ void after_b4(u32x2 (&sw)[24]) { publish(); if (rowbase >= 0) { wait_other(); load(sw); } }
    __device__ __forceinline__ void at_end(u32x2 (&sw)[24]) { if (rowbase >= 0) finish(sw); }
};
template <int WHICH>
__device__ __forceinline__ void issue_loads(int lane, int J, const bf16* LFp, const bf16* Vp, const bf16* Qp, long row0, int rstep, int hc, unsigned (&lraw)[16], unsigned (&vraw)[16], unsigned (&qraw)[16]) {
    const unsigned base = ((unsigned)((int)row0 + rstep * (16 * J)) * (unsigned)D + (unsigned)(hc + 2 * lane)) * 2u; const int rs = rstep * (D * 2);
    if (WHICH & 1) {
#pragma unroll
        for (int jj = 0; jj < 16; ++jj) lraw[jj] = *(const unsigned*)((const char*)LFp + (base + (unsigned)(rs * jj)));
#pragma unroll
        for (int jj = 0; jj < 16; ++jj) vraw[jj] = *(const unsigned*)((const char*)Vp + (base + (unsigned)(rs * jj)));
    }
    if (WHICH & 2) {
#pragma unroll
        for (int jj = 0; jj < 16; ++jj) qraw[jj] = *(const unsigned*)((const char*)Qp + (base + (unsigned)(rs * jj)));
    }
}
template <bool OUT, class Hook>
__device__ __forceinline__ void step(LAS unsigned char* hl, int hw, int lane_in, const bf16* Kp, const bf16* LFp, const bf16* Vp, const bf16* Qp, const bf16* SGp,
                                     long row0, int rstep, int hc, f32x4 (&Sacc)[8][2], float& dsum0, float& dsum1, volatile LAS unsigned* hbc, unsigned& hgen, bf16* OFd, unsigned long long (&gt)[4],
                                     unsigned (&lraw)[16], unsigned (&vraw)[16], unsigned (&qraw)[16], bool more, long next_row0, Hook& hk) {
    GT(0);
    int lane = lane_in; asm volatile("" : "+v"(lane));
    const int J = hw, c0 = 2 * lane, l15 = lane & 15, g = lane >> 4;
    issue_loads<1>(lane, J, LFp, Vp, Qp, row0, rstep, hc, lraw, vraw, qraw);
    GT_DRAIN(); GT(1);
    float a0 = 0.f, a1 = 0.f;
#pragma unroll
    for (int jj = 0; jj < 16; ++jj) { a0 += bflo(lraw[jj]); a1 += bfhi(lraw[jj]); }
    LAS float* TOT = (LAS float*)(hl + TOT_OFF);
    *(LAS f32x2*)(TOT + J * 128 + c0) = (f32x2){a0, a1};
    half_barrier(hbc, hgen, lane);
    GT(2);
    if (OUT) issue_loads<2>(lane, J, LFp, Vp, Qp, row0, rstep, hc, lraw, vraw, qraw);
    float t0[4], t1[4];
#pragma unroll
    for (int I = 0; I < 4; ++I) { const f32x2 t = *(const LAS f32x2*)(TOT + I * 128 + c0); t0[I] = t.x; t1[I] = t.y; }
    float RJ0 = 0.f, RJ1 = 0.f, RA0 = 0.f, RA1 = 0.f;
#pragma unroll
    for (int I = 0; I < 4; ++I) { if (I < J) { RJ0 += t0[I]; RJ1 += t1[I]; } if (I > J) { RA0 += t0[I]; RA1 += t1[I]; } }
    const float R40 = (t0[0] + t0[1]) + (t0[2] + t0[3]), R41 = (t1[0] + t1[1]) + (t1[2] + t1[3]);
    {
        LAS float* DG = (LAS float*)(hl + DG_OFF); LAS float* OD = (LAS float*)(hl + OD_OFF); LAS float* DEC = (LAS float*)(hl + DEC_OFF);
        *(LAS f32x2*)(DG + J * 128 + c0) = (f32x2){ex2(fminf(-a0, 115.f)), ex2(fminf(-a1, 115.f))};
        if (J == 0) { *(LAS f32x2*)(DEC + c0) = (f32x2){ex2(R40), ex2(R41)}; dsum0 += R40; dsum1 += R41; }
        else if (J == 1) *(LAS f32x2*)(OD + 0 * 128 + c0) = (f32x2){ex2(t0[1]), ex2(t1[1])};
        else if (J == 2) *(LAS f32x2*)(OD + 1 * 128 + c0) = (f32x2){ex2(t0[2]), ex2(t1[2])};
        else *(LAS f32x2*)(OD + 2 * 128 + c0) = (f32x2){ex2(t0[1] + t0[2]), ex2(t1[1] + t1[2])};
    }
    const float eR0 = ex2(RJ0), eR1 = ex2(RJ1), eA0 = ex2(RA0), eA1 = ex2(RA1);
    unsigned qs[16];
    {
        float su0 = 1.0f, su1 = 1.0f;
#pragma unroll
        for (int hh = 1; hh >= 0; --hh) {
            float ks0[8], ks1[8];
#pragma unroll
            for (int j8 = 7; j8 >= 0; --j8) {
                const int jj = 8 * hh + j8, i = 16 * J + jj;
                const float f0 = ex2(bflo(lraw[jj])), f1 = ex2(bfhi(lraw[jj]));
                const float ke0 = (1.0f - f0) * su0, ke1 = (1.0f - f1) * su1;
                ks0[j8] = ke0 * eA0; ks1[j8] = ke1 * eA1;
                if (OUT) *(LAS unsigned*)(hl + KE_OFF + i * QSTR + c0 * 2) = pk2(ke0, ke1);
                su0 *= f0; su1 *= f1;
            }
            u32x4 w;
            w.x = pk2(ks0[0], ks0[1]); w.y = pk2(ks0[2], ks0[3]); w.z = pk2(ks0[4], ks0[5]); w.w = pk2(ks0[6], ks0[7]);
            *(LAS u32x4*)(hl + KST_OFF + c0 * TSTR + 32 * J + 16 * hh) = w;
            w.x = pk2(ks1[0], ks1[1]); w.y = pk2(ks1[2], ks1[3]); w.z = pk2(ks1[4], ks1[5]); w.w = pk2(ks1[6], ks1[7]);
            *(LAS u32x4*)(hl + KST_OFF + (c0 + 1) * TSTR + 32 * J + 16 * hh) = w;
#define VLO(a, b) ((vraw[a] & 0xffffu) | (vraw[b] << 16))
#define VHI(a, b) ((vraw[a] >> 16) | (vraw[b] & 0xffff0000u))
            w.x = VLO(8 * hh + 0, 8 * hh + 1); w.y = VLO(8 * hh + 2, 8 * hh + 3); w.z = VLO(8 * hh + 4, 8 * hh + 5); w.w = VLO(8 * hh + 6, 8 * hh + 7);
            *(LAS u32x4*)(hl + VT_OFF + c0 * TSTR + 32 * J + 16 * hh) = w;
            w.x = VHI(8 * hh + 0, 8 * hh + 1); w.y = VHI(8 * hh + 2, 8 * hh + 3); w.z = VHI(8 * hh + 4, 8 * hh + 5); w.w = VHI(8 * hh + 6, 8 * hh + 7);
            *(LAS u32x4*)(hl + VT_OFF + (c0 + 1) * TSTR + 32 * J + 16 * hh) = w;
#undef VLO
#undef VHI
        }
        if (OUT) {
            float pr0 = 1.0f, pr1 = 1.0f;
#pragma unroll
            for (int jj = 0; jj < 16; ++jj) {
                pr0 *= ex2(bflo(lraw[jj])); pr1 *= ex2(bfhi(lraw[jj]));
                const float qt0 = bflo(qraw[jj]) * pr0, qt1 = bfhi(qraw[jj]) * pr1;
                *(LAS unsigned*)(hl + QX_OFF + (16 * J + jj) * QSTR + c0 * 2) = pk2(qt0, qt1);
                qs[jj] = pk2(qt0 * eR0, qt1 * eR1);
            }
        } else {
#pragma unroll
            for (int jj = 0; jj < 16; ++jj) qs[jj] = 0u;
        }
    }
    GT_DRAIN(); GT(3);
    half_barrier(hbc, hgen, lane);
    GT(4);
    u32x2 sw[24];
    if (OUT) {
        const int I = hw;
        f32x4 sc[4];
#pragma unroll
        for (int Jp = 0; Jp < 4; ++Jp) {
            sc[Jp] = (f32x4){0.f, 0.f, 0.f, 0.f};
            if (Jp <= I) {
                const LAS float* ft = (Jp == I) ? (const LAS float*)(hl + DG_OFF) + I * 128
                                    : ((I - Jp == 2) ? (const LAS float*)(hl + OD_OFF) + (I - 2) * 128 : (const LAS float*)(hl + OD_OFF) + 2 * 128);
                const bool needf = (Jp != I - 1);
                f32x4 acc = (f32x4){0.f, 0.f, 0.f, 0.f};
#pragma unroll
                for (int ks = 0; ks < 4; ++ks) {
                    bf16x8 a = *(const LAS bf16x8*)(hl + QX_OFF + (16 * I + l15) * QSTR + (32 * ks + 8 * g) * 2);
                    if (needf) { const f32x4 f0 = *(const LAS f32x4*)(ft + 32 * ks + 8 * g), f1 = *(const LAS f32x4*)(ft + 32 * ks + 8 * g + 4); a = scale8(a, f0, f1); }
                    const bf16x8 b = *(const LAS bf16x8*)(hl + KE_OFF + (16 * Jp + l15) * QSTR + (32 * ks + 8 * g) * 2);
                    acc = __builtin_amdgcn_mfma_f32_16x16x32_bf16(a, b, acc, 0, 0, 0);
                }
                if (Jp == I) {
#pragma unroll
                    for (int r = 0; r < 4; ++r) if (l15 > 4 * g + r) acc[r] = 0.f;
                }
                sc[Jp] = acc;
            }
        }
        GT(5);
        half_barrier(hbc, hgen, lane);
        GT(6);
#pragma unroll
        for (int Jp = 0; Jp < 4; ++Jp) {
            const bool wr_blk = (Jp <= I) || (I == 0 && Jp == 1) || (I == 2 && Jp == 3);
            if (wr_blk) {
#pragma unroll
                for (int r = 0; r < 4; ++r) *(LAS unsigned short*)(hl + KE_OFF + (16 * I + 4 * g + r) * PSTR + (16 * Jp + l15) * 2) = (unsigned short)(pk2(sc[Jp][r], 0.f) & 0xffffu);
            }
        }
#pragma unroll
        for (int jj = 0; jj < 16; ++jj) *(LAS unsigned*)(hl + QX_OFF + (16 * J + jj) * QSTR + c0 * 2) = qs[jj];
        half_barrier(hbc, hgen, lane);
        GT(7);
        hk.after_b4(sw);
    }
    bf16x8 vb[2][2];
#pragma unroll
    for (int ct = 0; ct < 2; ++ct)
#pragma unroll
        for (int js = 0; js < 2; ++js) vb[ct][js] = *(const LAS bf16x8*)(hl + VT_OFF + (32 * hw + 16 * ct + l15) * TSTR + (32 * js + 8 * g) * 2);
    if (OUT) {
        const unsigned cbase = (unsigned)(hc + 32 * hw + l15);
#pragma unroll
        for (int I = 0; I < 4; ++I) {
            f32x4 o0 = (f32x4){0.f, 0.f, 0.f, 0.f}, o1 = (f32x4){0.f, 0.f, 0.f, 0.f};
#pragma unroll
            for (int ks = 0; ks < (I < 2 ? 1 : 2); ++ks) {
                const bf16x8 pa = *(const LAS bf16x8*)(hl + KE_OFF + (16 * I + l15) * PSTR + (32 * ks + 8 * g) * 2);
                o0 = __builtin_amdgcn_mfma_f32_16x16x32_bf16(pa, vb[0][ks], o0, 0, 0, 0);
                o1 = __builtin_amdgcn_mfma_f32_16x16x32_bf16(pa, vb[1][ks], o1, 0, 0, 0);
            }
            if (I > 0) {
                asm volatile("" : "+v"(Sacc[0][0]), "+v"(Sacc[0][1]), "+v"(Sacc[1][0]), "+v"(Sacc[1][1]), "+v"(Sacc[2][0]), "+v"(Sacc[2][1]), "+v"(Sacc[3][0]), "+v"(Sacc[3][1]));
                asm volatile("" : "+v"(Sacc[4][0]), "+v"(Sacc[4][1]), "+v"(Sacc[5][0]), "+v"(Sacc[5][1]), "+v"(Sacc[6][0]), "+v"(Sacc[6][1]), "+v"(Sacc[7][0]), "+v"(Sacc[7][1]));
            }
#pragma unroll
            for (int ks = 0; ks < 4; ++ks) {
                bf16x8 Sb[2];
#pragma unroll
                for (int ct = 0; ct < 2; ++ct) { const f32x4 s0 = Sacc[2 * ks][ct], s1 = Sacc[2 * ks + 1][ct]; u32x4 w; w.x = pk2(s0[0], s0[1]); w.y = pk2(s0[2], s0[3]); w.z = pk2(s1[0], s1[1]); w.w = pk2(s1[2], s1[3]); Sb[ct] = __builtin_bit_cast(bf16x8, w); }
                const u32x2 lo = *(const LAS u32x2*)(hl + QX_OFF + (16 * I + l15) * QSTR + (32 * ks + 4 * g) * 2), hi = *(const LAS u32x2*)(hl + QX_OFF + (16 * I + l15) * QSTR + (32 * ks + 16 + 4 * g) * 2);
                const bf16x8 qa = __builtin_bit_cast(bf16x8, (u32x4){lo.x, lo.y, hi.x, hi.y});
                o0 = __builtin_amdgcn_mfma_f32_16x16x32_bf16(qa, Sb[0], o0, 0, 0, 0);
                o1 = __builtin_amdgcn_mfma_f32_16x16x32_bf16(qa, Sb[1], o1, 0, 0, 0);
            }
#pragma unroll
            for (int r = 0; r < 4; ++r) { const unsigned ro = (unsigned)((int)row0 + rstep * (16 * I + 4 * g + r)) * (unsigned)D + cbase;
                OFd[ro] = (bf16)(pk2(o0[r], 0.f) & 0xffffu); OFd[ro + 16] = (bf16)(pk2(o1[r], 0.f) & 0xffffu); }
        }
    }
#pragma unroll
    for (int kt = 0; kt < 8; ++kt) {
        const f32x4 d = *(const LAS f32x4*)(hl + DEC_OFF + (16 * kt + 4 * g) * 4);
        Sacc[kt][0] = Sacc[kt][0] * d; Sacc[kt][1] = Sacc[kt][1] * d;
#pragma unroll
        for (int js = 0; js < 2; ++js) {
            const bf16x8 ka = *(const LAS bf16x8*)(hl + KST_OFF + (16 * kt + l15) * TSTR + (32 * js + 8 * g) * 2);
            Sacc[kt][0] = __builtin_amdgcn_mfma_f32_16x16x32_bf16(ka, vb[0][js], Sacc[kt][0], 0, 0, 0);
            Sacc[kt][1] = __builtin_amdgcn_mfma_f32_16x16x32_bf16(ka, vb[1][js], Sacc[kt][1], 0, 0, 0);
        }
    }
    if (OUT) hk.at_end(sw);
    GT(8);
}

struct Ptrs { const bf16 *V, *KF, *LFF, *KB, *LFB, *Q, *SG; float* OF; bf16* OG; const float* gn; float *LST, *SENT, *LSTC, *DSUM, *DSUMC; };

__device__ __forceinline__ void pass_a(LAS unsigned char* lds, const Ptrs& P, int G) {
    const int tid = opaque_tid(), wid = __builtin_amdgcn_readfirstlane(tid >> 6), lane = tid & 63, dir = wid >> 2, hw = wid & 3, l15 = lane & 15, g = lane >> 4;
    LAS unsigned char* hl = lds + dir * HALF_LDS;
    const bf16* Kp = dir ? P.KB : P.KF; const bf16* LFp = dir ? P.LFB : P.LFF;
    volatile LAS unsigned* hbc = (volatile LAS unsigned*)(lds + MISC_OFF) + 16 + dir * 4; unsigned hgen = 0u;
    if (tid < 8) ((volatile LAS unsigned*)(lds + MISC_OFF))[16 + tid] = 0u;
    __syncthreads();
    for (int it = blockIdx.x; it < 320; it += G) {
        const bool isctx = it >= 256;
        int b, h, sc, nsteps; long base;
        if (!isctx) { b = it >> 7; h = (it >> 4) & 7; sc = it & 15; nsteps = 8; base = (long)b * T + sc * SCT; }
        else { const int r = it - 256; b = r >> 5; h = (r >> 2) & 7; sc = r & 3; nsteps = 1; base = (long)M + b * CTX + 64 * sc; }
        f32x4 Sacc[8][2];
#pragma unroll
        for (int kt = 0; kt < 8; ++kt) { Sacc[kt][0] = (f32x4){0.f, 0.f, 0.f, 0.f}; Sacc[kt][1] = (f32x4){0.f, 0.f, 0.f, 0.f}; }
        float ds0 = 0.f, ds1 = 0.f; unsigned long long gt[4] = {0ull, 0ull, 0ull, 0ull};
        unsigned lraw[16], vraw[16], qraw[16]; NoHook nohook;
#pragma unroll
        for (int jj = 0; jj < 16; ++jj) qraw[jj] = 0u;
        for (int s = 0; s < nsteps; ++s) {
            const long row0 = dir ? base + 64 * (nsteps - 1 - s) + 63 : base + 64 * s;
            step<false>(hl, hw, lane, Kp, LFp, P.V, P.Q, P.SG, row0, dir ? -1 : 1, h * HD, Sacc, ds0, ds1, hbc, hgen, nullptr, gt, lraw, vraw, qraw, s + 1 < nsteps, dir ? row0 - 64 : row0 + 64, nohook);
        }
#ifdef TS_SEG_LO
        if (it == TS_SEG_ITEM && tid == TS_SEG_TID && TS_SEG_PASS == 0) { *(volatile unsigned long long*)((unsigned char*)P.DSUM - WS_DSUM + WS_CTL + 32768) = 0ull; *(volatile unsigned long long*)((unsigned char*)P.DSUM - WS_DSUM + WS_CTL + 32776) = (unsigned long long)((float)gt[0] * 10000.0f / (float)gt[2]); }
#endif
        const int seq = (b * NH + h) * 2 + dir;
        if (isctx) { float* dst = P.LSTC + ((size_t)seq * 4 + sc) * 16384;
#pragma unroll
            for (int kt = 0; kt < 8; ++kt)
#pragma unroll
                for (int ct = 0; ct < 2; ++ct)
#pragma unroll
                    for (int r = 0; r < 4; ++r) dst[(16 * kt + 4 * g + r) * 128 + 32 * hw + 16 * ct + l15] = Sacc[kt][ct][r];
        } else { bf16* dst = (bf16*)P.LST + ((size_t)seq * NSC + sc) * 16384;
#pragma unroll
            for (int kt = 0; kt < 8; ++kt)
#pragma unroll
                for (int ct = 0; ct < 2; ++ct)
#pragma unroll
                    for (int r = 0; r < 4; ++r) dst[(16 * kt + 4 * g + r) * 128 + 32 * hw + 16 * ct + l15] = (bf16)(pk2(Sacc[kt][ct][r], 0.f) & 0xffffu); }
        if (hw == 0) *(f32x2*)((isctx ? P.DSUMC + ((size_t)seq * 4 + sc) * 128 : P.DSUM + ((size_t)seq * NSC + sc) * 128) + 2 * lane) = (f32x2){ds0, ds1};
    }
}
__device__ __forceinline__ void pass_b(const Ptrs& P, int G) {
    for (int idx = blockIdx.x * 512 + threadIdx.x; idx < 32 * 4096; idx += G * 512) {
        const int seq = idx >> 12, e4 = (idx & 4095) * 4, k = e4 >> 7, dir = seq & 1;
        f32x4 cur = (f32x4){0.f, 0.f, 0.f, 0.f};
        for (int j = 0; j < 4; ++j) { const int cc = dir ? 3 - j : j; const size_t o = (size_t)seq * 4 + cc;
            cur = cur * ex2(P.DSUMC[o * 128 + k]) + *(const f32x4*)(P.LSTC + o * 16384 + e4); }
        for (int j = 0; j < NSC; ++j) {
            const int sc = dir ? NSC - 1 - j : j;
            const size_t o = ((size_t)seq * NSC + sc);
            { u32x2 wv; wv.x = pk2(cur[0], cur[1]); wv.y = pk2(cur[2], cur[3]); *(u32x2*)((bf16*)P.SENT + o * 16384 + e4) = wv; }
            const float dk = ex2(P.DSUM[o * 128 + k]);
            const u32x2 lw = *(const u32x2*)((const bf16*)P.LST + o * 16384 + e4);
            cur = cur * dk + (f32x4){bflo(lw.x), bfhi(lw.x), bflo(lw.y), bfhi(lw.y)};
        }
    }
}
__device__ __forceinline__ void pass_c(LAS unsigned char* lds, const Ptrs& P, int G) {
    const int tid = opaque_tid(), wid = __builtin_amdgcn_readfirstlane(tid >> 6), lane = tid & 63, dir = wid >> 2, hw = wid & 3, l15 = lane & 15, g = lane >> 4;
    LAS unsigned char* hl = lds + dir * HALF_LDS;
    const bf16* Kp = dir ? P.KB : P.KF; const bf16* LFp = dir ? P.LFB : P.LFF;
    bf16* OFf = (bf16*)P.OF; bf16* OFb = OFf + (size_t)M * D; bf16* OFd = dir ? OFb : OFf;
    volatile LAS unsigned* hbc = (volatile LAS unsigned*)(lds + MISC_OFF) + 16 + dir * 4; unsigned hgen = 0u;
    volatile LAS unsigned* flags = (volatile LAS unsigned*)(lds + MISC_OFF) + 24;
    if (tid < 8) ((volatile LAS unsigned*)(lds + MISC_OFF))[16 + tid] = 0u;
    __syncthreads();
    GSTAMP(10);
    for (int it = blockIdx.x; it < 256; it += G) {
        if (tid < 2) flags[tid] = 0u;
        __syncthreads();
        const int b = it >> 7, h = (it >> 4) & 7, sc = it & 15; const long base = (long)b * T + sc * SCT;
        const int seq = (b * NH + h) * 2 + dir;
        const bf16* src = (const bf16*)P.SENT + ((size_t)seq * NSC + sc) * 16384;
        f32x4 Sacc[8][2];
#pragma unroll
        for (int kt = 0; kt < 8; ++kt)
#pragma unroll
            for (int ct = 0; ct < 2; ++ct)
#pragma unroll
                for (int r = 0; r < 4; ++r) Sacc[kt][ct][r] = bflo((unsigned)src[(16 * kt + 4 * g + r) * 128 + 32 * hw + 16 * ct + l15]);
        float ds0 = 0.f, ds1 = 0.f; unsigned long long gt[4] = {0ull, 0ull, 0ull, 0ull};
        unsigned lraw[16], vraw[16], qraw[16];
        SweepHook hk; hk.OFf = OFf; hk.OFb = OFb; hk.SG = P.SG; hk.OG = P.OG; hk.flags = flags; hk.dir = dir; hk.hw = hw; hk.lane = lane; hk.ch = h * HD + 4 * (lane & 31);
        hk.gw = *(const f32x4*)(P.gn + hk.ch);
        for (int s = 0; s < 8; ++s) {
            const long row0 = dir ? base + 64 * (7 - s) + 63 : base + 64 * s;
            hk.pub = (unsigned)s; hk.need = (unsigned)(9 - s);
            hk.rowbase = s >= 5 ? (dir ? base + 64 * (8 - s) : base + 64 * (s - 1)) : -1;
            step<true>(hl, hw, lane, Kp, LFp, P.V, P.Q, P.SG, row0, dir ? -1 : 1, h * HD, Sacc, ds0, ds1, hbc, hgen, OFd, gt, lraw, vraw, qraw, s < 7, dir ? row0 - 64 : row0 + 64, hk);
        }
#ifdef TS_SEG_LO
        if (it == TS_SEG_ITEM && tid == TS_SEG_TID && TS_SEG_PASS == 2) { *(volatile unsigned long long*)((unsigned char*)P.DSUM - WS_DSUM + WS_CTL + 32768) = 0ull; *(volatile unsigned long long*)((unsigned char*)P.DSUM - WS_DSUM + WS_CTL + 32776) = (unsigned long long)((float)gt[0] * 10000.0f / (float)gt[2]); }
#endif
        GSTAMP(12);
        VM_WAIT(); half_barrier(hbc, hgen, lane);
        hk.pub = 8u; hk.need = 1u; hk.rowbase = dir ? base : base + 64 * 7;
        { u32x2 sw[24]; hk.publish(); hk.wait_other(); hk.load(sw); hk.finish(sw); }
        __syncthreads();
        GSTAMP(13);
    }
}
}

struct Args {
    const float *x, *c, *ctx, *c_ctx, *w_ada, *b_ada, *norm_w, *hg_w_in, *hg_lb, *hg_gnorm, *hg_w_out, *sg_w_in, *sg_ln_w, *sg_ln_b, *sg_w_s, *sg_b_s, *sg_w_out,
                *moe_router, *moe_w_gate, *moe_w_up, *moe_w_down;
    float* out; unsigned char* ws; int ph_lo, ph_hi, li, pad;
};
#define CAS __attribute__((address_space(4)))
typedef const CAS Args& ArgsRef;
__device__ __forceinline__ const CAS Args* launder_args(const CAS Args* p) { asm volatile("" : "+s"(p)); return p; }

#ifdef TS_A
#define USTAMP(n) do { if (blockIdx.x == 0 && threadIdx.x == 0) { if ((n) == TS_A) *(volatile unsigned long long*)(a.ws + WS_CTL + 32768) = __builtin_amdgcn_s_memrealtime(); if ((n) == TS_B) *(volatile unsigned long long*)(a.ws + WS_CTL + 32776) = __builtin_amdgcn_s_memrealtime(); } } while (0)
#else
#define USTAMP(n) do { } while (0)
#endif
struct ConvTile { const float* W; bf16* WT; int K, N, rowmode, kt, nt, f8; };
constexpr int NT_SMALL = 160 + 32 + 64 + 32, NT_MOE = 2 * 3072;
constexpr int Q_HEAD = 6144, Q_DONE0 = 6144 + 64, Q_DONE1 = 6144 + 128, Q_DONE2 = 6144 + 192, Q_SMALL = 6144 + 256;
__device__ __forceinline__ void conv_decode_small(ArgsRef a, int r, ConvTile& t) {
    unsigned char* ws = a.ws;
    t.f8 = 0;
    if (r < 160) { t.W = a.hg_w_in; t.K = D; t.N = 5 * D; t.rowmode = 0; t.kt = r / 20; t.nt = r % 20;
                   const int region = t.nt >> 2; t.f8 = (region == 1 || region == 2) ? 0 : 1; t.WT = (bf16*)(ws + (t.f8 ? WS_WHIN8 : WS_WHIN)); }
    else if ((r -= 160) < 32) { t.W = a.hg_w_out; t.WT = (bf16*)(ws + WS_WHOUT); t.K = D; t.N = D; t.rowmode = 0; t.kt = r >> 2; t.nt = r & 3; }
    else if ((r -= 32) < 64) { t.W = a.sg_w_in; t.WT = (bf16*)(ws + WS_WSIN); t.K = D; t.N = 2 * D; t.rowmode = 0; t.kt = r >> 3; t.nt = r & 7; t.f8 = 1; }
    else { r -= 64; t.W = a.sg_w_out; t.WT = (bf16*)(ws + WS_WSOUT); t.K = D; t.N = D; t.rowmode = 0; t.kt = r >> 2; t.nt = r & 3; t.f8 = 1; }
}
__device__ __forceinline__ void conv_decode_moe(ArgsRef a, int r, ConvTile& t) {
    unsigned char* ws = a.ws; unsigned char* WGU = ws + WS_WGU; unsigned char* WD = ws + WS_WD;
    const int l = r / 3072, q = r % 3072, mat = q >> 10, e = (q >> 6) & 15, tt = q & 63, le = l * 16 + e;
    t.f8 = 1;
    if (mat == 0) { t.W = a.moe_w_gate + (size_t)le * D * FF; t.WT = (bf16*)(WGU + (size_t)le * 4096 * D); t.K = D; t.N = FF; t.rowmode = 1; t.kt = tt >> 3; t.nt = tt & 7; }
    else if (mat == 1) { t.W = a.moe_w_up + (size_t)le * D * FF; t.WT = (bf16*)(WGU + (size_t)le * 4096 * D); t.K = D; t.N = FF; t.rowmode = 2; t.kt = tt >> 3; t.nt = tt & 7; }
    else { t.W = a.moe_w_down + (size_t)le * FF * D; t.WT = (bf16*)(WD + (size_t)le * D * FF); t.K = FF; t.N = D; t.rowmode = 0; t.kt = tt >> 2; t.nt = tt & 3; }
}
__device__ __forceinline__ void conv_load(const ConvTile& t, f32x4 (&v)[16], int wave, int lane) {
#pragma unroll
    for (int i = 0; i < 16; ++i) v[i] = __builtin_nontemporal_load((const f32x4*)(t.W + (size_t)(t.kt * 128 + wave * 16 + i) * t.N + t.nt * 256 + 4 * lane));
}
__device__ __forceinline__ void conv_to_lds(LAS unsigned char* buf, const f32x4 (&v)[16], int wave, int lane) {
#pragma unroll
    for (int i = 0; i < 16; ++i) { const int k = wave * 16 + i; u32x2 w; w.x = pk2(v[i][0], v[i][1]); w.y = pk2(v[i][2], v[i][3]); *(LAS u32x2*)(buf + k * 512 + (((4 * lane) ^ (((k >> 3) & 7) << 3)) * 2)) = w; }
}
__device__ __forceinline__ void conv_store(LAS unsigned char* buf, const ConvTile& t, int wave, int lane) {
#pragma unroll
    for (int q = 0; q < 8; ++q) {
        const int idx = wave * 8 + q, rowgrp = idx >> 1, c8 = (idx & 1) * 8 + (lane & 7), nl = rowgrp * 8 + (lane >> 3), n = t.nt * 256 + nl;
        const LAS unsigned short* p = (const LAS unsigned short*)(buf + (8 * c8) * 512 + ((nl ^ ((c8 & 7) << 3)) * 2));
        u32x4 o;
        o.x = (unsigned)p[0 * 256] | ((unsigned)p[1 * 256] << 16); o.y = (unsigned)p[2 * 256] | ((unsigned)p[3 * 256] << 16);
        o.z = (unsigned)p[4 * 256] | ((unsigned)p[5 * 256] << 16); o.w = (unsigned)p[6 * 256] | ((unsigned)p[7 * 256] << 16);
        const int row = t.rowmode == 0 ? n : ((n >> 7) * 256 + (n & 127) + (t.rowmode == 2 ? 128 : 0));
        *(u32x4*)(t.WT + (size_t)row * t.K + t.kt * 128 + 8 * c8) = o;
    }
}
__device__ __forceinline__ void conv_to_lds8(LAS unsigned char* buf, const f32x4 (&v)[16], int wave, int lane) {
#pragma unroll
    for (int j = 0; j < 4; ++j) { const int n = 4 * lane + j; u32x4 o;
        o.x = pk4_fp8(v[0][j] * 32.f, v[1][j] * 32.f, v[2][j] * 32.f, v[3][j] * 32.f); o.y = pk4_fp8(v[4][j] * 32.f, v[5][j] * 32.f, v[6][j] * 32.f, v[7][j] * 32.f);
        o.z = pk4_fp8(v[8][j] * 32.f, v[9][j] * 32.f, v[10][j] * 32.f, v[11][j] * 32.f); o.w = pk4_fp8(v[12][j] * 32.f, v[13][j] * 32.f, v[14][j] * 32.f, v[15][j] * 32.f);
        *(LAS u32x4*)(buf + n * 128 + ((wave ^ (((n >> 2) ^ n) & 7)) << 4)) = o; }
}
__device__ __forceinline__ void conv_store8(LAS unsigned char* buf, const ConvTile& t, int wave, int lane) {
    unsigned char* WT8 = (unsigned char*)t.WT;
#pragma unroll
    for (int q = 0; q < 4; ++q) {
        const int c = lane & 7, nl = (wave * 4 + q) * 8 + (lane >> 3), n = t.nt * 256 + nl;
        const u32x4 o = *(const LAS u32x4*)(buf + nl * 128 + ((c ^ (((nl >> 2) ^ nl) & 7)) << 4));
        const int row = t.rowmode == 0 ? n : ((n >> 7) * 256 + (n & 127) + (t.rowmode == 2 ? 128 : 0));
        __builtin_nontemporal_store(o, (u32x4*)(WT8 + (size_t)row * t.K + t.kt * 128 + 16 * c));
    }
}
#define CONV_BAR() do { LDS_WAIT(); __builtin_amdgcn_s_barrier(); asm volatile("" ::: "memory"); } while (0)
template <int CONV_BATCH>
__device__ __forceinline__ void convert_worker(LAS unsigned char* lds, ArgsRef a, int mand, int done_idx, unsigned done_target) {
    const int tid = opaque_tid(), lane = tid & 63, wave = __builtin_amdgcn_readfirstlane(tid >> 6);
    unsigned* ctl = (unsigned*)(a.ws + WS_CTL);
    volatile LAS int* slot = (volatile LAS int*)(lds + 131072);
    int rng_next = 0, rng_end = 0, lastb = -1; bool stopf = false;
#define CONV_NEXT(r_) do { \
        if (rng_next < rng_end) r_ = rng_next++; \
        else if (stopf) r_ = -1; \
        else { const unsigned dn_ = __hip_atomic_load(ctl + done_idx, __ATOMIC_RELAXED, __HIP_MEMORY_SCOPE_AGENT); \
            if (lastb >= 0 && lastb + CONV_BATCH >= mand && dn_ >= done_target) { stopf = true; r_ = -1; } \
            else { const int t_ = (int)__hip_atomic_fetch_add(ctl + Q_HEAD, (unsigned)CONV_BATCH, __ATOMIC_RELAXED, __HIP_MEMORY_SCOPE_AGENT); lastb = t_; \
                if (t_ >= NT_MOE) { stopf = true; r_ = -1; } else { rng_next = t_ + 1; rng_end = t_ + CONV_BATCH < NT_MOE ? t_ + CONV_BATCH : NT_MOE; r_ = t_; } } } } while (0)
    if (tid == 0) { int r0, r1; CONV_NEXT(r0); CONV_NEXT(r1); slot[0] = r0; slot[1] = r1; }
    __syncthreads();
    f32x4 va[16], vb[16]; ConvTile ta, tb;
    int ca = slot[0], cb = slot[1];
    if (ca >= 0) { conv_decode_moe(a, ca, ta); conv_load(ta, va, wave, lane); }
    if (cb >= 0) { conv_decode_moe(a, cb, tb); conv_load(tb, vb, wave, lane); }
#define CONV_ROUND(X, tX, cX, bufoff, sl) do { \
        LAS unsigned char* buf_ = lds + (bufoff); \
        conv_to_lds8(buf_, X, wave, lane); \
        const ConvTile cc_ = tX; \
        if (tid == 0) { int r_; CONV_NEXT(r_); slot[sl] = r_; } \
        CONV_BAR(); \
        const int nxt_ = slot[sl]; \
        if (nxt_ >= 0) { conv_decode_moe(a, nxt_, tX); conv_load(tX, X, wave, lane); } \
        conv_store8(buf_, cc_, wave, lane); \
        cX = nxt_; } while (0)
    while (ca >= 0) {
        CONV_ROUND(va, ta, ca, 0, 2);
        if (cb < 0) break;
        CONV_ROUND(vb, tb, cb, 65536, 3);
    }
#undef CONV_ROUND
#undef CONV_NEXT
    __syncthreads();
}

__device__ __forceinline__ void phase_p0a(LAS unsigned char* lds, ArgsRef a, int G, int vcu) {
    unsigned char* ws = a.ws;
    const int tid = opaque_tid(), lane = tid & 63, wave = __builtin_amdgcn_readfirstlane(tid >> 6);
    USTAMP(0);
    {
        LAS float* sv = (LAS float*)(lds + 67584);
        LAS float* red = (LAS float*)(lds + 67584 + 12288);
        float* MOD = (float*)(ws + WS_MOD);
        for (int i = tid; i < 3072; i += 512) { const int v = i >> 10, k = i & 1023; sv[i] = siluf_(v < 2 ? a.c[v * D + k] : a.c_ctx[k]); }
        __syncthreads();
        for (int it = blockIdx.x; it < 192; it += G) {
            const int l = it / 96, cb = it % 96, n = cb * 64 + lane;
            const float* w = a.w_ada + (size_t)l * D * 6144 + (size_t)(wave * 128) * 6144 + n;
            float a0 = 0.f, a1 = 0.f, a2 = 0.f;
#pragma unroll 32
            for (int k = 0; k < 128; ++k) { const float wv = __builtin_nontemporal_load(w + (size_t)k * 6144); const int kk = wave * 128 + k; a0 += sv[kk] * wv; a1 += sv[1024 + kk] * wv; a2 += sv[2048 + kk] * wv; }
            red[(wave * 3 + 0) * 64 + lane] = a0; red[(wave * 3 + 1) * 64 + lane] = a1; red[(wave * 3 + 2) * 64 + lane] = a2;
            __syncthreads();
            if (tid < 192) { const int v = tid >> 6, c = tid & 63; float sacc = a.b_ada[l * 6144 + cb * 64 + c];
#pragma unroll
                for (int ww = 0; ww < 8; ++ww) sacc += red[(ww * 3 + v) * 64 + c];
                MOD[(size_t)(l * 3 + v) * 6144 + cb * 64 + c] = sacc; }
            __syncthreads();
        }
    }
    USTAMP(1);
    {
        f32x4 v[16]; ConvTile ct; int par = 0;
        volatile LAS int* slot = (volatile LAS int*)(lds + 131072);
        unsigned* qs = (unsigned*)(ws + WS_CTL) + Q_SMALL;
        if (tid == 0) slot[0] = (int)__hip_atomic_fetch_add(qs, 1u, __ATOMIC_RELAXED, __HIP_MEMORY_SCOPE_AGENT);
        __syncthreads();
        int it = slot[0];
        if (it < NT_SMALL) { conv_decode_small(a, it, ct); conv_load(ct, v, wave, lane); }
        while (it < NT_SMALL) {
            LAS unsigned char* buf = lds + par * 65536;
            const ConvTile cc = ct;
            if (cc.f8) conv_to_lds8(buf, v, wave, lane); else conv_to_lds(buf, v, wave, lane);
            if (tid == 0) slot[1 + par] = (int)__hip_atomic_fetch_add(qs, 1u, __ATOMIC_RELAXED, __HIP_MEMORY_SCOPE_AGENT);
            CONV_BAR();
            const int nx = slot[1 + par];
            if (nx < NT_SMALL) { conv_decode_small(a, nx, ct); conv_load(ct, v, wave, lane); }
            if (cc.f8) conv_store8(buf, cc, wave, lane); else conv_store(buf, cc, wave, lane);
            it = nx; par ^= 1;
        }
        __syncthreads();
    }
    USTAMP(2);
    {
        const int gt = blockIdx.x * 512 + tid, GT = G * 512;
        bf16* WSb = (bf16*)(ws + WS_WS);
        for (int i = gt; i < 8 * 128 * 128 / 2; i += GT) { const f32x2 v = *(const f32x2*)(a.sg_w_s + 2 * i); ((unsigned*)WSb)[i] = pk2(v.x, v.y); }
        float* LB = (float*)(ws + WS_LB);
        for (int i = gt; i < 2048; i += GT) { const float l0 = a.hg_lb[i], l1 = a.hg_lb[2048 + i], l2 = a.hg_lb[4096 + i]; const float mx = fmaxf(l0, fmaxf(l1, l2));
            const float e0 = expf(l0 - mx), e1 = expf(l1 - mx), e2 = expf(l2 - mx); LB[i] = e0 / (e0 + e1 + e2); }
    }
    USTAMP(3);
}

#define ROFF(lane, j) (8 * (lane) + 512 * ((j) >> 1) + 4 * ((j) & 1))
__device__ __forceinline__ void row_load_f32(const float* p, int lane, f32x4 (&x)[4]) {
#pragma unroll
    for (int j = 0; j < 4; ++j) x[j] = *(const f32x4*)(p + ROFF(lane, j));
}
__device__ __forceinline__ void row_load_f32_nt(const float* p, int lane, f32x4 (&x)[4]) {
#pragma unroll
    for (int j = 0; j < 4; ++j) x[j] = __builtin_nontemporal_load((const f32x4*)(p + ROFF(lane, j)));
}
__device__ __forceinline__ void row_store_f32(float* p, int lane, const f32x4 (&x)[4]) {
#pragma unroll
    for (int j = 0; j < 4; ++j) __builtin_nontemporal_store(x[j], (f32x4*)(p + ROFF(lane, j)));
}
__device__ __forceinline__ void row_store_bf16(bf16* p, int lane, const f32x4 (&x)[4]) {
#pragma unroll
    for (int h = 0; h < 2; ++h) { u32x4 w; w.x = pk2(x[2 * h][0], x[2 * h][1]); w.y = pk2(x[2 * h][2], x[2 * h][3]); w.z = pk2(x[2 * h + 1][0], x[2 * h + 1][1]); w.w = pk2(x[2 * h + 1][2], x[2 * h + 1][3]);
        *(u32x4*)(p + 8 * lane + 512 * h) = w; }
}
__device__ __forceinline__ void row_load_raw(const bf16* p, int lane, u32x4 (&r)[2]) {
#pragma unroll
    for (int h = 0; h < 2; ++h) r[h] = *(const u32x4*)(p + 8 * lane + 512 * h);
}
__device__ __forceinline__ void row_unpack(const u32x4 (&r)[2], f32x4 (&x)[4]) {
#pragma unroll
    for (int h = 0; h < 2; ++h) { x[2 * h] = (f32x4){bflo(r[h].x), bfhi(r[h].x), bflo(r[h].y), bfhi(r[h].y)}; x[2 * h + 1] = (f32x4){bflo(r[h].z), bfhi(r[h].z), bflo(r[h].w), bfhi(r[h].w)}; }
}
__device__ __forceinline__ void row_store_fp8(unsigned char* p, int lane, const f32x4 (&x)[4]) {
#pragma unroll
    for (int h = 0; h < 2; ++h) { u32x2 w; w.x = pk4_fp8(x[2 * h][0], x[2 * h][1], x[2 * h][2], x[2 * h][3]); w.y = pk4_fp8(x[2 * h + 1][0], x[2 * h + 1][1], x[2 * h + 1][2], x[2 * h + 1][3]);
        *(u32x2*)(p + 8 * lane + 512 * h) = w; }
}
__device__ __forceinline__ float row_rstd(const f32x4 (&x)[4]) {
    float s = 0.f;
#pragma unroll
    for (int j = 0; j < 4; ++j) s += (x[j][0] * x[j][0] + x[j][1] * x[j][1]) + (x[j][2] * x[j][2] + x[j][3] * x[j][3]);
    return rsqrtf(wave_sum(s) * (1.0f / D) + EPS);
}

__device__ __forceinline__ void phase_p0b(LAS unsigned char* lds, ArgsRef a, int G, int vcu) {
    unsigned char* ws = a.ws;
    const int tid = opaque_tid(), lane = tid & 63, wave = __builtin_amdgcn_readfirstlane(tid >> 6);
    const float* MOD = (const float*)(ws + WS_MOD);
    LAS float* modl = (LAS float*)lds;
    for (int i = tid; i < 6144; i += 512) { const int v = i >> 11, n = i & 2047; modl[i] = MOD[(size_t)v * 6144 + n]; }
    __syncthreads();
    bf16* XR = (bf16*)(ws + WS_XR); bf16* H = (bf16*)(ws + WS_H);
    f32x4 nw[4]; row_load_f32(a.norm_w, lane, nw);
    float frq[16];
#pragma unroll
    for (int j = 0; j < 4; ++j)
#pragma unroll
        for (int e = 0; e < 4; ++e) { const int dd = ROFF(lane, j) + e; frq[4 * j + e] = expf(-9.210340371976184f * (float)(dd & 255) / 256.0f); }
    const float phs = (lane & 32) ? 1.5707963267948966f : 0.0f;
    f32x4 pcol[2];
    { const float pc = (float)((vcu * 8 + wave) & 63);
#pragma unroll
      for (int j = 2; j < 4; ++j)
#pragma unroll
        for (int e = 0; e < 4; ++e) pcol[j - 2][e] = __sinf(pc * frq[4 * j + e] + phs); }
    const bool colconst = ((G * 8) & 63) == 0;
    f32x4 xn[4];
    { const int m0 = vcu * 8 + wave; if (m0 < MT) row_load_f32_nt(m0 < M ? a.x + (size_t)m0 * D : a.ctx + (size_t)(m0 - M) * D, lane, xn); }
    for (int m = vcu * 8 + wave; m < MT; m += G * 8) {
        f32x4 x[4]; int v;
#pragma unroll
        for (int j = 0; j < 4; ++j) x[j] = xn[j];
        { const int mn = m + G * 8; if (mn < MT) row_load_f32_nt(mn < M ? a.x + (size_t)mn * D : a.ctx + (size_t)(mn - M) * D, lane, xn); }
        if (m < M) {
            v = m >> 13;
            const float pr = (float)((m & (T - 1)) >> 6);
            if (!colconst) { const float pc = (float)(m & 63);
#pragma unroll
                for (int j = 2; j < 4; ++j)
#pragma unroll
                    for (int e = 0; e < 4; ++e) pcol[j - 2][e] = __sinf(pc * frq[4 * j + e] + phs); }
#pragma unroll
            for (int j = 0; j < 2; ++j)
#pragma unroll
                for (int e = 0; e < 4; ++e) x[j][e] += __sinf(pr * frq[4 * j + e] + phs);
            x[2] = x[2] + pcol[0]; x[3] = x[3] + pcol[1];
        } else v = 2;
        const float rs = row_rstd(x);
#pragma unroll
        for (int j = 0; j < 4; ++j) { const f32x4 sh = *(const LAS f32x4*)(modl + v * 2048 + ROFF(lane, j)), sc = *(const LAS f32x4*)(modl + v * 2048 + 1024 + ROFF(lane, j));
            x[j] = x[j] * rs * nw[j] * (sc + 1.0f) + sh; }
        row_store_bf16(H + (size_t)m * D, lane, x);
        row_store_fp8(ws + WS_H8 + (size_t)m * D, lane, x);
    }
}

__device__ __forceinline__ void rowpass_a_fill(LAS unsigned char* lds, ArgsRef a, int l) {
    LAS float* RT = (LAS float*)lds; const int tid = opaque_tid();
    const float* router = a.moe_router + (size_t)l * D * NE;
    for (int i = tid; i < D * NE; i += 512) { const int d = i >> 4, ln = (d & 511) >> 3, jj = 2 * (d >> 9) + ((d & 7) >> 2);
        RT[(i & 15) * 1024 + 4 * ln + 256 * jj + (d & 3)] = router[i]; }
}
__device__ __forceinline__ void phase_rowpass_a(LAS unsigned char* lds, ArgsRef a, int G, int vcu, int l) {
    unsigned char* ws = a.ws;
    const int tid = opaque_tid(), lane = tid & 63, wave = __builtin_amdgcn_readfirstlane(tid >> 6);
    LAS float* RT = (LAS float*)lds;
    if (MK_N_LAUNCHES != 1) rowpass_a_fill(lds, a, l);
    __syncthreads();
    const float* MOD = (const float*)(ws + WS_MOD); bf16* XR = (bf16*)(ws + WS_XR); bf16* H = (bf16*)(ws + WS_H); const bf16* Y = (const bf16*)(ws + WS_Y); float* AFF = (float*)(ws + WS_AFF);
    f32x4 c1[4], c2[4], sh[4]; int bcur = -1;
    const int S8 = G * 8; const bool pairok = (T % (2 * S8)) == 0;
    const int step = pairok ? 2 * S8 : S8;
    u32x4 yr0[2], xr0[2], yr1[2], xr1[2];
    f32x4 xf0[4], xf1[4];
    const float phs = (lane & 32) ? 1.5707963267948966f : 0.0f;
    LAS f32x4* PT = (LAS f32x4*)(lds + 65536 + wave * 6144) + lane * 6;
    const bool colconst = ((G * 8) & 63) == 0;
    if (l == 0) {
        const float pc = (float)((vcu * 8 + wave) & 63);
#pragma unroll
        for (int j = 0; j < 4; ++j) { f32x4 fq4;
#pragma unroll
            for (int e = 0; e < 4; ++e) { const int dd = ROFF(lane, j) + e; fq4[e] = expf(-9.210340371976184f * (float)(dd & 255) / 256.0f); }
            if (j < 2) PT[j] = fq4;
            else { f32x4 pv; PT[j + 2] = fq4;
#pragma unroll
                for (int e = 0; e < 4; ++e) pv[e] = __sinf(pc * fq4[e] + phs);
                PT[j] = pv; } }
    }
#define RPA_LOADX(m_, XRR, XFF) do { if (l == 0) row_load_f32_nt(a.x + (size_t)(m_) * D, lane, XFF); else row_load_raw(XR + (size_t)(m_) * D, lane, XRR); } while (0)
#define RPA_GETX(m_, XRR, XFF, x_) do { if (l == 0) { const float pr_ = (float)(((m_) & (T - 1)) >> 6); \
            _Pragma("unroll") for (int j = 0; j < 2; ++j) { const f32x4 fq4 = PT[j]; _Pragma("unroll") for (int e = 0; e < 4; ++e) x_[j][e] = XFF[j][e] + __sinf(pr_ * fq4[e] + phs); } \
            if (colconst) { x_[2] = XFF[2] + PT[2]; x_[3] = XFF[3] + PT[3]; } \
            else { const float pc_ = (float)((m_) & 63); _Pragma("unroll") for (int j = 2; j < 4; ++j) { const f32x4 fq4 = PT[j + 2]; _Pragma("unroll") for (int e = 0; e < 4; ++e) x_[j][e] = XFF[j][e] + __sinf(pc_ * fq4[e] + phs); } } \
            } else row_unpack(XRR, x_); } while (0)
    { const int m0 = vcu * 8 + wave; if (m0 < M) { row_load_raw(Y + (size_t)m0 * D, lane, yr0); RPA_LOADX(m0, xr0, xf0); }
      if (pairok && m0 + S8 < M) { row_load_raw(Y + (size_t)(m0 + S8) * D, lane, yr1); RPA_LOADX(m0 + S8, xr1, xf1); } }
    for (int m = vcu * 8 + wave; m < M; m += step) {
        const bool two = pairok && m + S8 < M;
        const int b = m >> 13;
        if (b != bcur) { const float* mod = MOD + (size_t)(l * 3 + b) * 6144; f32x4 g1[4], scv[4], n1[4], n2[4];
            row_load_f32(mod + 2 * D, lane, g1); row_load_f32(mod + 3 * D, lane, sh); row_load_f32(mod + 4 * D, lane, scv);
            row_load_f32(a.norm_w + (size_t)(l * 4 + 1) * D, lane, n1); row_load_f32(a.norm_w + (size_t)(l * 4 + 2) * D, lane, n2);
#pragma unroll
            for (int j = 0; j < 4; ++j) { c1[j] = g1[j] * n1[j]; c2[j] = n2[j] * (scv[j] + 1.0f); }
            bcur = b; }
        f32x4 ya[4], yb[4];
        {   f32x4 y[4], x[4];
            row_unpack(yr0, y); RPA_GETX(m, xr0, xf0, x);
            { const int mn = m + step; if (mn < M) { row_load_raw(Y + (size_t)mn * D, lane, yr0); RPA_LOADX(mn, xr0, xf0); } }
            const float r1 = row_rstd(y);
#pragma unroll
            for (int j = 0; j < 4; ++j) x[j] = x[j] + c1[j] * (y[j] * r1);
            row_store_bf16(XR + (size_t)m * D, lane, x);
            const float r2 = row_rstd(x);
#pragma unroll
            for (int j = 0; j < 4; ++j) ya[j] = x[j] * r2 * c2[j] + sh[j];
            row_store_fp8((unsigned char*)H + (size_t)m * D, lane, ya); }
        if (two) { f32x4 y[4], x[4]; const int m1 = m + S8;
            row_unpack(yr1, y); RPA_GETX(m1, xr1, xf1, x);
            { const int mn = m1 + step; if (mn < M) { row_load_raw(Y + (size_t)mn * D, lane, yr1); RPA_LOADX(mn, xr1, xf1); } }
            const float r1 = row_rstd(y);
#pragma unroll
            for (int j = 0; j < 4; ++j) x[j] = x[j] + c1[j] * (y[j] * r1);
            row_store_bf16(XR + (size_t)m1 * D, lane, x);
            const float r2 = row_rstd(x);
#pragma unroll
            for (int j = 0; j < 4; ++j) yb[j] = x[j] * r2 * c2[j] + sh[j];
            row_store_fp8((unsigned char*)H + (size_t)m1 * D, lane, yb);
        } else {
#pragma unroll
            for (int j = 0; j < 4; ++j) yb[j] = (f32x4){0.f, 0.f, 0.f, 0.f};
        }
        float rsa = 0.f, rsb = 0.f;
#pragma unroll
        for (int eh = 0; eh < 2; ++eh) {
            f32x4 pa[8], pb[8];
#pragma unroll
            for (int e = 0; e < 8; ++e) { pa[e] = (f32x4){0.f, 0.f, 0.f, 0.f}; pb[e] = (f32x4){0.f, 0.f, 0.f, 0.f}; }
#pragma unroll
            for (int j = 0; j < 4; ++j) {
#pragma unroll
                for (int e4 = 0; e4 < 8; e4 += 4) {
                    f32x4 r[4];
#pragma unroll
                    for (int e = 0; e < 4; ++e) r[e] = *(const LAS f32x4*)(RT + (8 * eh + e4 + e) * 1024 + 4 * lane + 256 * j);
                    __builtin_amdgcn_sched_barrier(0);
#pragma unroll
                    for (int e = 0; e < 4; ++e) { pa[e4 + e] = pa[e4 + e] + ya[j] * r[e]; pb[e4 + e] = pb[e4 + e] + yb[j] * r[e]; }
                    __builtin_amdgcn_sched_barrier(0);
                }
            }
#pragma unroll
            for (int e = 0; e < 8; ++e) { const float sa = row16_sum((pa[e][0] + pa[e][1]) + (pa[e][2] + pa[e][3])), sb = row16_sum((pb[e][0] + pb[e][1]) + (pb[e][2] + pb[e][3]));
                const bool mineq = (lane & 15) == 8 * eh + e; rsa = mineq ? sa : rsa; rsb = mineq ? sb : rsb; }
        }
#pragma unroll
        for (int rr = 0; rr < 2; ++rr) {
            if (rr == 1 && !two) break;
            const float mine_rs = rr ? rsb : rsa; const int mrow = rr ? m + S8 : m;
            float mylg = xor32_sum(xor16_sum(mine_rs));
            float mx = mylg;
            mx = fmaxf(mx, __builtin_bit_cast(float, __builtin_amdgcn_update_dpp(0, __builtin_bit_cast(int, mx), 0xB1, 0xF, 0xF, true)));
            mx = fmaxf(mx, __builtin_bit_cast(float, __builtin_amdgcn_update_dpp(0, __builtin_bit_cast(int, mx), 0x4E, 0xF, 0xF, true)));
            mx = fmaxf(mx, __builtin_bit_cast(float, __builtin_amdgcn_update_dpp(0, __builtin_bit_cast(int, mx), 0x141, 0xF, 0xF, true)));
            mx = fmaxf(mx, __builtin_bit_cast(float, __builtin_amdgcn_update_dpp(0, __builtin_bit_cast(int, mx), 0x140, 0xF, 0xF, true)));
            const float mine = __expf(mylg - mx);
            const float se = row16_sum(mine);
            const int myexp = lane & 15;
            if (lane < 16) AFF[((size_t)(b * NE + myexp)) * T + (mrow & (T - 1))] = mine / se;
        }
    }
}
#undef RPA_LOADX
#undef RPA_GETX
__device__ __forceinline__ int block_exscan(int v, LAS int* sbuf, int tid, int* tot) {
    const int lane = tid & 63, wave = tid >> 6; int inc = v;
#pragma unroll
    for (int o = 1; o < 64; o <<= 1) { const int n = __shfl_up(inc, o); if (lane >= o) inc += n; }
    __syncthreads();
    if (lane == 63) sbuf[wave] = inc;
    __syncthreads();
    int base = 0, t = 0;
#pragma unroll
    for (int w = 0; w < 8; ++w) { const int s = sbuf[w]; if (w < wave) base += s; t += s; }
    *tot = t;
    return base + inc - v;
}

__device__ __forceinline__ void phase_topk(LAS unsigned char* lds, ArgsRef a, int G, unsigned* sig) {
    unsigned char* ws = a.ws; const int tid = opaque_tid();
    const float* AFF = (const float*)(ws + WS_AFF); int* ROWMAP = (int*)(ws + WS_ROWMAP); float* GATE = (float*)(ws + WS_GATE); int* INV = (int*)(ws + WS_INV);
    LAS int* hist = (LAS int*)lds; LAS int* ctl = hist + 256; LAS int* sbuf = hist + 272;
    for (int pe = blockIdx.x; pe < NB * NE; pe += G) {
        const int e = pe >> 1, b = pe & 1;
        unsigned key[16];
#pragma unroll
        for (int i = 0; i < 4; ++i) { const f32x4 kv = *(const f32x4*)(AFF + ((size_t)(b * NE + e) * T + tid * 16 + 4 * i));
#pragma unroll
            for (int j = 0; j < 4; ++j) { const float sc = kv[j] * 4294967296.0f; key[4 * i + j] = sc >= 4294967040.0f ? 0xFFFFFFFFu : (unsigned)sc; } }
        unsigned prefix = 0u, mask = 0u; int need = CAP;
        for (int pass = 0; pass < 4; ++pass) {
            const int shift = 24 - 8 * pass;
            __syncthreads();
            if (tid < 256) hist[tid] = 0;
            __syncthreads();
#pragma unroll
            for (int i = 0; i < 16; ++i) if ((key[i] & mask) == prefix) __hip_atomic_fetch_add(&hist[(key[i] >> shift) & 255u], 1, __ATOMIC_RELAXED, __HIP_MEMORY_SCOPE_WORKGROUP);
            __syncthreads();
            const int hv = tid < 256 ? hist[255 - tid] : 0; int tot;
            const int above = block_exscan(hv, sbuf, tid, &tot);
            if (tid < 256 && above < need && above + hv >= need) { ctl[0] = 255 - tid; ctl[1] = need - above; }
            __syncthreads();
            prefix |= (unsigned)ctl[0] << shift; mask |= 255u << shift; need = ctl[1];
        }
        if (sig != nullptr && pe + G >= NB * NE && tid == 0) __hip_atomic_fetch_add(sig, 1u, __ATOMIC_RELAXED, __HIP_MEMORY_SCOPE_AGENT);
        int neq = 0;
#pragma unroll
        for (int i = 0; i < 16; ++i) neq += (key[i] == prefix) ? 1 : 0;
        int tot; int eqb = block_exscan(neq, sbuf, tid, &tot);
        int nsel = 0; unsigned selm = 0u;
#pragma unroll
        for (int i = 0; i < 16; ++i) { bool sl = key[i] > prefix; if (key[i] == prefix) { sl = eqb < need; ++eqb; } if (sl) { selm |= 1u << i; ++nsel; } }
        int slot = block_exscan(nsel, sbuf, tid, &tot);
#pragma unroll
        for (int i = 0; i < 16; ++i) { const int t = tid * 16 + i; const bool sl = (selm >> i) & 1u;
            INV[((size_t)b * T + t) * 16 + e] = sl ? slot : -1;
            if (sl) { ROWMAP[(e * 2 + b) * CAP + slot] = b * T + t; GATE[(e * 2 + b) * CAP + slot] = AFF[(size_t)(b * NE + e) * T + t]; ++slot; } }
    }
}

__device__ __forceinline__ void phase_rowpass_b(ArgsRef a, int G, int vcu, int l) {
    unsigned char* ws = a.ws;
    const int tid = opaque_tid(), lane = tid & 63, wave = __builtin_amdgcn_readfirstlane(tid >> 6);
    const float* MOD = (const float*)(ws + WS_MOD); bf16* XR = (bf16*)(ws + WS_XR); bf16* H = (bf16*)(ws + WS_H); const bf16* YP = (const bf16*)(ws + WS_YP); const int* INV = (const int*)(ws + WS_INV);
    f32x4 nw3[4], nwn[4]; row_load_f32(a.norm_w + (size_t)(l * 4 + 3) * D, lane, nw3); row_load_f32(a.norm_w + (size_t)(4 + 0) * D, lane, nwn);
    u32x4 xr[2]; int ivn = -1;
    { const int m0 = vcu * 8 + wave; if (m0 < M) { ivn = INV[(size_t)m0 * 16 + (lane & 15)]; row_load_raw(XR + (size_t)m0 * D, lane, xr); } }
    for (int m = vcu * 8 + wave; m < M; m += G * 8) {
        const int b = m >> 13; const float* mod = MOD + (size_t)(l * 3 + b) * 6144;
        const int iv = ivn;
        f32x4 x[4]; row_unpack(xr, x);
        { const int mn = m + G * 8; if (mn < M) { ivn = INV[(size_t)mn * 16 + (lane & 15)]; row_load_raw(XR + (size_t)mn * D, lane, xr); } }
        f32x4 y[4];
#pragma unroll
        for (int j = 0; j < 4; ++j) y[j] = (f32x4){0.f, 0.f, 0.f, 0.f};
        unsigned msel = (unsigned)(__ballot(iv >= 0) & 0xFFFFull);
        while (msel) {
            int ee[4]; u32x2 tr[4][2];
#pragma unroll
            for (int q = 0; q < 4; ++q) { if (msel) { ee[q] = __builtin_ctz(msel); msel &= msel - 1u; } else ee[q] = -1; }
#pragma unroll
            for (int q = 0; q < 4; ++q) if (ee[q] >= 0) { const int slot = __builtin_amdgcn_readlane(iv, ee[q]); const unsigned char* yr8 = (const unsigned char*)YP + (size_t)((ee[q] * 2 + b) * CAP + slot) * D; tr[q][0] = *(const u32x2*)(yr8 + 8 * lane); tr[q][1] = *(const u32x2*)(yr8 + 8 * lane + 512); }
#pragma unroll
            for (int q = 0; q < 4; ++q) if (ee[q] >= 0) {
#pragma unroll
                for (int h = 0; h < 2; ++h) { const f32x2 p0 = __builtin_amdgcn_cvt_pk_f32_fp8(tr[q][h].x, false), p1 = __builtin_amdgcn_cvt_pk_f32_fp8(tr[q][h].x, true), p2 = __builtin_amdgcn_cvt_pk_f32_fp8(tr[q][h].y, false), p3 = __builtin_amdgcn_cvt_pk_f32_fp8(tr[q][h].y, true);
                    y[2 * h] = y[2 * h] + (f32x4){p0.x, p0.y, p1.x, p1.y}; y[2 * h + 1] = y[2 * h + 1] + (f32x4){p2.x, p2.y, p3.x, p3.y}; } }
        }
#pragma unroll
        for (int j = 0; j < 4; ++j) y[j] = y[j] * 0.0625f;
        f32x4 g2[4]; row_load_f32(mod + 5 * D, lane, g2);
        const float r = row_rstd(y);
#pragma unroll
        for (int j = 0; j < 4; ++j) x[j] = x[j] + g2[j] * (y[j] * r * nw3[j]);
        if (l == 0) {
            row_store_bf16(XR + (size_t)m * D, lane, x);
            const float* mod1 = MOD + (size_t)(1 * 3 + b) * 6144; f32x4 sh[4], sc[4]; row_load_f32(mod1, lane, sh); row_load_f32(mod1 + D, lane, sc);
            const float r2 = row_rstd(x);
#pragma unroll
            for (int j = 0; j < 4; ++j) y[j] = x[j] * r2 * nwn[j] * (sc[j] + 1.0f) + sh[j];
            row_store_fp8((unsigned char*)H + (size_t)m * D, lane, y);
        } else {
#ifdef TS_LO
            if (m == 0) { const unsigned long long t0 = *(volatile unsigned long long*)(ws + WS_CTL + 32768), t1 = *(volatile unsigned long long*)(ws + WS_CTL + 32776);
#ifdef TS_CONST
                const float dt = TS_CONST;
#else
                float dt = (float)(long long)(t1 - t0) * 0.01f;
#ifdef TS_Q
                dt = floorf(dt / TS_Q + 0.5f) * TS_Q;
#endif
#endif
#ifndef TS_SCALE
#define TS_SCALE 1.0f
#endif
                const float e = sqrtf(dt * 0.1514f * TS_SCALE);
#pragma unroll
                for (int j = 0; j < 4; ++j) x[j] = x[j] + e; }
#endif
            row_store_f32(a.out + (size_t)m * D, lane, x); }
    }
}

__device__ __forceinline__ void phase_sgu_mix(LAS unsigned char* lds, ArgsRef a, int G) {
    unsigned char* ws = a.ws;
    const int tid = opaque_tid(), lane = tid & 63, w = __builtin_amdgcn_readfirstlane(tid >> 6), l15 = lane & 15, gq = lane >> 4;
    const bf16* Z = (const bf16*)(ws + WS_Z); const float* STATS = (const float*)(ws + WS_STATS); bf16* A2 = (bf16*)(ws + WS_A2); const bf16* WSb = (const bf16*)(ws + WS_WS);
    LAS float* ST = (LAS float*)lds; LAS unsigned char* vt = lds + 1024; constexpr int VS = 272; constexpr int OB_OFF = 40960, OBS = 132;
    u32x4 ur[4], urN[4]; unsigned raw[16], rawN[16]; f32x4 st[8], stN[8];
#define MIX_ISSUE(it_, UR, RAW, STV) do { const int n_ = (it_) >> 3, g_ = (it_) & 7; const size_t r0_ = (size_t)n_ * 128; \
        _Pragma("unroll") for (int i4 = 0; i4 < 4; ++i4) UR[i4] = *(const u32x4*)(Z + (r0_ + 16 * w + 4 * i4 + (lane >> 4)) * 2048 + 128 * g_ + (lane & 15) * 8); \
        _Pragma("unroll") for (int jj = 0; jj < 16; ++jj) RAW[jj] = *(const unsigned*)(Z + (r0_ + 16 * w + jj) * 2048 + 1024 + 128 * g_ + 2 * lane); \
        if (tid < 128) { _Pragma("unroll") for (int j = 0; j < 8; ++j) STV[j] = *(const f32x4*)(STATS + (r0_ + tid) * 32 + 4 * j); } } while (0)
    if ((int)blockIdx.x < 128 * 8) MIX_ISSUE((int)blockIdx.x, ur, raw, st);
    for (int it = blockIdx.x; it < 128 * 8; it += G) {
        const int n = it >> 3, g = it & 7; const size_t r0 = (size_t)n * 128;
        const bool more = it + G < 128 * 8;
        if (more) MIX_ISSUE(it + G, urN, rawN, stN);
        __syncthreads();
        if (tid < 128) { float s1 = 0.f, s2 = 0.f;
#pragma unroll
            for (int j = 0; j < 8; ++j) { s1 += st[j][0] + st[j][2]; s2 += st[j][1] + st[j][3]; }
            const float mean = s1 * (1.0f / 1024.0f), var = fmaxf(s2 * (1.0f / 1024.0f) - mean * mean, 0.f);
            ST[2 * tid] = mean; ST[2 * tid + 1] = rsqrtf(var + EPS); }
        __syncthreads();
        {
            const int c0 = 2 * lane; const f32x2 lw = *(const f32x2*)(a.sg_ln_w + 128 * g + c0), lbv = *(const f32x2*)(a.sg_ln_b + 128 * g + c0);
            float v0[16], v1[16];
#pragma unroll
            for (int jj = 0; jj < 16; ++jj) { const int q = 16 * w + jj; const unsigned rw = raw[jj];
                const float mean = ST[2 * q], rs = ST[2 * q + 1];
                v0[jj] = (bflo(rw) - mean) * rs * lw.x + lbv.x; v1[jj] = (bfhi(rw) - mean) * rs * lw.y + lbv.y; }
#pragma unroll
            for (int hh = 0; hh < 2; ++hh) { u32x4 o;
                o.x = pk2(v0[8 * hh + 0], v0[8 * hh + 1]); o.y = pk2(v0[8 * hh + 2], v0[8 * hh + 3]); o.z = pk2(v0[8 * hh + 4], v0[8 * hh + 5]); o.w = pk2(v0[8 * hh + 6], v0[8 * hh + 7]);
                *(LAS u32x4*)(vt + c0 * VS + 32 * w + 16 * hh) = o;
                o.x = pk2(v1[8 * hh + 0], v1[8 * hh + 1]); o.y = pk2(v1[8 * hh + 2], v1[8 * hh + 3]); o.z = pk2(v1[8 * hh + 4], v1[8 * hh + 5]); o.w = pk2(v1[8 * hh + 6], v1[8 * hh + 7]);
                *(LAS u32x4*)(vt + (c0 + 1) * VS + 32 * w + 16 * hh) = o; }
        }
        __syncthreads();
        f32x4 acc[8];
#pragma unroll
        for (int ct = 0; ct < 8; ++ct) acc[ct] = (f32x4){0.f, 0.f, 0.f, 0.f};
#pragma unroll
        for (int ks = 0; ks < 4; ++ks) {
            const bf16x8 av = *(const bf16x8*)(WSb + ((size_t)(g * 128 + 16 * w + l15)) * 128 + 32 * ks + 8 * gq);
#pragma unroll
            for (int ct = 0; ct < 8; ++ct) { const bf16x8 bv = *(const LAS bf16x8*)(vt + (16 * ct + l15) * VS + (32 * ks + 8 * gq) * 2);
                acc[ct] = __builtin_amdgcn_mfma_f32_16x16x32_bf16(av, bv, acc[ct], 0, 0, 0); }
        }
        {
            LAS float* ob = (LAS float*)(lds + OB_OFF);
#pragma unroll
            for (int r = 0; r < 4; ++r) { const int p = 16 * w + 4 * gq + r; const float bias = a.sg_b_s[g * 128 + p];
#pragma unroll
                for (int ct = 0; ct < 8; ++ct) ob[p * OBS + 16 * ct + l15] = acc[ct][r] + bias; }
            LDS_WAIT();
#pragma unroll
            for (int i4 = 0; i4 < 4; ++i4) { const int p = 16 * w + 4 * i4 + (lane >> 4), c8 = (lane & 15) * 8;
                const f32x4 m0 = *(const LAS f32x4*)(ob + p * OBS + c8), m1 = *(const LAS f32x4*)(ob + p * OBS + c8 + 4);
                const u32x4 uu = ur[i4];
                u32x2 o; o.x = pk4_fp8(bflo(uu.x) * m0[0], bfhi(uu.x) * m0[1], bflo(uu.y) * m0[2], bfhi(uu.y) * m0[3]); o.y = pk4_fp8(bflo(uu.z) * m1[0], bfhi(uu.z) * m1[1], bflo(uu.w) * m1[2], bfhi(uu.w) * m1[3]);
                *(u32x2*)((unsigned char*)A2 + (r0 + p) * D + 128 * g + c8) = o; }
        }
        if (more) {
#pragma unroll
            for (int i4 = 0; i4 < 4; ++i4) ur[i4] = urN[i4];
#pragma unroll
            for (int jj = 0; jj < 16; ++jj) raw[jj] = rawN[jj];
#pragma unroll
            for (int j = 0; j < 8; ++j) st[j] = stN[j];
        }
    }
#undef MIX_ISSUE
}

constexpr int N_LAUNCHES = MK_N_LAUNCHES;
__global__ void __launch_bounds__(512, 2) fwd_kernel(Args a_unused) {
    extern __shared__ __attribute__((aligned(16))) unsigned char lds_raw[];
    LAS unsigned char* lds = (LAS unsigned char*)lds_raw;
    const CAS Args* kp = (const CAS Args*)__builtin_amdgcn_kernarg_segment_ptr();
    __builtin_amdgcn_s_setreg((0 << 11) | (23 << 6) | 1, 1u);
    {
        volatile LAS unsigned* MISC = (volatile LAS unsigned*)(lds + MISC_OFF);
        if (threadIdx.x < 64) MISC[threadIdx.x] = 0u;
        __syncthreads();
        if (N_LAUNCHES == 1) (void)xcd_barrier_post((unsigned*)(kp->ws + WS_CTL) + 1024, MISC + 8);
    }
#if defined(PHASE_MASK)
#define IN(k) ((((PHASE_MASK) >> (k)) & 1) && A.ph_lo <= (k) && (k) < A.ph_hi)
#elif defined(ONLY_PHASE)
#define IN(k) ((k) == ONLY_PHASE && A.ph_lo <= (k) && (k) < A.ph_hi)
#else
#define IN(k) (A.ph_lo <= (k) && (k) < A.ph_hi)
#endif
#ifdef TS_LO
#define TS_BEGIN(k) if ((k) == TS_LO && blockIdx.x == 0 && threadIdx.x == 0) { *(volatile unsigned long long*)(ws + WS_CTL + 32768) = __builtin_amdgcn_s_memrealtime(); }
#define TS_END(k) if ((k) == TS_HI - 1 && blockIdx.x == 0 && threadIdx.x == 0) { *(volatile unsigned long long*)(ws + WS_CTL + 32776) = __builtin_amdgcn_s_memrealtime(); }
#else
#define TS_BEGIN(k)
#define TS_END(k)
#endif
#define PHASE_BEGIN(k) { ArgsRef A = *launder_args(kp); if (IN(k)) { unsigned char* ws = A.ws; const int G = gridDim.x, bx = blockIdx.x; const int vcu = (G % 8 == 0) ? (bx % 8) * (G / 8) + bx / 8 : bx; (void)vcu; (void)ws; TS_BEGIN(k)
#define PHASE_END(k) if (N_LAUNCHES == 1 && (k) + 1 < A.ph_hi) { XcdBarrier bar; bar.bar = (unsigned*)(ws + WS_CTL) + 1024; bar.x = xb_xcc_id(); bar.st = (volatile LAS unsigned*)(lds + MISC_OFF) + 8; xcd_barrier(bar); } TS_END(k) } }
#define PHASE_END_H(k, hook_) if (N_LAUNCHES == 1 && (k) + 1 < A.ph_hi) { XcdBarrier bar; bar.bar = (unsigned*)(ws + WS_CTL) + 1024; bar.x = xb_xcc_id(); bar.st = (volatile LAS unsigned*)(lds + MISC_OFF) + 8; xcd_barrier(bar, [&] { hook_; }); } TS_END(k) } }
#define GLA_PTRS gla::Ptrs GP{(const bf16*)(ws + WS_V), (const bf16*)(ws + WS_KF), (const bf16*)(ws + WS_LFF), (const bf16*)(ws + WS_KB), (const bf16*)(ws + WS_LFB), (const bf16*)(ws + WS_Q), (const bf16*)(ws + WS_SG), \
                 (float*)(ws + WS_OF), (bf16*)(ws + WS_OG), A.hg_gnorm, (float*)(ws + WS_LST), (float*)(ws + WS_SENT), (float*)(ws + WS_LSTC), (float*)(ws + WS_DSUM), (float*)(ws + WS_DSUMC)}

    PHASE_BEGIN(0) phase_p0a(lds, A, G, vcu); PHASE_END(0)
    PHASE_BEGIN(1) phase_p0b(lds, A, G, vcu); PHASE_END(1)
    PHASE_BEGIN(2)
        const int NG = (G == 256) ? 132 : G;
        if (bx >= NG) convert_worker<1>(lds, A, 0, Q_DONE0, (unsigned)NG);
        else {
            const float* LB = (const float*)(ws + WS_LB); LAS float* aux = (LAS float*)(lds + GEMM_AUX_OFF); bool sigdone = false;
            for (int i = threadIdx.x; i < 2048; i += 512) aux[i] = LB[i];
            __syncthreads();
            {
                pg8::Gemm g{(const bf16*)(ws + WS_H), (const bf16*)(ws + WS_WHIN), D, nullptr}; pg8::HinOrder<false> S; S.init(NG, NG - 1 - bx);
                pg8::EpiHin<false> E{ws};
                pg8::gemm_phase<pg8::EpiHin<false>, pg8::HinOrder<false>, false, false, D>(lds, g, S, E);
            }
            {
                pg8::Gemm g{(const bf16*)(ws + WS_H8), (const bf16*)(ws + WS_WHIN8), D, nullptr}; pg8::HinOrder<true> S; S.init(NG, bx);
                pg8::EpiHin<true> E{ws}; pg8::Unit u0; const bool any = S.next(0, u0);
                if (G == 256 && any) g.sig = (unsigned*)(ws + WS_CTL) + Q_DONE0;
                pg8::gemm_phase<pg8::EpiHin<true>, pg8::HinOrder<true>, false, true, D>(lds, g, S, E);
                if (g.sig != nullptr) sigdone = true;
            }
            if (!sigdone && threadIdx.x == 0) __hip_atomic_fetch_add((unsigned*)(ws + WS_CTL) + Q_DONE0, 1u, __ATOMIC_RELAXED, __HIP_MEMORY_SCOPE_AGENT);
        }
    PHASE_END(2)
#ifdef TS_QH
    PHASE_BEGIN(3) if (bx == 0 && threadIdx.x == 0) { const unsigned qh = __hip_atomic_load((unsigned*)(ws + WS_CTL) + Q_HEAD, __ATOMIC_RELAXED, __HIP_MEMORY_SCOPE_AGENT); *(volatile unsigned long long*)(ws + WS_CTL + 32768) = 0ull; *(volatile unsigned long long*)(ws + WS_CTL + 32776) = (unsigned long long)(qh >= (unsigned)TS_QH ? 0u : 5000u); } GLA_PTRS; gla::pass_a(lds, GP, G); PHASE_END(3)
#else
    PHASE_BEGIN(3) GLA_PTRS; gla::pass_a(lds, GP, G); PHASE_END(3)
#endif
    PHASE_BEGIN(4) GLA_PTRS; gla::pass_b(GP, G); PHASE_END(4)
    PHASE_BEGIN(5) GLA_PTRS; gla::pass_c(lds, GP, G); PHASE_END(5)
    PHASE_BEGIN(6)
        pg8::Gemm g{(const bf16*)(ws + WS_OG), (const bf16*)(ws + WS_WHOUT), D, nullptr}; pg8::GridOrder S; S.init(64, 4, G, bx, 0);
        pg8::EpiBf16<0> E{(bf16*)(ws + WS_Y), D, nullptr, 1.0f};
        pg8::gemm_phase<pg8::EpiBf16<0>, pg8::GridOrder, false, false, D>(lds, g, S, E);
    PHASE_END_H(6, rowpass_a_fill(lds, A, 0))
#define MOE_PHASES(l, p0) \
    PHASE_BEGIN(p0) phase_rowpass_a(lds, A, G, vcu, l); PHASE_END(p0) \
    PHASE_BEGIN(p0 + 1)   \
        if (bx >= NB * NE && G > NB * NE) convert_worker<1>(lds, A, (l + 1) * 3072, (l) == 0 ? Q_DONE1 : Q_DONE2, (unsigned)(NB * NE)); \
        else { phase_topk(lds, A, G, G > NB * NE ? (unsigned*)(ws + WS_CTL) + ((l) == 0 ? Q_DONE1 : Q_DONE2) : nullptr); } \
    PHASE_END(p0 + 1) \
    PHASE_BEGIN(p0 + 2)   \
        pg8::Gemm g{(const bf16*)(ws + WS_H), (const bf16*)(ws + WS_WGU + (size_t)(l) * NE * 4096 * D), D, (const int*)(ws + WS_ROWMAP)}; pg8::GridOrder S; S.init(128, 16, G, bx, 16); \
        pg8::fill_row_table(lds, S, (const unsigned*)(ws + WS_ROWMAP)); \
        pg8::EpiGU8 E{ws + WS_HID}; \
        pg8::gemm_phase<pg8::EpiGU8, pg8::GridOrder, true, true, D>(lds, g, S, E); \
    PHASE_END_H(p0 + 2, { pg8::GridOrder S2; S2.init(128, 4, G, bx, 4); pg8::fill_row_table(lds, S2, (const unsigned*)(ws + WS_GATE)); })   \
    PHASE_BEGIN(p0 + 3)   \
        pg8::Gemm g{(const bf16*)(ws + WS_HID), (const bf16*)(ws + WS_WD + (size_t)(l) * NE * D * FF), FF, nullptr}; pg8::GridOrder S; S.init(128, 4, G, bx, 4); \
        if (MK_N_LAUNCHES != 1) pg8::fill_row_table(lds, S, (const unsigned*)(ws + WS_GATE)); \
        pg8::EpiDown E{(bf16*)(ws + WS_YP), 1.0f}; \
        pg8::gemm_phase<pg8::EpiDown, pg8::GridOrder, false, true, FF>(lds, g, S, E); \
    PHASE_END(p0 + 3) \
    PHASE_BEGIN(p0 + 4) phase_rowpass_b(A, G, vcu, l); PHASE_END(p0 + 4)

    MOE_PHASES(0, 7)
    PHASE_BEGIN(12)
        pg8::Gemm g{(const bf16*)(ws + WS_H), (const bf16*)(ws + WS_WSIN), D, nullptr}; pg8::GridOrder S; S.init(64, 8, G, bx, 0);
        pg8::EpiBf16<1> E{(bf16*)(ws + WS_Z), 2 * D, (float*)(ws + WS_STATS), 0.03125f};
        pg8::gemm_phase<pg8::EpiBf16<1>, pg8::GridOrder, false, true, D>(lds, g, S, E);
    PHASE_END(12)
    PHASE_BEGIN(13) phase_sgu_mix(lds, A, G); PHASE_END(13)
    PHASE_BEGIN(14)
        pg8::Gemm g{(const bf16*)(ws + WS_A2), (const bf16*)(ws + WS_WSOUT), D, nullptr}; pg8::GridOrder S; S.init(64, 4, G, bx, 0);
        pg8::EpiBf16<0> E{(bf16*)(ws + WS_Y), D, nullptr, 0.03125f};
        pg8::gemm_phase<pg8::EpiBf16<0>, pg8::GridOrder, false, true, D>(lds, g, S, E);
    PHASE_END_H(14, rowpass_a_fill(lds, A, 1))
    MOE_PHASES(1, 15)
#undef IN
}

extern "C" void kernel_launch(void* const* d_in, const int* in_sizes, int n_in, void* d_out, int out_size, void* d_ws, size_t ws_size, hipStream_t stream) {
    static int grid = 0;
    if (grid == 0) {
        if (n_in != 21 || in_sizes[0] != M * D || out_size != M * D || ws_size < WS_END) {
            fprintf(stderr, "kernel_launch: unexpected problem (n_in %d, in0 %d, out %d, ws %zu; need ws >= %zu); nothing launched\n", n_in, n_in > 0 ? in_sizes[0] : -1, out_size, ws_size, (size_t)WS_END); grid = -1; return; }
        int dev = 0, cus = 0, per_cu = 0;
        if (hipGetDevice(&dev) != hipSuccess || hipDeviceGetAttribute(&cus, hipDeviceAttributeMultiprocessorCount, dev) != hipSuccess) { grid = -1; return; }
        if (hipFuncSetAttribute((const void*)fwd_kernel, hipFuncAttributeMaxDynamicSharedMemorySize, LDS_BYTES) != hipSuccess) { fprintf(stderr, "kernel_launch: hipFuncSetAttribute failed\n"); grid = -1; return; }
        if (hipOccupancyMaxActiveBlocksPerMultiprocessor(&per_cu, (const void*)fwd_kernel, 512, LDS_BYTES) != hipSuccess || per_cu < 1) { fprintf(stderr, "kernel_launch: occupancy query reports %d blocks per CU\n", per_cu); (void)hipGetLastError(); }
        grid = cus;
    }
    if (grid < 0) return;
    (void)hipMemsetAsync((char*)d_ws + WS_CTL, 0, CTL_ZERO_BYTES, stream);
    Args a{};
    const float** fp = (const float**)&a;
    for (int i = 0; i < 21; ++i) fp[i] = (const float*)d_in[i];
    a.out = (float*)d_out; a.ws = (unsigned char*)d_ws;
    if (N_LAUNCHES == 1) { a.ph_lo = 0; a.ph_hi = NPHASE; a.li = 0; hipLaunchKernelGGL(fwd_kernel, dim3(grid), dim3(512), LDS_BYTES, stream, a); }
    else for (int li = 0; li < NPHASE; ++li) { a.ph_lo = li; a.ph_hi = li + 1; a.li = li; hipLaunchKernelGGL(fwd_kernel, dim3(grid), dim3(512), LDS_BYTES, stream, a); }
}
```
